# Optimizing an MI355X kernel written in HIP

```python
import jax, jax.numpy as jnp
from jax import lax
import numpy as np

D_MODEL = 4096
BATCH = 2
SEQ = 4096
DEPTH = 2
DEC_BATCH = 16
DEC_SEQ = 32
PAST_LEN = 1024

CHUNK = 64
N_MEM = 256
MIX_WIDTH = D_MODEL
MEM_HEADS = 4
MEM_WIDTH = MIX_WIDTH // 4
MEM_HD = MEM_WIDTH // MEM_HEADS
TOK_WIDTH = MIX_WIDTH - MEM_WIDTH
SGU_CHUNK = 128
SGU_GROUPS = 8
SGU_GW = TOK_WIDTH // SGU_GROUPS
B_HD = 128
B_HEADS = TOK_WIDTH // B_HD
B_BAND_CHUNKS = 8
B_REACH = B_BAND_CHUNKS * CHUNK
REL_CLIP = 128
PEER_HEADS = 8
PEER_NKEYS = 128
PEER_EXPERTS = PEER_NKEYS * PEER_NKEYS
PEER_DKEY = 256
PEER_TOPK = 16
PEER_BLOCK = 64
N_A = (DEPTH + 1) // 2
N_B = DEPTH // 2
ALPHA = (2 * DEPTH) ** 0.25
BETA = (8 * DEPTH) ** -0.25
LN_EPS = 1e-5

kernel_name = 'hybrid_streaming_sgu_bandattn_peer_step'


def layer_norm(x, g, b):
    xf = x.astype(jnp.float32)
    mu = jnp.mean(xf, axis=-1, keepdims=True)
    var = jnp.mean(jnp.square(xf - mu), axis=-1, keepdims=True)
    return ((xf - mu) * lax.rsqrt(var + LN_EPS)).astype(x.dtype) * g + b


def mem_kv(mem, w):
    B = mem.shape[0]
    k, v = jnp.split(mem @ w, 2, axis=-1)
    return (k.reshape(B, N_MEM, MEM_HEADS, MEM_HD), v.reshape(B, N_MEM, MEM_HEADS, MEM_HD))


def mem_attend(q, mk, mv):
    s = jnp.einsum('bthd,bmhd->bhtm', q, mk).astype(jnp.float32) * (MEM_HD ** -0.5)
    p = jax.nn.softmax(s, axis=-1).astype(q.dtype)
    return jnp.einsum('bhtm,bmhd->bthd', p, mv)


def sgu_branch(x, w_in, ln_g, ln_b, w_s, b_s):
    B, T, _ = x.shape
    h = x @ w_in
    uv = jax.nn.gelu(h[..., :2 * TOK_WIDTH])
    qm = h[..., 2 * TOK_WIDTH:]
    u, v = jnp.split(uv, 2, axis=-1)
    v = layer_norm(v, ln_g, ln_b)
    n = min(T, SGU_CHUNK)
    nc = T // n
    mask = jnp.tril(jnp.ones((n, n), dtype=bool))
    w = jnp.where(mask[None], w_s[:, :n, :n], jnp.zeros_like(w_s[:, :n, :n]))
    vc = v.reshape(B, nc, n, SGU_GROUPS, SGU_GW)
    s = jnp.einsum('gts,bcsgd->bctgd', w, vc) + b_s[:, :n].T[None, None, :, :, None]
    tok = u * s.reshape(B, T, TOK_WIDTH)
    return tok, qm, v


def band_qkv(x, w_in):
    B, T, _ = x.shape
    h = x @ w_in
    q = h[..., :TOK_WIDTH].reshape(B, T, B_HEADS, B_HD)
    k = h[..., TOK_WIDTH:2 * TOK_WIDTH].reshape(B, T, B_HEADS, B_HD)
    v = h[..., 2 * TOK_WIDTH:3 * TOK_WIDTH].reshape(B, T, B_HEADS, B_HD)
    qm = h[..., 3 * TOK_WIDTH:]
    return q, k, v, qm


def band_attend(q, k, v, q_pos, k_pos, rel_bias):
    s = jnp.einsum('bqhd,bkhd->bhqk', q, k).astype(jnp.float32) * (B_HD ** -0.5)
    rel = jnp.clip(q_pos[:, None] - k_pos[None, :], -REL_CLIP, REL_CLIP) + REL_CLIP
    s = s + rel_bias[:, rel].astype(jnp.float32)[None]
    s = jnp.where((k_pos >= 0)[None, None, None, :], s, -1e30)
    p = jax.nn.softmax(s, axis=-1).astype(q.dtype)
    return jnp.einsum('bhqk,bkhd->bqhd', p, v)


def chunk_band_prompt(q, k, v, rel_bias):
    B, S, H, hd = q.shape
    nc = S // CHUNK
    pad = ((0, 0), (B_REACH, 0), (0, 0), (0, 0))
    kp = jnp.pad(k, pad)
    vp = jnp.pad(v, pad)
    qc = jnp.moveaxis(q.reshape(B, nc, CHUNK, H, hd), 1, 0)

    def one_chunk(args):
        c, qi = args
        start = c * CHUNK
        ks = lax.dynamic_slice_in_dim(kp, start, B_REACH + CHUNK, axis=1)
        vs = lax.dynamic_slice_in_dim(vp, start, B_REACH + CHUNK, axis=1)
        q_pos = start + jnp.arange(CHUNK)
        k_pos = start - B_REACH + jnp.arange(B_REACH + CHUNK)
        return band_attend(qi, ks, vs, q_pos, k_pos, rel_bias)

    out = lax.map(one_chunk, (jnp.arange(nc), qc))
    return jnp.moveaxis(out, 0, 1).reshape(B, S, H * hd)


def chunk_band_sample(q, k, v, cache_k, cache_v, rel_bias):
    B, T, H, hd = q.shape
    L = cache_k.shape[1]
    k_all = jnp.concatenate([cache_k, k], axis=1)
    v_all = jnp.concatenate([cache_v, v], axis=1)
    q_pos = PAST_LEN + jnp.arange(T)
    k_pos = PAST_LEN - L + jnp.arange(L + T)
    return band_attend(q, k_all, v_all, q_pos, k_pos, rel_bias).reshape(B, T, H * hd)


def peer_ffn(x, wq, keys, u_tab, v_tab):
    B, T, D = x.shape
    n = B * T
    npad = (-n) % PEER_BLOCK
    xt = jnp.pad(x.reshape(n, D), ((0, npad), (0, 0)))
    m = n + npad
    q = (xt @ wq).reshape(m, PEER_HEADS, 2, PEER_DKEY // 2)
    s = jnp.einsum('thpd,hpnd->thpn', q, keys).astype(jnp.float32)
    top_s, top_i = lax.top_k(s, PEER_TOPK)
    cand_s = (top_s[:, :, 0, :, None] + top_s[:, :, 1, None, :]).reshape(m, PEER_HEADS, PEER_TOPK * PEER_TOPK)
    cand_i = (top_i[:, :, 0, :, None] * PEER_NKEYS + top_i[:, :, 1, None, :]).reshape(m, PEER_HEADS, PEER_TOPK * PEER_TOPK)
    best_s, pos = lax.top_k(cand_s, PEER_TOPK)
    idx = jnp.take_along_axis(cand_i, pos, axis=-1)
    g = jax.nn.softmax(best_s, axis=-1)
    hk = PEER_HEADS * PEER_TOPK
    nb = m // PEER_BLOCK

    def one_block(args):
        xb, ib, gb = args
        act = jnp.einsum('td,ted->te', xb, u_tab[ib])
        a = gb.astype(xb.dtype) * jax.nn.gelu(act)
        return jnp.einsum('te,ted->td', a, v_tab[ib])

    y = lax.map(one_block, (xt.reshape(nb, PEER_BLOCK, D), idx.reshape(nb, PEER_BLOCK, hk), g.reshape(nb, PEER_BLOCK, hk)))
    return y.reshape(m, D)[:n].reshape(B, T, D)


def residual_block(x, tok, qm, mk, mv, w_out, ln1g, ln1b, ln2g, ln2b, wq, keys, u_tab, v_tab):
    B, T, _ = x.shape
    mo = mem_attend(qm.reshape(B, T, MEM_HEADS, MEM_HD), mk, mv).reshape(B, T, MEM_WIDTH)
    x = layer_norm(ALPHA * x + jnp.concatenate([tok, mo], axis=-1) @ w_out, ln1g, ln1b)
    return layer_norm(ALPHA * x + peer_ffn(x, wq, keys, u_tab, v_tab), ln2g, ln2b)


def setup_inputs(seed: int = 0) -> dict:
    key = jax.random.key(seed)
    ks = jax.random.split(key, 32)
    nrm = jax.random.normal
    D = D_MODEL
    cache_len = min(B_REACH, PAST_LEN)
    col_a = jnp.concatenate([jnp.full((2 * TOK_WIDTH,), BETA), jnp.ones((MEM_WIDTH,))])
    col_b = jnp.concatenate([jnp.ones((2 * TOK_WIDTH,)), jnp.full((TOK_WIDTH,), BETA), jnp.ones((MEM_WIDTH,))])
    col_m = jnp.concatenate([jnp.ones((MEM_WIDTH,)), jnp.full((MEM_WIDTH,), BETA)])
    return {
        'x_prompt': nrm(ks[0], (BATCH, SEQ, D)),
        'x_sample': nrm(ks[1], (DEC_BATCH, DEC_SEQ, D)),
        'cache_b_k': nrm(ks[2], (N_B, DEC_BATCH, cache_len, B_HEADS, B_HD)),
        'cache_b_v': nrm(ks[3], (N_B, DEC_BATCH, cache_len, B_HEADS, B_HD)) * BETA,
        'cache_mem_k': nrm(ks[4], (DEPTH, DEC_BATCH, N_MEM, MEM_HEADS, MEM_HD)),
        'cache_mem_v': nrm(ks[5], (DEPTH, DEC_BATCH, N_MEM, MEM_HEADS, MEM_HD)) * BETA,
        'mem_prompt': nrm(ks[6], (BATCH, N_MEM, D)),
        'w_in_a': nrm(ks[7], (N_A, D, 2 * TOK_WIDTH + MEM_WIDTH)) * (D ** -0.5) * col_a,
        'sgu_ln_g': 1.0 + 0.05 * nrm(ks[8], (N_A, TOK_WIDTH)),
        'sgu_ln_b': 0.05 * nrm(ks[9], (N_A, TOK_WIDTH)),
        'sgu_w': nrm(ks[10], (N_A, SGU_GROUPS, SGU_CHUNK, SGU_CHUNK)) * (SGU_CHUNK ** -0.5),
        'sgu_b': 1.0 + 0.1 * nrm(ks[11], (N_A, SGU_GROUPS, SGU_CHUNK)),
        'w_in_b': nrm(ks[12], (N_B, D, 3 * TOK_WIDTH + MEM_WIDTH)) * (D ** -0.5) * col_b,
        'rel_bias': 0.5 * nrm(ks[13], (N_B, B_HEADS, 2 * REL_CLIP + 1)),
        'w_mem_kv': nrm(ks[14], (DEPTH, D, 2 * MEM_WIDTH)) * (D ** -0.5) * col_m,
        'w_out': nrm(ks[15], (DEPTH, MIX_WIDTH, D)) * (MIX_WIDTH ** -0.5) * BETA,
        'ln1_g': 1.0 + 0.05 * nrm(ks[16], (DEPTH, D)),
        'ln1_b': 0.05 * nrm(ks[17], (DEPTH, D)),
        'ln2_g': 1.0 + 0.05 * nrm(ks[18], (DEPTH, D)),
        'ln2_b': 0.05 * nrm(ks[19], (DEPTH, D)),
        'peer_wq': nrm(ks[20], (DEPTH, D, PEER_HEADS * PEER_DKEY)) * (D ** -0.5),
        'peer_keys': nrm(ks[21], (DEPTH, PEER_HEADS, 2, PEER_NKEYS, PEER_DKEY // 2)) * ((PEER_DKEY // 2) ** -0.5),
        'peer_u': nrm(ks[22], (DEPTH, PEER_EXPERTS, D)) * (D ** -0.5) * BETA,
        'peer_v': nrm(ks[23], (DEPTH, PEER_EXPERTS, D)) * BETA,
    }


def reference(x_prompt, x_sample, cache_b_k, cache_b_v, cache_mem_k, cache_mem_v, mem_prompt,
              w_in_a, sgu_ln_g, sgu_ln_b, sgu_w, sgu_b, w_in_b, rel_bias, w_mem_kv, w_out,
              ln1_g, ln1_b, ln2_g, ln2_b, peer_wq, peer_keys, peer_u, peer_v):
    xp, xs = x_prompt, x_sample
    S = xp.shape[1]
    keep = min(B_REACH, S)
    kb_p, vb_p, mk_p_all, mv_p_all, kb_s, vb_s, va_s = [], [], [], [], [], [], []
    for i in range(DEPTH):
        j = i // 2
        mk_p, mv_p = mem_kv(mem_prompt, w_mem_kv[i])
        mk_p_all.append(mk_p)
        mv_p_all.append(mv_p)
        if i % 2 == 0:
            tok_p, qm_p, _ = sgu_branch(xp, w_in_a[j], sgu_ln_g[j], sgu_ln_b[j], sgu_w[j], sgu_b[j])
            tok_s, qm_s, v_rows = sgu_branch(xs, w_in_a[j], sgu_ln_g[j], sgu_ln_b[j], sgu_w[j], sgu_b[j])
            va_s.append(v_rows)
        else:
            q, k, v, qm_p = band_qkv(xp, w_in_b[j])
            tok_p = chunk_band_prompt(q, k, v, rel_bias[j])
            kb_p.append(k[:, S - keep:])
            vb_p.append(v[:, S - keep:])
            q, k, v, qm_s = band_qkv(xs, w_in_b[j])
            tok_s = chunk_band_sample(q, k, v, cache_b_k[j], cache_b_v[j], rel_bias[j])
            kb_s.append(k)
            vb_s.append(v)
        xp = residual_block(xp, tok_p, qm_p, mk_p, mv_p, w_out[i], ln1_g[i], ln1_b[i], ln2_g[i], ln2_b[i],
                            peer_wq[i], peer_keys[i], peer_u[i], peer_v[i])
        xs = residual_block(xs, tok_s, qm_s, cache_mem_k[i], cache_mem_v[i], w_out[i], ln1_g[i], ln1_b[i],
                            ln2_g[i], ln2_b[i], peer_wq[i], peer_keys[i], peer_u[i], peer_v[i])
    return (xp, xs, jnp.stack(kb_p), jnp.stack(vb_p), jnp.stack(mk_p_all), jnp.stack(mv_p_all),
            jnp.stack(kb_s), jnp.stack(vb_s), jnp.stack(va_s))
```

```cpp
#include <hip/hip_runtime.h>
#include <cstdio>
#include <cstdint>

#define GAS __attribute__((address_space(1)))
#define LAS __attribute__((address_space(3)))
#define DI __device__ __forceinline__
typedef unsigned short bf16;
typedef short bf16x8 __attribute__((ext_vector_type(8)));
typedef float f32x4 __attribute__((ext_vector_type(4)));
typedef float f32x2 __attribute__((ext_vector_type(2)));
typedef unsigned u32x4 __attribute__((ext_vector_type(4)));
typedef unsigned u32x2 __attribute__((ext_vector_type(2)));
typedef __bf16 bf2_t __attribute__((ext_vector_type(2)));

#ifndef MK_CHECK
#define MK_CHECK 0
#endif
#ifndef MK_N_LAUNCHES
#define MK_N_LAUNCHES 1
#endif
constexpr int NPHASES = 15;
constexpr int U1_A = 8192, V1_A = 12288;
constexpr int V0_A = 4096, V0_B = 12288;
#ifndef MK_P9_SUB
#define MK_P9_SUB 1
#endif
#ifndef MK_STEP_DUP
#define MK_STEP_DUP 0
#endif
#ifndef MK_DUP_MASK
#define MK_DUP_MASK 0
#endif
constexpr int N_LAUNCHES = MK_N_LAUNCHES;

constexpr int D = 4096, MP = 8192, MS = 512, M = MP + MS;
constexpr int TOK = 3072, MEMW = 1024;
constexpr int NEXP = 16384;
constexpr float ALPHA = 1.41421356237f;
constexpr float LN_EPS = 1e-5f;
constexpr int KDIM = 4096;

constexpr size_t O_YP = 0, O_YS = 33554432, O_BKP = 35651584, O_BVP = 38797312, O_MKP = 41943040, O_MVP = 42991616,
                 O_BKS = 44040192, O_BVS = 45613056, O_SGV = 47185920, O_END = 48758784;

constexpr size_t MiB = 1u << 20;
constexpr size_t WS_CTL = 0, CTL_ZERO_BYTES = 2 * MiB;
constexpr size_t WS_WA = 4 * MiB, WS_WB = 60 * MiB, WS_WMKV = 140 * MiB, WS_WOUT = 172 * MiB, WS_WQ = 236 * MiB, WS_KEYB = 268 * MiB, WS_SWB = 269 * MiB;
constexpr size_t WS_PU = 270 * MiB, WS_SCU = 400 * MiB, WS_PV = 526 * MiB, WS_SCV = 656 * MiB,
                  WS_XB = 782 * MiB, WS_XF = 850 * MiB, WS_MEMB = 986 * MiB, WS_MKB = 990 * MiB, WS_MVT = 992 * MiB;
constexpr size_t WS_CMK = 994 * MiB, WS_CMVT = 1010 * MiB, WS_CK = 1026 * MiB, WS_CVT = 1074 * MiB;
constexpr size_t WS_BUFA = 1122 * MiB, WS_BUFB = 1173 * MiB, WS_BUFC = 1224 * MiB, WS_QM = 1275 * MiB, WS_CAT = 1292 * MiB;
constexpr size_t WS_Z = 1360 * MiB, WS_X1F = 1496 * MiB, WS_X1B = 1632 * MiB, WS_PQ = 1700 * MiB, WS_IDX = 1734 * MiB, WS_GATE = 1739 * MiB, WS_VST = 1744 * MiB, WS_XB8 = 1746 * MiB, WS_WA8 = 1780 * MiB, WS_WB8 = 1808 * MiB, WS_END = 1848 * MiB;
constexpr int CW_TMO = 0, CW_BAR = 4096;

constexpr int RING_BYTES = 131072;
constexpr int LDSCTL_OFF = 163328, MISC_OFF = LDSCTL_OFF + 320;
constexpr int LDS_BYTES = 163840;
constexpr int NWAVES = 8;

DI unsigned pk2(float lo, float hi) { return __builtin_bit_cast(unsigned, __builtin_convertvector((f32x2){lo, hi}, bf2_t)); }
DI unsigned pk4_fp8(float a, float b, float c, float d) {
    a = fminf(fmaxf(a, -448.f), 448.f); b = fminf(fmaxf(b, -448.f), 448.f); c = fminf(fmaxf(c, -448.f), 448.f); d = fminf(fmaxf(d, -448.f), 448.f);
    int w = 0; w = __builtin_amdgcn_cvt_pk_fp8_f32(a, b, w, false); w = __builtin_amdgcn_cvt_pk_fp8_f32(c, d, w, true); return (unsigned)w; }
constexpr float CAT_SCALE = 32.0f, WOUT_SCALE = 2048.0f, XB_SCALE = 16.0f, WIN_SCALE = 2048.0f;
DI float bflo(unsigned u) { return __uint_as_float(u << 16); }
DI float bfhi(unsigned u) { return __uint_as_float(u & 0xffff0000u); }
DI float gelu_tanh(float x) {
    const float t = x * (1.0f + 0.044715f * x * x);
    return x * __builtin_amdgcn_rcpf(1.0f + __builtin_amdgcn_exp2f(-2.3022081984f * t));
}
DI float wave_sum(float v) {
#pragma unroll
    for (int o = 1; o < 64; o <<= 1) v += __shfl_xor(v, o);
    return v;
}
DI float row16_sum(float x) {
    x += __builtin_bit_cast(float, __builtin_amdgcn_update_dpp(0, __builtin_bit_cast(int, x), 0x128, 0xf, 0xf, false));
    x += __builtin_bit_cast(float, __builtin_amdgcn_update_dpp(0, __builtin_bit_cast(int, x), 0x124, 0xf, 0xf, false));
    x += __builtin_bit_cast(float, __builtin_amdgcn_update_dpp(0, __builtin_bit_cast(int, x), 0x122, 0xf, 0xf, false));
    x += __builtin_bit_cast(float, __builtin_amdgcn_update_dpp(0, __builtin_bit_cast(int, x), 0x121, 0xf, 0xf, false));
    return x;
}
#define LDS_WAIT() asm volatile("s_waitcnt lgkmcnt(0)" ::: "memory")
#define VM_WAIT() asm volatile("s_waitcnt vmcnt(0)" ::: "memory")

namespace pg8 {
constexpr int BM = 256, BK = 64, HALF = 128, HTB = HALF * BK * 2, STAGE_BYTES = 8 * HTB, NXCD = 8, WGM = 8;
DI int lds_byte(int r, int c) { const int st = (r >> 4) * 2 + (c >> 5), rr = r & 15, cc = c & 31, ob = rr * 64 + cc * 2; return st * 1024 + (ob ^ (((ob >> 9) & 1) << 5)); }
DI void stage_rc(int b, int& R, int& C) { const int st = b / 1024, sb = b % 1024, swz = sb ^ (((sb >> 9) & 1) << 5); R = (st >> 1) * 16 + swz / 64; C = (st & 1) * 32 + (swz % 64) / 2; }
DI int perm32(int rho) { const int n = rho >> 4, i = rho & 15; return 8 * (i >> 2) + 4 * n + (i & 3); }

typedef int v8i __attribute__((ext_vector_type(8))); typedef int v4i __attribute__((ext_vector_type(4)));
DI v8i cat8(bf16x8 a, bf16x8 b) { return __builtin_shufflevector(__builtin_bit_cast(v4i, a), __builtin_bit_cast(v4i, b), 0, 1, 2, 3, 4, 5, 6, 7); }
struct Unit { int pm, pn, kind, aux; const char* pA; const char* pB; };
struct Job { const bf16* A; const bf16* Bt; int nM, nN, kind, aux; int pm0 = 0, pn0 = 0; };
constexpr size_t TSTEP = (size_t)BM * KDIM * 2;

template <class JT, size_t TS = TSTEP> struct MultiOrder {
    JT jt; int G, c;
    DI bool next(int i, Unit& u) const {
        int L = i * G + c;
#pragma unroll
        for (int k = 0; k < JT::NJ; ++k) {
            const Job jb = jt.job(k);
            const int nM = jb.nM, nN = jb.nN, nwg = nM * nN;
            if (L < nwg) {
                unsigned wgid = (unsigned)L; { const unsigned q = (unsigned)nwg / NXCD, r = (unsigned)nwg % NXCD, xcd = wgid % NXCD, off = wgid / NXCD; wgid = (xcd < r ? xcd * (q + 1) : r * (q + 1) + (xcd - r) * q) + off; }
                const unsigned nig = WGM * (unsigned)nN, gid = wgid / nig, fm = gid * WGM, gsz = ((unsigned)nM - fm) < WGM ? ((unsigned)nM - fm) : WGM;
                u.pm = (int)(fm + ((wgid % nig) % gsz)); u.pn = (int)((wgid % nig) / gsz); u.kind = jb.kind; u.aux = jb.aux;
                u.pA = (const char*)jb.A + (size_t)u.pm * TS; u.pB = (const char*)jb.Bt + (size_t)u.pn * TS; u.pm += jb.pm0; u.pn += jb.pn0;
                return true;
            }
            L -= nwg;
        }
        return false;
    }
};

template <class Epi, class Sched, bool F8 = false>
DI void gemm_phase(LAS unsigned char* lds, const Sched& S, const Epi& E, const int tid) {
    constexpr int K = F8 ? KDIM / 2 : KDIM;
    const int wid = __builtin_amdgcn_readfirstlane(tid >> 6), lane = tid & 63, wr = wid >> 2, wc = wid & 3, fr = lane & 15, fq = lane >> 4;
    constexpr int nt = K / BK;
    unsigned voffA[2], voffB[2];
#pragma unroll
    for (int i = 0; i < 2; ++i) { int R, C; stage_rc(tid * 16 + i * 8192, R, C); const int Rb = ((R & ~31) + perm32(R & 31));
        voffA[i] = (unsigned)(R * K + C) * 2u; voffB[i] = (unsigned)(Rb * K + C) * 2u; }
    const size_t kstep = (size_t)(BK * 2);
    const size_t hstep = (size_t)HALF * K * 2;
    const unsigned ldsw = (unsigned)wid * 1024u;
    const int aoff = lds_byte(wr * 64 + fr, fq * 8), boff = lds_byte(wc * 32 + fr, fq * 8);
#define PG8_SA(b, h) (((b) * 2 + (h)) * HTB)
#define PG8_SB(b, h) ((4 + (b) * 2 + (h)) * HTB)
#define PG8_STAGE(bufoff, gbase, voff) do { _Pragma("unroll") for (int _i = 0; _i < 2; ++_i) \
        __builtin_amdgcn_global_load_lds((const unsigned*)((const char*)(gbase) + (voff)[_i]), (LAS unsigned*)(lds + (bufoff) + ldsw + _i * 8192), 16, 0, 0); } while (0)
#define PG8_LDA(dst, b, h) do { _Pragma("unroll") for (int m = 0; m < 4; ++m) { dst[m].lo = *(const LAS v4i*)(lds + PG8_SA(b, h) + aoff + m * 2048); dst[m].hi = *(const LAS v4i*)(lds + PG8_SA(b, h) + aoff + m * 2048 + 1024); } } while (0)
#define PG8_LDB(dst, b, h) do { _Pragma("unroll") for (int n = 0; n < 2; ++n) { dst[n].lo = *(const LAS v4i*)(lds + PG8_SB(b, h) + boff + n * 2048); dst[n].hi = *(const LAS v4i*)(lds + PG8_SB(b, h) + boff + n * 2048 + 1024); } } while (0)
#define PG8_MMA(ai, bj, At, Bt) do { __builtin_amdgcn_s_setprio(1); _Pragma("unroll") for (int m = 0; m < 4; ++m) _Pragma("unroll") for (int n = 0; n < 2; ++n) { \
        if constexpr (F8) { asm volatile("v_mfma_scale_f32_16x16x128_f8f6f4 %0, %1, %2, %0, %3, %3 op_sel_hi:[0,0,0]" : "+v"(acc[ai][bj][m][n]) : "v"(Bt[n]), "v"(At[m]), "v"(sc1)); } \
        else { const v4i _bl = Bt[n].lo, _bh = Bt[n].hi, _al = At[m].lo, _ah = At[m].hi;     \
               acc[ai][bj][m][n] = __builtin_amdgcn_mfma_f32_16x16x32_bf16(__builtin_bit_cast(bf16x8, _bl), __builtin_bit_cast(bf16x8, _al), acc[ai][bj][m][n], 0, 0, 0); \
               acc[ai][bj][m][n] = __builtin_amdgcn_mfma_f32_16x16x32_bf16(__builtin_bit_cast(bf16x8, _bh), __builtin_bit_cast(bf16x8, _ah), acc[ai][bj][m][n], 0, 0, 0); } } __builtin_amdgcn_s_setprio(0); } while (0)
#define PG8_WAIT_V(n) asm volatile("s_waitcnt vmcnt(" #n ")" ::: "memory")
#define PG8_WAIT_L(n) asm volatile("s_waitcnt lgkmcnt(" #n ")" ::: "memory")
#define PG8_BAR __builtin_amdgcn_s_barrier()
#define PG8_SCHED __builtin_amdgcn_sched_barrier(0)
    Unit cur, nxt; int ui = 0;
    if (!S.next(0, cur)) return;
    f32x4 acc[2][2][4][2];
#pragma unroll
    for (int a = 0; a < 2; ++a)
#pragma unroll
        for (int b = 0; b < 2; ++b)
#pragma unroll
            for (int m = 0; m < 4; ++m)
#pragma unroll
                for (int n = 0; n < 2; ++n) acc[a][b][m][n] = (f32x4){0.f, 0.f, 0.f, 0.f};
    const int sc1 = 0x7F7F7F7F;
    v8i At[4], B0[2], B1[2];
    const char* cA = cur.pA; const char* cB = cur.pB;
    PG8_STAGE(PG8_SB(0, 0), cB, voffB); PG8_STAGE(PG8_SB(0, 1), cB + hstep, voffB); PG8_STAGE(PG8_SA(0, 0), cA, voffA); PG8_STAGE(PG8_SA(0, 1), cA + hstep, voffA);
    if (wr == 1) PG8_BAR;
    PG8_WAIT_V(2); PG8_BAR;
    PG8_STAGE(PG8_SB(1, 0), cB + kstep, voffB); PG8_STAGE(PG8_SA(1, 0), cA + kstep, voffA); PG8_STAGE(PG8_SB(1, 1), cB + hstep + kstep, voffB);
    PG8_WAIT_V(6); PG8_BAR;
    for (;;) {
        const bool has_next = S.next(ui + 1, nxt);
        const char* nA = has_next ? nxt.pA : cA; const char* nB = has_next ? nxt.pB : cB;
        for (int t = 0; t < nt; t += 2) {
            const bool last = (t == nt - 2);
            const char* a1 = cA + (size_t)(t + 1) * kstep;
            const char* a2 = last ? nA : cA + (size_t)(t + 2) * kstep; const char* b2 = last ? nB : cB + (size_t)(t + 2) * kstep;
            const char* a3 = a2 + kstep; const char* b3 = b2 + kstep;
            PG8_LDB(B0, 0, 0); PG8_LDB(B1, 0, 1); PG8_SCHED; PG8_LDA(At, 0, 0); PG8_STAGE(PG8_SA(1, 1), a1 + hstep, voffA);
            PG8_WAIT_V(8); PG8_WAIT_L(0); PG8_BAR; PG8_MMA(0, 0, At, B0); PG8_MMA(0, 1, At, B1); PG8_BAR; PG8_SCHED;
            PG8_LDA(At, 0, 1); PG8_STAGE(PG8_SB(0, 0), b2, voffB); PG8_STAGE(PG8_SB(0, 1), b2 + hstep, voffB); PG8_STAGE(PG8_SA(0, 0), a2, voffA);
            PG8_WAIT_V(8); PG8_WAIT_L(0); PG8_BAR; PG8_MMA(1, 0, At, B0); PG8_MMA(1, 1, At, B1); PG8_BAR; PG8_SCHED;
            PG8_LDB(B0, 1, 0); PG8_LDB(B1, 1, 1); PG8_SCHED; PG8_LDA(At, 1, 0); PG8_STAGE(PG8_SA(0, 1), a2 + hstep, voffA);
            PG8_WAIT_V(8); PG8_WAIT_L(0); PG8_BAR; PG8_MMA(0, 0, At, B0); PG8_MMA(0, 1, At, B1); PG8_BAR; PG8_SCHED;
            PG8_LDA(At, 1, 1); PG8_STAGE(PG8_SB(1, 0), b3, voffB); PG8_STAGE(PG8_SB(1, 1), b3 + hstep, voffB); PG8_STAGE(PG8_SA(1, 0), a3, voffA);
            PG8_WAIT_V(8); PG8_WAIT_L(0); PG8_BAR; PG8_MMA(1, 0, At, B0); PG8_MMA(1, 1, At, B1); PG8_BAR; PG8_SCHED;
        }
        if (wr == 0) PG8_BAR;
        if constexpr (F8) asm volatile("s_nop 15\n\ts_nop 15" ::: "memory");
        E(acc, cur, wr, wc, fr, fq);
        if (!has_next) break;
#pragma unroll
        for (int a = 0; a < 2; ++a)
#pragma unroll
            for (int b = 0; b < 2; ++b)
#pragma unroll
                for (int m = 0; m < 4; ++m)
#pragma unroll
                    for (int n = 0; n < 2; ++n) acc[a][b][m][n] = (f32x4){0.f, 0.f, 0.f, 0.f};
        cur = nxt; cA = nA; cB = nB; ++ui;
        if (wr == 1) PG8_BAR;
    }
    PG8_WAIT_V(0);
    PG8_BAR;
#undef PG8_SA
#undef PG8_SB
#undef PG8_STAGE
#undef PG8_LDA
#undef PG8_LDB
#undef PG8_MMA
#undef PG8_WAIT_V
#undef PG8_WAIT_L
#undef PG8_BAR
#undef PG8_SCHED
}
}

#define XB_TMO      128
#define XB_XCNT(j)  (256  + 64 * (j))
#define XB_XSUB(j)  (1280 + 64 * (j))
#define XB_XGEN(j)  (2304 + 64 * (j))
#define XB_TOP      3328
#define XB_TOPGEN   3392
#define XCD_BAR_WORDS 3456
#define XB_SPIN_CAP (1u << 22)

DI unsigned xb_ld(unsigned* p)              { return __hip_atomic_load(p, __ATOMIC_RELAXED, __HIP_MEMORY_SCOPE_AGENT); }
DI unsigned xb_add(unsigned* p, unsigned v) { return __hip_atomic_fetch_add(p, v, __ATOMIC_RELAXED, __HIP_MEMORY_SCOPE_AGENT); }
DI unsigned xb_xcc_id() { return (unsigned)__builtin_amdgcn_s_getreg((3 << 11) | 20) & 0xFu; }
#define XB_SPIN(cond, bar) do { unsigned _sp = 0; while (cond) { __builtin_amdgcn_s_sleep(1); \
    if ((++_sp & 255u) == 0u) { if (xb_ld(&(bar)[XB_TMO])) break; if (_sp > XB_SPIN_CAP) { atomicAdd(&(bar)[XB_TMO], 1u); break; } } } } while (0)

struct XcdBarrier { unsigned* bar; unsigned x; volatile LAS unsigned* st; };

DI XcdBarrier xcd_barrier_post(unsigned* bar, volatile LAS unsigned* st) {
    XcdBarrier b; b.bar = bar; b.x = xb_xcc_id(); b.st = st;
    if (threadIdx.x == 0) st[2] = xb_add(&bar[XB_XCNT(b.x)], 1u);
    return b;
}
DI void xcd_barrier_complete(unsigned* bar, unsigned x, unsigned& nloc, unsigned& nx) {
    const unsigned G = gridDim.x * gridDim.y * gridDim.z;
    unsigned sum, cnt, mine, sp = 0u;
    for (;;) {
        sum = 0u; cnt = 0u; mine = 0u;
#pragma unroll
        for (unsigned j = 0; j < 16; ++j) { const unsigned c = xb_ld(&bar[XB_XCNT(j)]); sum += c; cnt += (c > 0u) ? 1u : 0u; mine = (j == x) ? c : mine; }
        if (sum == G) break;
        __builtin_amdgcn_s_sleep(1);
        if ((++sp & 255u) == 0u) { if (xb_ld(&bar[XB_TMO])) break; if (sp > XB_SPIN_CAP) { atomicAdd(&bar[XB_TMO], 1u); break; } }
    }
    nloc = mine > 0u ? mine : 1u; nx = cnt > 0u ? cnt : 1u;
}
DI void xcd_barrier(const XcdBarrier& b) {
    asm volatile("s_waitcnt vmcnt(0)" ::: "memory");
    __syncthreads();
    if (threadIdx.x == 0) {
        unsigned* bar = b.bar;
        __builtin_amdgcn_s_waitcnt(0);
        unsigned nloc = b.st[0], nx = b.st[1];
        if (nloc == 0u) { xcd_barrier_complete(bar, b.x, nloc, nx); b.st[0] = nloc; b.st[1] = nx; }
        const unsigned old = xb_add(&bar[XB_XSUB(b.x)], 1u);
        const unsigned gen = old / nloc;
        if (old + 1u == (gen + 1u) * nloc) {
            __builtin_amdgcn_fence(__ATOMIC_RELEASE, "agent");
            asm volatile("s_waitcnt vmcnt(0)" ::: "memory");
            const unsigned og = xb_add(&bar[XB_TOP], 1u);
            const unsigned tg = og / nx;
            if (og + 1u == (tg + 1u) * nx) xb_add(&bar[XB_TOPGEN], 1u);
            else XB_SPIN(xb_ld(&bar[XB_TOPGEN]) == tg, bar);
            __builtin_amdgcn_fence(__ATOMIC_ACQUIRE, "agent");
            xb_add(&bar[XB_XGEN(b.x)], 1u);
            asm volatile("s_waitcnt vmcnt(0)" ::: "memory");
        } else {
            XB_SPIN(xb_ld(&bar[XB_XGEN(b.x)]) == gen, bar);
            __builtin_amdgcn_fence(__ATOMIC_ACQUIRE, "agent");
            asm volatile("s_waitcnt vmcnt(0)" ::: "memory");
        }
    }
    __syncthreads();
}

struct Args { const float* in[24]; float* out; unsigned char* ws; int ph_lo, ph_hi, dup, pad; };
enum { I_XP = 0, I_XS, I_CBK, I_CBV, I_CMK, I_CMV, I_MEMP, I_WINA, I_SLNG, I_SLNB, I_SGUW, I_SGUB, I_WINB, I_RELB, I_WMKV, I_WOUT,
       I_LN1G, I_LN1B, I_LN2G, I_LN2B, I_PWQ, I_PKEYS, I_PU, I_PV };

DI void tr_item_load(const float* W, int N, int ldw, int item, int lane, f32x4 (&v)[16]) {
    const int nblk = N / 64, kb = item / nblk, nb = item % nblk, k0 = 64 * kb, n0 = 64 * nb;
#pragma unroll
    for (int i = 0; i < 16; ++i) v[i] = *(const f32x4*)(W + (size_t)(k0 + 4 * i + (lane >> 4)) * ldw + n0 + 4 * (lane & 15));
}
DI void tr_item_store(const f32x4 (&v)[16], int K, int N, bf16* WT, unsigned char* W8T, float scale, LAS float* scr, int item, int lane) {
    const int nblk = N / 64, kb = item / nblk, nb = item % nblk, k0 = 64 * kb, n0 = 64 * nb;
#pragma unroll
    for (int i = 0; i < 16; ++i) { LAS float* p = scr + (4 * i + (lane >> 4)) * 65 + 4 * (lane & 15); p[0] = v[i][0]; p[1] = v[i][1]; p[2] = v[i][2]; p[3] = v[i][3]; }
    LDS_WAIT(); asm volatile("" ::: "memory");
    const int c = lane >> 3, nl = lane & 7;
#pragma unroll
    for (int j = 0; j < 8; ++j) { const int n = nl + 8 * j; const LAS float* s = scr + (8 * c) * 65 + n;
        const float e0 = s[0 * 65], e1 = s[1 * 65], e2 = s[2 * 65], e3 = s[3 * 65], e4 = s[4 * 65], e5 = s[5 * 65], e6 = s[6 * 65], e7 = s[7 * 65];
        if (WT) { u32x4 o; o.x = pk2(e0, e1); o.y = pk2(e2, e3); o.z = pk2(e4, e5); o.w = pk2(e6, e7); *(u32x4*)(WT + (size_t)(n0 + n) * K + k0 + 8 * c) = o; }
        if (W8T) { u32x2 o8; o8.x = pk4_fp8(e0 * scale, e1 * scale, e2 * scale, e3 * scale); o8.y = pk4_fp8(e4 * scale, e5 * scale, e6 * scale, e7 * scale); *(u32x2*)(W8T + (size_t)(n0 + n) * K + k0 + 8 * c) = o8; } }
    LDS_WAIT(); asm volatile("" ::: "memory");
}
DI void tr_generic(const float* src, int K, int N, int ldw, int nmat, size_t sstride, bf16* dstb, unsigned char* dst8, size_t dstride, float scale, LAS float* scr, int gw, int ngw, int lane) {
    const int per = (K / 64) * (N / 64), total = per * nmat;
    f32x4 va[16], vb[16];
    int it = gw; if (it >= total) return;
#define TRG_LOAD(v, i) do { const int _mi = (i) / per; tr_item_load(src + (size_t)_mi * sstride, N, ldw, (i) - _mi * per, lane, v); } while (0)
#define TRG_STORE(v, i) do { const int _mi = (i) / per; tr_item_store(v, K, N, dstb ? dstb + (size_t)_mi * dstride : nullptr, dst8 ? dst8 + (size_t)_mi * dstride : nullptr, scale, scr, (i) - _mi * per, lane); } while (0)
    TRG_LOAD(va, it);
#pragma unroll 1
    for (; it < total; it += 2 * ngw) {
        const int i2 = it + ngw, i3 = i2 + ngw;
        if (i2 < total) TRG_LOAD(vb, i2);
        TRG_STORE(va, it);
        if (i3 < total) TRG_LOAD(va, i3);
        if (i2 < total) TRG_STORE(vb, i2);
    }
#undef TRG_LOAD
#undef TRG_STORE
}
DI void tr_job_both(const float* src, bf16* dst, unsigned char* dst8, int K, int N, int ldw, float scale, LAS float* scr, int gw, int ngw, int lane) { tr_generic(src, K, N, ldw, 1, 0, dst, dst8, 0, scale, scr, gw, ngw, lane); }
DI void tr_job8(const float* src, unsigned char* dst, int K, int N, int ldw, float scale, LAS float* scr, int gw, int ngw, int lane) { tr_generic(src, K, N, ldw, 1, 0, nullptr, dst, 0, scale, scr, gw, ngw, lane); }
DI void tr_job(const float* src, bf16* dst, int K, int N, int nmat, size_t sstride, size_t dstride, LAS float* scr, int gw, int ngw, int lane) { tr_generic(src, K, N, N, nmat, sstride, dst, nullptr, dstride, 1.f, scr, gw, ngw, lane); }
DI void tr_job_ld(const float* src, bf16* dst, int K, int N, int ldw, LAS float* scr, int gw, int ngw, int lane) { tr_generic(src, K, N, ldw, 1, 0, dst, nullptr, 0, 1.f, scr, gw, ngw, lane); }
DI void cvt_job(const float* src, bf16* dst, size_t n, size_t gtid, size_t nthr, unsigned char* dst8 = nullptr, float scale8 = 1.f) {
    const size_t n8 = n / 8;
    for (size_t i0 = gtid; i0 < n8; i0 += 4 * nthr) {
        f32x4 a[4], b[4];
#pragma unroll
        for (int u = 0; u < 4; ++u) { const size_t i = i0 + u * nthr; if (i < n8) { a[u] = ((const f32x4*)src)[2 * i]; b[u] = ((const f32x4*)src)[2 * i + 1]; } }
#pragma unroll
        for (int u = 0; u < 4; ++u) { const size_t i = i0 + u * nthr; if (i < n8) { u32x4 o; o.x = pk2(a[u][0], a[u][1]); o.y = pk2(a[u][2], a[u][3]); o.z = pk2(b[u][0], b[u][1]); o.w = pk2(b[u][2], b[u][3]); ((u32x4*)dst)[i] = o;
            if (dst8) { u32x2 o8; o8.x = pk4_fp8(a[u][0] * scale8, a[u][1] * scale8, a[u][2] * scale8, a[u][3] * scale8); o8.y = pk4_fp8(b[u][0] * scale8, b[u][1] * scale8, b[u][2] * scale8, b[u][3] * scale8); ((u32x2*)dst8)[i] = o8; } } }
    }
}
DI void fp4_row_load(const float* src, int r, int lane, f32x4 (&v)[8][2]) {
    const f32x4* sp = (const f32x4*)(src + (size_t)r * D);
#pragma unroll
    for (int j = 0; j < 8; ++j)
#pragma unroll
        for (int hh = 0; hh < 2; ++hh) v[j][hh] = sp[(j * 64 + lane) * 2 + hh];
}
DI void fp4_row_store(const f32x4 (&v)[8][2], unsigned* dst, float* sc, int r, int lane) {
    float am = 0.f;
#pragma unroll
    for (int j = 0; j < 8; ++j)
#pragma unroll
        for (int hh = 0; hh < 2; ++hh) am = fmaxf(am, fmaxf(fmaxf(fabsf(v[j][hh][0]), fabsf(v[j][hh][1])), fmaxf(fabsf(v[j][hh][2]), fabsf(v[j][hh][3]))));
#pragma unroll
    for (int o = 1; o < 64; o <<= 1) am = fmaxf(am, __shfl_xor(am, o));
    const float mul = am > 0.f ? 6.0f / am : 1.0f;
#pragma unroll
    for (int j = 0; j < 8; ++j) { unsigned w = 0u;
        w = __builtin_amdgcn_cvt_scalef32_pk_fp4_f32(w, v[j][0][0] * mul, v[j][0][1] * mul, 1.0f, 0); w = __builtin_amdgcn_cvt_scalef32_pk_fp4_f32(w, v[j][0][2] * mul, v[j][0][3] * mul, 1.0f, 1);
        w = __builtin_amdgcn_cvt_scalef32_pk_fp4_f32(w, v[j][1][0] * mul, v[j][1][1] * mul, 1.0f, 2); w = __builtin_amdgcn_cvt_scalef32_pk_fp4_f32(w, v[j][1][2] * mul, v[j][1][3] * mul, 1.0f, 3);
        dst[(size_t)(2 * j + (lane >> 5)) * (NEXP * 32) + (size_t)r * 32 + (lane & 31)] = w; }
    if (lane == 0) sc[r] = am > 0.f ? am * (1.0f / 6.0f) : 1.0f;
}
DI void fp4_rows_job(const float* src, unsigned* dst, float* sc, int r0, int nrows, int gw, int ngw, int lane) {
    f32x4 va[8][2], vb[8][2];
    int r = r0 + gw; if (r >= nrows) return;
    fp4_row_load(src, r, lane, va);
#pragma unroll 1
    for (; r < nrows; r += 2 * ngw) {
        const int r2 = r + ngw, r3 = r2 + ngw;
        if (r2 < nrows) fp4_row_load(src, r2, lane, vb);
        fp4_row_store(va, dst, sc, r, lane);
        if (r3 < nrows) fp4_row_load(src, r3, lane, va);
        if (r2 < nrows) fp4_row_store(vb, dst, sc, r2, lane);
    }
}

enum { K_U = 0, K_QM, K_VT0, K_MEMKV, K_MEMVT, K_OUT, K_WQ, K_Q, K_KK, K_VT1 };
DI void st_bf16x8(bf16* p, f32x4 v0, f32x4 v1) { u32x4 w; w.x = pk2(v0[0], v0[1]); w.y = pk2(v0[2], v0[3]); w.z = pk2(v1[0], v1[1]); w.w = pk2(v1[2], v1[3]); *(u32x4*)p = w; }


DI pg8::Job mkjob(const void* A, const void* Bt, int nM, int nN, int kind, int aux, int pm0, int pn0) { pg8::Job j{(const bf16*)A, (const bf16*)Bt, nM, nN, kind, aux}; j.pm0 = pm0; j.pn0 = pn0; return j; }
struct JobsA { static constexpr int NJ = 5; const bf16 *XB, *Wa, *MEMB, *Wmkv;
    DI pg8::Job job(int k) const {
        switch (k) {
            case 0: return mkjob(Wa + (size_t)3072 * KDIM, XB + (size_t)32 * 256 * KDIM, 12, 2, K_VT0, 0, 0, 32);
            case 1: return pg8::Job{MEMB, Wmkv, 2, 8, K_MEMKV, 0};
            case 2: return pg8::Job{MEMB, Wmkv + (size_t)2048 * KDIM, 2, 8, K_MEMKV, 1};
            case 3: return pg8::Job{Wmkv + (size_t)1024 * KDIM, MEMB, 4, 2, K_MEMVT, 0};
            default: return pg8::Job{Wmkv + (size_t)(2048 + 1024) * KDIM, MEMB, 4, 2, K_MEMVT, 1};
        } } };
struct JobsA8 { static constexpr int NJ = 3; const unsigned char *X8, *W8;
    DI pg8::Job job(int k) const {
        if (k == 0) return mkjob(X8, W8, 34, 12, K_U, 0, 0, 0);
        if (k == 1) return mkjob(W8 + (size_t)4096 * KDIM, X8, 12, 32, K_VT0, 1, 0, 0);
        return mkjob(X8, W8 + (size_t)3072 * KDIM, 34, 4, K_QM, 0, 0, 0); } };
struct JobsB { static constexpr int NJ = 6; const bf16 *XB, *Wb;
    DI pg8::Job job(int k) const {
        const int p0 = (k % 3 == 0) ? 14 : (k % 3 == 1 ? 30 : 32);
        if (k < 3) return mkjob(XB + (size_t)p0 * 256 * KDIM, Wb + (size_t)3072 * KDIM, 2, 12, K_KK, 0, p0, 0);
        return mkjob(Wb + (size_t)6144 * KDIM, XB + (size_t)p0 * 256 * KDIM, 12, 2, K_VT1, 0, 0, p0); } };
struct JobsB8 { static constexpr int NJ = 6; const unsigned char *X8, *W8;
    DI pg8::Job job(int k) const {
        switch (k) {
            case 0: return mkjob(X8, W8, 34, 12, K_Q, 0, 0, 0);
            case 1: return mkjob(X8, W8 + (size_t)4096 * KDIM, 14, 12, K_KK, 1, 0, 0);
            case 2: return mkjob(X8 + (size_t)16 * 256 * KDIM, W8 + (size_t)4096 * KDIM, 14, 12, K_KK, 1, 16, 0);
            case 3: return mkjob(W8 + (size_t)7168 * KDIM, X8, 12, 14, K_VT1, 1, 0, 0);
            case 4: return mkjob(W8 + (size_t)7168 * KDIM, X8 + (size_t)16 * 256 * KDIM, 12, 14, K_VT1, 1, 0, 16);
            default: return mkjob(X8, W8 + (size_t)3072 * KDIM, 34, 4, K_QM, 0, 0, 0);
        } } };
struct Jobs1 { static constexpr int NJ = 1; const bf16 *A, *Bt; int nN, kind;
    DI pg8::Job job(int) const { return pg8::Job{A, Bt, 34, nN, kind, 0}; } };

struct EpiA {
    bf16* U; bf16* QM; bf16* VT; float* vst; float* out; bf16* MKB; bf16* MVT;
    DI void operator()(const f32x4 (&acc)[2][2][4][2], const pg8::Unit& u, int wr, int wc, int fr, int fq) const {
        const int row0 = u.pm * 256 + wr * 64 + fr, col0 = u.pn * 256 + wc * 32 + 8 * fq;
        if (u.kind == K_U) {
#pragma unroll
            for (int ai = 0; ai < 2; ++ai)
#pragma unroll
                for (int m = 0; m < 4; ++m) { bf16* rowp = U + (size_t)(row0 + ai * 128 + m * 16) * TOK + col0;
#pragma unroll
                    for (int bj = 0; bj < 2; ++bj) { f32x4 v0 = acc[ai][bj][m][0], v1 = acc[ai][bj][m][1];
#pragma unroll
                        for (int i = 0; i < 4; ++i) { v0[i] = gelu_tanh(v0[i] * (1.0f / (XB_SCALE * WIN_SCALE))); v1[i] = gelu_tanh(v1[i] * (1.0f / (XB_SCALE * WIN_SCALE))); }
                        st_bf16x8(rowp + bj * 128, v0, v1); } }
        } else if (u.kind == K_QM) {
#pragma unroll
            for (int ai = 0; ai < 2; ++ai)
#pragma unroll
                for (int m = 0; m < 4; ++m) { bf16* rowp = QM + (size_t)(row0 + ai * 128 + m * 16) * MEMW + col0;
#pragma unroll
                    for (int bj = 0; bj < 2; ++bj) st_bf16x8(rowp + bj * 128, acc[ai][bj][m][0] * (0.0625f * (1.0f / (XB_SCALE * WIN_SCALE))), acc[ai][bj][m][1] * (0.0625f * (1.0f / (XB_SCALE * WIN_SCALE)))); }
        } else if (u.kind == K_VT0) {
            const int slot = u.pm * 2 + wr;
            const float ds = u.aux ? (1.0f / (XB_SCALE * WIN_SCALE)) : 1.0f;
#pragma unroll
            for (int bj = 0; bj < 2; ++bj)
#pragma unroll
                for (int n = 0; n < 2; ++n) {
                    float cs[4], cq[4];
#pragma unroll
                    for (int i = 0; i < 4; ++i) { cs[i] = 0.f; cq[i] = 0.f; }
#pragma unroll
                    for (int ai = 0; ai < 2; ++ai)
#pragma unroll
                        for (int m = 0; m < 4; ++m) { bf16* rowp = VT + (unsigned)((row0 + ai * 128 + m * 16) * M + col0 + bj * 128 + 4 * n);
                            f32x4 v0 = acc[ai][bj][m][n];
#pragma unroll
                            for (int i = 0; i < 4; ++i) { v0[i] = gelu_tanh(v0[i] * ds); cs[i] += v0[i]; cq[i] += v0[i] * v0[i]; }
                            u32x2 w; w.x = pk2(v0[0], v0[1]); w.y = pk2(v0[2], v0[3]); *(u32x2*)rowp = w; }
                    float ms = 0.f, mq = 0.f;
#pragma unroll
                    for (int i = 0; i < 4; ++i) { const float s = row16_sum(cs[i]), q = row16_sum(cq[i]); if (fr == i) { ms = s; mq = q; } }
                    if (fr < 4) { const int tokc = u.pn * 256 + bj * 128 + wc * 32 + 8 * fq + 4 * n + fr; *(f32x2*)(vst + ((size_t)slot * M + tokc) * 2) = (f32x2){ms, mq}; }
                    asm volatile("" ::: "memory");
                }
        } else if (u.kind == K_MEMKV) {
            const int li = u.aux; const bool isk = u.pn < 4;
            float* ob = out + (isk ? O_MKP : O_MVP) + (size_t)li * 512 * 1024; const int cc = col0 - (isk ? 0 : 1024);
#pragma unroll
            for (int ai = 0; ai < 2; ++ai)
#pragma unroll
                for (int m = 0; m < 4; ++m) { const int row = row0 + ai * 128 + m * 16;
#pragma unroll
                    for (int bj = 0; bj < 2; ++bj) { float* p = ob + (size_t)row * 1024 + cc + bj * 128;
                        *(f32x4*)p = acc[ai][bj][m][0]; *(f32x4*)(p + 4) = acc[ai][bj][m][1];
                        if (isk) st_bf16x8(MKB + ((size_t)li * 512 + row) * 1024 + cc + bj * 128, acc[ai][bj][m][0], acc[ai][bj][m][1]); } }
        } else {
            const int li = u.aux;
#pragma unroll
            for (int ai = 0; ai < 2; ++ai)
#pragma unroll
                for (int m = 0; m < 4; ++m) { bf16* rowp = MVT + ((size_t)li * 1024 + row0 + ai * 128 + m * 16) * 512 + col0;
#pragma unroll
                    for (int bj = 0; bj < 2; ++bj) st_bf16x8(rowp + bj * 128, acc[ai][bj][m][0], acc[ai][bj][m][1]); }
        }
    }
};

template <bool XBF> struct EpiOut {
    const void* xp; const void* xs; bf16* Z;
    DI void operator()(const f32x4 (&acc)[2][2][4][2], const pg8::Unit& u, int wr, int wc, int fr, int fq) const {
        const int row0 = u.pm * 256 + wr * 64 + fr, col0 = u.pn * 256 + wc * 32 + 8 * fq;
#pragma unroll
        for (int ai = 0; ai < 2; ++ai)
#pragma unroll
            for (int m = 0; m < 4; ++m) { const size_t off = (size_t)(row0 + ai * 128 + m * 16) * D + col0;
#pragma unroll
                for (int bj = 0; bj < 2; ++bj) { f32x4 x0, x1;
                    if (XBF) { const bf16* xb = (u.pm < 32) ? (const bf16*)xp : ((const bf16*)xs - (size_t)MP * D); const u32x4 r = *(const u32x4*)(xb + off + bj * 128);
                        x0 = (f32x4){bflo(r.x), bfhi(r.x), bflo(r.y), bfhi(r.y)}; x1 = (f32x4){bflo(r.z), bfhi(r.z), bflo(r.w), bfhi(r.w)}; }
                    else { const float* xb = (u.pm < 32) ? (const float*)xp : ((const float*)xs - (size_t)MP * D); x0 = *(const f32x4*)(xb + off + bj * 128); x1 = *(const f32x4*)(xb + off + bj * 128 + 4); }
                    st_bf16x8(Z + off + bj * 128, x0 * ALPHA + acc[ai][bj][m][0] * (1.0f / (CAT_SCALE * WOUT_SCALE)), x1 * ALPHA + acc[ai][bj][m][1] * (1.0f / (CAT_SCALE * WOUT_SCALE))); } }
    }
};
struct EpiWq {
    bf16* PQ;
    DI void operator()(const f32x4 (&acc)[2][2][4][2], const pg8::Unit& u, int wr, int wc, int fr, int fq) const {
        const int row0 = u.pm * 256 + wr * 64 + fr, col0 = u.pn * 256 + wc * 32 + 8 * fq;
#pragma unroll
        for (int ai = 0; ai < 2; ++ai)
#pragma unroll
            for (int m = 0; m < 4; ++m) { bf16* rowp = PQ + (size_t)(row0 + ai * 128 + m * 16) * 2048 + col0;
#pragma unroll
                for (int bj = 0; bj < 2; ++bj) st_bf16x8(rowp + bj * 128, acc[ai][bj][m][0], acc[ai][bj][m][1]); }
    }
};
template <bool F8P> struct EpiB {
    bf16* Q; bf16* Kb; bf16* QM; bf16* VT; float* out;
    DI void operator()(const f32x4 (&acc)[2][2][4][2], const pg8::Unit& u, int wr, int wc, int fr, int fq) const {
        const int row0 = u.pm * 256 + wr * 64 + fr, col0 = u.pn * 256 + wc * 32 + 8 * fq;
        constexpr float ds = F8P ? (1.0f / (XB_SCALE * WIN_SCALE)) : 1.0f;
        if (F8P && (u.kind == K_Q || u.kind == K_QM)) {
            const bool isq = u.kind == K_Q; bf16* base = isq ? Q : QM; const int ld = isq ? TOK : MEMW;
            const float sc = (isq ? 0.08838834764831845f : 0.0625f) * ds;
#pragma unroll
            for (int ai = 0; ai < 2; ++ai)
#pragma unroll
                for (int m = 0; m < 4; ++m) { bf16* rowp = base + (size_t)(row0 + ai * 128 + m * 16) * ld + col0;
#pragma unroll
                    for (int bj = 0; bj < 2; ++bj) st_bf16x8(rowp + bj * 128, acc[ai][bj][m][0] * sc, acc[ai][bj][m][1] * sc); }
        } else if (u.kind == K_KK) {
            float* fo = nullptr;
            if (!F8P) { if (u.pm >= 32) fo = out + O_BKS + (size_t)(u.pm - 32) * 256 * TOK; else fo = out + O_BKP + ((size_t)(u.pm >> 4) * 512 + ((u.pm & 15) - 14) * 256) * TOK; }
#pragma unroll
            for (int ai = 0; ai < 2; ++ai)
#pragma unroll
                for (int m = 0; m < 4; ++m) { const int rl = wr * 64 + fr + ai * 128 + m * 16; bf16* rowp = Kb + (size_t)(u.pm * 256 + rl) * TOK + col0;
#pragma unroll
                    for (int bj = 0; bj < 2; ++bj) { st_bf16x8(rowp + bj * 128, acc[ai][bj][m][0] * ds, acc[ai][bj][m][1] * ds);
                        if (!F8P) { float* p = fo + (size_t)rl * TOK + col0 + bj * 128; *(f32x4*)p = acc[ai][bj][m][0]; *(f32x4*)(p + 4) = acc[ai][bj][m][1]; } } }
        } else {
            float* fo = nullptr;
            if (!F8P) { if (u.pn >= 32) fo = out + O_BVS + (size_t)(u.pn - 32) * 256 * TOK; else fo = out + O_BVP + ((size_t)(u.pn >> 4) * 512 + ((u.pn & 15) - 14) * 256) * TOK; }
#pragma unroll
            for (int ai = 0; ai < 2; ++ai)
#pragma unroll
                for (int m = 0; m < 4; ++m) { const int ch = row0 + ai * 128 + m * 16; bf16* rowp = VT + (size_t)ch * M + col0;
#pragma unroll
                    for (int bj = 0; bj < 2; ++bj) { st_bf16x8(rowp + bj * 128, acc[ai][bj][m][0] * ds, acc[ai][bj][m][1] * ds);
                        if (!F8P) { float* p = fo + (size_t)(wc * 32 + 8 * fq + bj * 128) * TOK + ch;
#pragma unroll
                            for (int i = 0; i < 4; ++i) { p[(size_t)i * TOK] = acc[ai][bj][m][0][i]; p[(size_t)(4 + i) * TOK] = acc[ai][bj][m][1][i]; } } } }
        }
    }
};

template <int DH> struct AttnState {
    bf16x8 qf[DH / 32]; f32x4 o[DH / 16]; float m, l;
    DI void init(const bf16* qrow, int fq) {
#pragma unroll
        for (int ks = 0; ks < DH / 32; ++ks) qf[ks] = *(const bf16x8*)(qrow + ks * 32 + fq * 8);
#pragma unroll
        for (int db = 0; db < DH / 16; ++db) o[db] = (f32x4){0.f, 0.f, 0.f, 0.f};
        m = -1e30f; l = 0.f;
    }
    template <bool BIAS> DI void tile(const bf16* Kb, int kstride, const bf16* VTb, int vstride, int nblk, const float* rb, int dpos, int fr, int fq) {
        f32x4 s[4];
#pragma unroll
        for (int nb = 0; nb < 4; ++nb) { s[nb] = (f32x4){0.f, 0.f, 0.f, 0.f};
            if (nb < nblk) {
#pragma unroll
                for (int ks = 0; ks < DH / 32; ++ks) { const bf16x8 kf = *(const bf16x8*)(Kb + (size_t)(nb * 16 + fr) * kstride + ks * 32 + fq * 8);
                    s[nb] = __builtin_amdgcn_mfma_f32_16x16x32_bf16(kf, qf[ks], s[nb], 0, 0, 0); }
                if (BIAS) {
#pragma unroll
                    for (int j = 0; j < 4; ++j) { int rel = dpos - (nb * 16 + 4 * fq + j); rel = rel < -128 ? -128 : (rel > 128 ? 128 : rel); s[nb][j] += rb[rel + 128]; }
                }
            } else s[nb] = (f32x4){-1e30f, -1e30f, -1e30f, -1e30f};
        }
        float mx = -1e30f;
#pragma unroll
        for (int nb = 0; nb < 4; ++nb)
#pragma unroll
            for (int j = 0; j < 4; ++j) mx = fmaxf(mx, s[nb][j]);
        mx = fmaxf(mx, __shfl_xor(mx, 16)); mx = fmaxf(mx, __shfl_xor(mx, 32));
        const float mn = fmaxf(m, mx), alpha = __expf(m - mn); m = mn;
        float ps = 0.f;
#pragma unroll
        for (int nb = 0; nb < 4; ++nb)
#pragma unroll
            for (int j = 0; j < 4; ++j) { const float p = __expf(s[nb][j] - mn); s[nb][j] = p; ps += p; }
        l = l * alpha + ps;
#pragma unroll
        for (int db = 0; db < DH / 16; ++db) o[db] = o[db] * alpha;
#pragma unroll
        for (int kk = 0; kk < 2; ++kk) if (2 * kk < nblk) {
            u32x4 pw; pw.x = pk2(s[2 * kk][0], s[2 * kk][1]); pw.y = pk2(s[2 * kk][2], s[2 * kk][3]); pw.z = pk2(s[2 * kk + 1][0], s[2 * kk + 1][1]); pw.w = pk2(s[2 * kk + 1][2], s[2 * kk + 1][3]);
            const bf16x8 pf = __builtin_bit_cast(bf16x8, pw);
#pragma unroll
            for (int db = 0; db < DH / 16; ++db) { const bf16* vp = VTb + (size_t)(db * 16 + fr) * vstride + kk * 32 + 4 * fq;
                const u32x2 lo = *(const u32x2*)vp, hi = *(const u32x2*)(vp + 16); u32x4 vw; vw.x = lo.x; vw.y = lo.y; vw.z = hi.x; vw.w = hi.y;
                o[db] = __builtin_amdgcn_mfma_f32_16x16x32_bf16(__builtin_bit_cast(bf16x8, vw), pf, o[db], 0, 0, 0); }
        }
    }
    DI void finish(bf16* orow, int fq) {
        float lt = l; lt += __shfl_xor(lt, 16); lt += __shfl_xor(lt, 32);
        const float inv = 1.0f / lt;
#pragma unroll
        for (int db = 0; db < DH / 16; ++db) { u32x2 w; w.x = pk2(o[db][0] * inv, o[db][1] * inv); w.y = pk2(o[db][2] * inv, o[db][3] * inv); *(u32x2*)(orow + db * 16 + 4 * fq) = w; }
    }
};

template <int DH> struct AttnWG {
    static constexpr int VT0 = (DH / 64) * 8192, STAGE = VT0 + (DH / 128) * 16384, NDMA = DH / 64 + DH / 64;
    bf16x8 qf[DH / 32]; f32x4 o[DH / 16]; float m, l;
    DI void init(const bf16* qrow, int fq) {
#pragma unroll
        for (int ks = 0; ks < DH / 32; ++ks) qf[ks] = *(const bf16x8*)(qrow + ks * 32 + fq * 8);
#pragma unroll
        for (int db = 0; db < DH / 16; ++db) o[db] = (f32x4){0.f, 0.f, 0.f, 0.f};
        m = -1e30f; l = 0.f;
#pragma unroll
        for (int ks = 0; ks < DH / 32; ++ks) asm volatile("" : "+v"(qf[ks]));
    }
    static DI int kperm(int R) { return (R & 0x23) | ((R & 0x0C) << 1) | ((R & 0x10) >> 2); }
    static DI void dma16(const void* g, LAS unsigned char* l) {
        const unsigned la = __builtin_amdgcn_readfirstlane((unsigned)(unsigned long)l);
        asm volatile("s_mov_b32 m0, %0\n\ts_nop 0\n\tglobal_load_lds_dwordx4 %1, off" :: "s"(la), "v"(g) : "memory", "m0");
    }
    static DI void stage(LAS unsigned char* st, const bf16* kg, int kstride, const bf16* vg, int vstride, int sR, int sC, int wave) {
#pragma unroll
        for (int dh = 0; dh < DH / 64; ++dh) dma16(kg + (size_t)kperm(sR) * kstride + dh * 64 + sC, st + dh * 8192 + wave * 1024);
#pragma unroll
        for (int vb = 0; vb < DH / 128; ++vb)
#pragma unroll
            for (int hf = 0; hf < 2; ++hf) dma16(vg + (size_t)(vb * 128 + hf * 64 + sR) * vstride + sC, st + VT0 + vb * 16384 + hf * 8192 + wave * 1024);
    }
    template <bool BIAS> DI void tile(const LAS unsigned char* st, int nblk, const LAS float* rb, int dpos, int fr, int fq) {
        const int koff = (fr * 64 + fq * 16) ^ ((fr >> 3) << 5);
        const bool far = BIAS && (__builtin_amdgcn_readfirstlane(dpos - fr) - 63 >= 128); float bfar = 0.f; if (BIAS) bfar = rb[0];
        f32x4 s[4];
#pragma unroll
        for (int nb = 0; nb < 4; ++nb) { s[nb] = (f32x4){0.f, 0.f, 0.f, 0.f};
            if (nb < nblk) {
#pragma unroll
                for (int ks = 0; ks < DH / 32; ++ks) { const bf16x8 kf = *(const LAS bf16x8*)(st + (ks >> 1) * 8192 + (nb * 2 + (ks & 1)) * 1024 + koff);
                    s[nb] = __builtin_amdgcn_mfma_f32_16x16x32_bf16(kf, qf[ks], s[nb], 0, 0, 0); }
                if (DH > 128) __builtin_amdgcn_sched_barrier(0);
                if (BIAS) {
                    if (far) { s[nb] = s[nb] + bfar; }
                    else { const LAS float* bp = rb + (640 - dpos) + 8 * fq + (nb >> 1) * 32 + (nb & 1) * 4;
#pragma unroll
                        for (int j = 0; j < 4; ++j) s[nb][j] += bp[j]; }
                }
            } else s[nb] = (f32x4){-1e30f, -1e30f, -1e30f, -1e30f};
        }
        float mx = -1e30f;
#pragma unroll
        for (int nb = 0; nb < 4; ++nb)
#pragma unroll
            for (int j = 0; j < 4; ++j) mx = fmaxf(mx, s[nb][j]);
        mx = fmaxf(mx, __shfl_xor(mx, 16)); mx = fmaxf(mx, __shfl_xor(mx, 32));
        const float mn = fmaxf(m, mx), alpha = __expf(m - mn); m = mn;
        float ps = 0.f;
#pragma unroll
        for (int nb = 0; nb < 4; ++nb)
#pragma unroll
            for (int j = 0; j < 4; ++j) { const float p = __expf(s[nb][j] - mn); s[nb][j] = p; ps += p; }
        l = l * alpha + ps;
#pragma unroll
        for (int db = 0; db < DH / 16; ++db) o[db] = o[db] * alpha;
#pragma unroll
        for (int kk = 0; kk < 2; ++kk) if (2 * kk < nblk) {
            u32x4 pw; pw.x = pk2(s[2 * kk][0], s[2 * kk][1]); pw.y = pk2(s[2 * kk][2], s[2 * kk][3]); pw.z = pk2(s[2 * kk + 1][0], s[2 * kk + 1][1]); pw.w = pk2(s[2 * kk + 1][2], s[2 * kk + 1][3]);
            const bf16x8 pf = __builtin_bit_cast(bf16x8, pw);
#pragma unroll
            for (int db = 0; db < DH / 16; ++db) { const bf16x8 vf = *(const LAS bf16x8*)(st + VT0 + (db >> 3) * 16384 + ((db & 7) * 2 + kk) * 1024 + koff);
                o[db] = __builtin_amdgcn_mfma_f32_16x16x32_bf16(vf, pf, o[db], 0, 0, 0);
                if (DH > 128 && (db & 3) == 3) __builtin_amdgcn_sched_barrier(0); }
        }
    }
    DI void finish(unsigned char* orow, int fq) {
        float lt = l; lt += __shfl_xor(lt, 16); lt += __shfl_xor(lt, 32);
        const float inv = CAT_SCALE / lt;
#pragma unroll
        for (int db = 0; db < DH / 16; ++db) *(unsigned*)(orow + db * 16 + 4 * fq) = pk4_fp8(o[db][0] * inv, o[db][1] * inv, o[db][2] * inv, o[db][3] * inv);
    }
};
#define AW_WAIT(n) asm volatile("s_waitcnt vmcnt(" #n ")" ::: "memory")
#define AW_BAR() do { asm volatile("s_waitcnt lgkmcnt(0)" ::: "memory"); __builtin_amdgcn_s_barrier(); asm volatile("" ::: "memory"); } while (0)
DI void mem_wg(int task, int li, const bf16* QMp, const bf16* MKBp, const bf16* MVTp, const bf16* CMKp, const bf16* CMVTp, unsigned char* CATp, LAS unsigned char* lds, int tid, int wave, int lane) {
    typedef AttnWG<256> A;
    asm volatile("" : "+v"(tid), "+v"(lane));
    const int fr = lane & 15, fq = lane >> 4; int sR, sC; pg8::stage_rc(tid * 16, sR, sC);
    const bf16* kg; const bf16* vg; int vstride, m0; bool active;
    if (task < 256) { const int hm = task & 3, rb = task >> 2, b = rb >> 5; kg = MKBp + ((size_t)li * 512 + b * 256) * 1024 + hm * 256; vg = MVTp + ((size_t)li * 1024 + hm * 256) * 512 + b * 256; vstride = 512; m0 = rb * 128 + wave * 16; active = true; }
    else { const int t2 = task - 256, hm = t2 & 3, sb = t2 >> 2; kg = CMKp + ((size_t)(li * 16 + sb) * 256) * 1024 + hm * 256; vg = CMVTp + ((size_t)(li * 16 + sb) * 1024 + hm * 256) * 256; vstride = 256; m0 = MP + sb * 32 + (wave & 1) * 16; active = wave < 2; }
    const int hm = (task < 256 ? task : task - 256) & 3;
    A st; st.init(QMp + (size_t)(m0 + fr) * MEMW + hm * 256, fq);
    AW_WAIT(0);
    A::stage(lds, kg, 1024, vg, vstride, sR, sC, wave);
    for (int t = 0; t < 4; ++t) {
        if (t < 3) { A::stage(lds + ((t + 1) & 1) * A::STAGE, kg + (size_t)(t + 1) * 64 * 1024, 1024, vg + (t + 1) * 64, vstride, sR, sC, wave); AW_WAIT(8); } else AW_WAIT(0);
        AW_BAR();
        if (active) st.tile<false>(lds + (t & 1) * A::STAGE, 4, nullptr, 0, fr, fq);
        AW_BAR();
    }
    if (active) st.finish(CATp + (size_t)(m0 + fr) * D + TOK + hm * 256, fq);
}
DI void band_wg(int task, const bf16* Qb, const bf16* Kb, const bf16* VT, const bf16* CKp, const bf16* CVTp, const float* relb, unsigned char* CATp, LAS unsigned char* lds, int tid, int wave, int lane) {
    typedef AttnWG<128> A;
    asm volatile("" : "+v"(tid), "+v"(lane));
    const int fr = lane & 15, fq = lane >> 4, grp = wave >> 2; int sR, sC; pg8::stage_rc(tid * 16, sR, sC);
    LAS float* biasl = (LAS float*)(lds + 3 * A::STAGE);
    const bool prompt = task < 1536;
    int h, b, c0 = 0, m0, qpos, jfirst, jlast; bool active;
    if (prompt) { const int cp = task & 31, bh = task >> 5; h = bh % 24; b = bh / 24; c0 = 2 * cp; const int c = c0 + grp; m0 = b * 4096 + c * 64 + (wave & 3) * 16; qpos = c * 64 + (wave & 3) * 16 + fr; jfirst = c0 < 8 ? 8 - c0 : 0; jlast = 9; active = true; }
    else { const int t2 = task - 1536; h = t2 % 24; b = t2 / 24; m0 = MP + b * 32 + (wave & 1) * 16; qpos = 1024 + (wave & 1) * 16 + fr; jfirst = 0; jlast = 8; active = wave < 2; }
    AW_BAR();
    for (int i = tid; i < 704; i += NWAVES * 64) { int rel = 640 - i; rel = rel < -128 ? -128 : (rel > 128 ? 128 : rel); biasl[i] = relb[h * 257 + rel + 128]; }
    A st; st.init(Qb + (size_t)(m0 + fr) * TOK + h * 128, fq);
    AW_WAIT(0);
#define BAND_SRC(j, kp, vp, vs) do { if (prompt) { const int kt = b * 4096 + (c0 - 8 + (j)) * 64; kp = Kb + (size_t)kt * TOK + h * 128; vp = VT + (size_t)(h * 128) * M + kt; vs = M; } \
        else if ((j) < 8) { kp = CKp + ((size_t)(b * 512 + (j) * 64)) * TOK + h * 128; vp = CVTp + ((size_t)b * TOK + h * 128) * 512 + (j) * 64; vs = 512; } \
        else { kp = Kb + (size_t)(MP + b * 32) * TOK + h * 128; vp = VT + (size_t)(h * 128) * M + MP + b * 32; vs = M; } } while (0)
#define BAND_STAGE(j) do { const bf16* kp; const bf16* vp; int vs; BAND_SRC((j), kp, vp, vs); A::stage(lds + (((j) - jfirst) % 3) * A::STAGE, kp, TOK, vp, vs, sR, sC, wave); } while (0)
    BAND_STAGE(jfirst);
    if (jfirst + 1 <= jlast) BAND_STAGE(jfirst + 1);
    for (int j = jfirst; j <= jlast; ++j) {
        if (j < jlast) AW_WAIT(4); else AW_WAIT(0);
        AW_BAR();
        if (j + 2 <= jlast) BAND_STAGE(j + 2);
        const bool part = active && (prompt ? (grp == 0 ? j <= 8 : j >= 1) : true);
        if (part) { const int kp0 = prompt ? (c0 - 8 + j) * 64 : (j < 8 ? 512 + 64 * j : 1024); st.tile<true>(lds + ((j - jfirst) % 3) * A::STAGE, (!prompt && j == 8) ? 2 : 4, biasl, qpos - kp0, fr, fq); }
    }
#undef BAND_STAGE
#undef BAND_SRC
    if (active) st.finish(CATp + (size_t)(m0 + fr) * D + h * 128, fq);
}

struct AttnWG2 {
    static constexpr int VT0 = 16384, STAGE = 32768;
    bf16x8 qf[2][4]; f32x4 o[2][8]; float m[2], l[2];
    DI void init(const bf16* qrow0, const bf16* qrow1, int fq) {
#pragma unroll
        for (int ks = 0; ks < 4; ++ks) { qf[0][ks] = *(const bf16x8*)(qrow0 + ks * 32 + fq * 8); qf[1][ks] = *(const bf16x8*)(qrow1 + ks * 32 + fq * 8); }
#pragma unroll
        for (int g = 0; g < 2; ++g) {
#pragma unroll
            for (int db = 0; db < 8; ++db) o[g][db] = (f32x4){0.f, 0.f, 0.f, 0.f};
            m[g] = -1e30f; l[g] = 0.f; }
#pragma unroll
        for (int ks = 0; ks < 4; ++ks) { asm volatile("" : "+v"(qf[0][ks])); asm volatile("" : "+v"(qf[1][ks])); }
    }
    DI void tile(const LAS unsigned char* st, const LAS float* rb, int dpos0, int fr, int fq) {
        int koff = (fr * 64 + fq * 16) ^ ((fr >> 3) << 5);
        asm volatile("" : "+v"(dpos0), "+v"(koff));
        const int dbase = __builtin_amdgcn_readfirstlane(dpos0 - fr); const float bfar = rb[0];
        const LAS unsigned char* kb = st + koff; const LAS unsigned char* vb = st + VT0 + koff;
        f32x4 s[2][4]; bf16x8 kf[2][4];
#pragma unroll
        for (int ks = 0; ks < 4; ++ks) kf[0][ks] = *(const LAS bf16x8*)(kb + (ks >> 1) * 8192 + (ks & 1) * 1024);
        __builtin_amdgcn_sched_barrier(0);
#pragma unroll
        for (int nb = 0; nb < 4; ++nb) {
            if (nb < 3) {
#pragma unroll
                for (int ks = 0; ks < 4; ++ks) kf[(nb + 1) & 1][ks] = *(const LAS bf16x8*)(kb + (ks >> 1) * 8192 + ((nb + 1) * 2 + (ks & 1)) * 1024); }
            s[0][nb] = (f32x4){0.f, 0.f, 0.f, 0.f}; s[1][nb] = (f32x4){0.f, 0.f, 0.f, 0.f};
#pragma unroll
            for (int ks = 0; ks < 4; ++ks) { s[0][nb] = __builtin_amdgcn_mfma_f32_16x16x32_bf16(kf[nb & 1][ks], qf[0][ks], s[0][nb], 0, 0, 0); s[1][nb] = __builtin_amdgcn_mfma_f32_16x16x32_bf16(kf[nb & 1][ks], qf[1][ks], s[1][nb], 0, 0, 0); }
            if (nb < 3) __builtin_amdgcn_sched_group_barrier(0x100, 4, 0);
            __builtin_amdgcn_sched_group_barrier(0x008, 8, 0);
            __builtin_amdgcn_sched_barrier(0);
        }
        bf16x8 vf[2][4];
#pragma unroll
        for (int i = 0; i < 4; ++i) vf[0][i] = *(const LAS bf16x8*)(vb + (i * 2) * 1024);
        __builtin_amdgcn_sched_barrier(0);
        bf16x8 pf[2][2];
#pragma unroll
        for (int g = 0; g < 2; ++g) {
            const bool far = dbase + 16 * g - 63 >= 128;
#pragma unroll
            for (int nb = 0; nb < 4; ++nb) {
                if (far) s[g][nb] = s[g][nb] + bfar;
                else { const LAS float* bp = rb + (640 - dpos0 - 16 * g) + 8 * fq + (nb >> 1) * 32 + (nb & 1) * 4;
#pragma unroll
                    for (int j = 0; j < 4; ++j) s[g][nb][j] += bp[j]; } }
            float mx = -1e30f;
#pragma unroll
            for (int nb = 0; nb < 4; ++nb)
#pragma unroll
                for (int j = 0; j < 4; ++j) mx = fmaxf(mx, s[g][nb][j]);
            mx = fmaxf(mx, __shfl_xor(mx, 16)); mx = fmaxf(mx, __shfl_xor(mx, 32));
            const float mn = fmaxf(m[g], mx), alpha = __expf(m[g] - mn); m[g] = mn;
            float ps = 0.f;
#pragma unroll
            for (int nb = 0; nb < 4; ++nb)
#pragma unroll
                for (int j = 0; j < 4; ++j) { const float p = __expf(s[g][nb][j] - mn); s[g][nb][j] = p; ps += p; }
            l[g] = l[g] * alpha + ps;
#pragma unroll
            for (int db = 0; db < 8; ++db) o[g][db] = o[g][db] * alpha;
#pragma unroll
            for (int kk = 0; kk < 2; ++kk) { u32x4 pw; pw.x = pk2(s[g][2 * kk][0], s[g][2 * kk][1]); pw.y = pk2(s[g][2 * kk][2], s[g][2 * kk][3]); pw.z = pk2(s[g][2 * kk + 1][0], s[g][2 * kk + 1][1]); pw.w = pk2(s[g][2 * kk + 1][2], s[g][2 * kk + 1][3]);
                pf[g][kk] = __builtin_bit_cast(bf16x8, pw); }
        }
        __builtin_amdgcn_sched_barrier(0);
#pragma unroll
        for (int b = 0; b < 4; ++b) {
            if (b < 3) {
#pragma unroll
                for (int i = 0; i < 4; ++i) { const int f = 4 * (b + 1) + i, kk = f >> 3, db = f & 7; vf[(b + 1) & 1][i] = *(const LAS bf16x8*)(vb + (db * 2 + kk) * 1024); } }
#pragma unroll
            for (int i = 0; i < 4; ++i) { const int f = 4 * b + i, kk = f >> 3, db = f & 7;
                o[0][db] = __builtin_amdgcn_mfma_f32_16x16x32_bf16(vf[b & 1][i], pf[0][kk], o[0][db], 0, 0, 0); o[1][db] = __builtin_amdgcn_mfma_f32_16x16x32_bf16(vf[b & 1][i], pf[1][kk], o[1][db], 0, 0, 0); }
            if (b < 3) __builtin_amdgcn_sched_group_barrier(0x100, 4, 0);
            __builtin_amdgcn_sched_group_barrier(0x008, 8, 0);
            __builtin_amdgcn_sched_barrier(0);
        }
    }
    DI void finish(unsigned char* orow0, unsigned char* orow1, int fq) {
#pragma unroll
        for (int g = 0; g < 2; ++g) { float lt = l[g]; lt += __shfl_xor(lt, 16); lt += __shfl_xor(lt, 32); const float inv = CAT_SCALE / lt; unsigned char* orow = g ? orow1 : orow0;
#pragma unroll
            for (int db = 0; db < 8; ++db) *(unsigned*)(orow + db * 16 + 4 * fq) = pk4_fp8(o[g][db][0] * inv, o[g][db][1] * inv, o[g][db][2] * inv, o[g][db][3] * inv); }
    }
};
DI void band_wg2(int task, const bf16* Qb, const bf16* Kb, const bf16* VT, const float* relb, unsigned char* CATp, LAS unsigned char* lds0, int tid, int wave, int lane, int mode = 0) {
    typedef AttnWG<128> A;
    asm volatile("" : "+v"(tid), "+v"(lane));
    LAS unsigned char* lds = lds0; asm volatile("" : "+v"(lds));
    const int fr = lane & 15, fq = lane >> 4, ci = wave >> 1; int sR, sC; pg8::stage_rc(tid * 16, sR, sC);
    LAS float* biasl = (LAS float*)(lds + 3 * A::STAGE);
    const int cq = task & 15, bh = task >> 4, h = bh % 24, b = bh / 24, c0 = 4 * cq, c = c0 + ci;
    const int r0 = c * 64 + (wave & 1) * 32, m0 = b * 4096 + r0;
    const int jfirst = c0 < 8 ? 8 - c0 : 0, jlast = 11;
    AW_BAR();
    for (int i = tid; i < 704; i += NWAVES * 64) { int rel = 640 - i; rel = rel < -128 ? -128 : (rel > 128 ? 128 : rel); biasl[i] = relb[h * 257 + rel + 128]; }
    AttnWG2 st; st.init(Qb + (size_t)(m0 + fr) * TOK + h * 128, Qb + (size_t)(m0 + 16 + fr) * TOK + h * 128, fq);
    AW_WAIT(0);
    const bf16* kp = Kb + (size_t)(b * 4096 + (c0 - 8 + jfirst) * 64) * TOK + h * 128;
    const bf16* vp = VT + (size_t)(h * 128) * M + b * 4096 + (c0 - 8 + jfirst) * 64;
    if (!(mode & 16)) { A::stage(lds, kp, TOK, vp, M, sR, sC, wave);
    A::stage(lds + A::STAGE, kp + (size_t)64 * TOK, TOK, vp + 64, M, sR, sC, wave); }
    kp += (size_t)128 * TOK; vp += 128;
    int sidx = 0;
    for (int j = jfirst; j <= jlast; ++j) {
        if (j < jlast) AW_WAIT(4); else AW_WAIT(0);
        AW_BAR();
        if (j + 2 <= jlast && !(mode & 16)) { const int s2 = sidx == 0 ? 2 : sidx - 1; A::stage(lds + s2 * A::STAGE, kp, TOK, vp, M, sR, sC, wave); kp += (size_t)64 * TOK; vp += 64; }
        if (j >= ci && j <= ci + 8 && !(mode & 8)) st.tile(lds + sidx * A::STAGE, biasl, r0 + fr - (c0 - 8 + j) * 64, fr, fq);
        sidx = sidx == 2 ? 0 : sidx + 1;
    }
    if (!(mode & 24)) st.finish(CATp + (size_t)(m0 + fr) * D + h * 128, CATp + (size_t)(m0 + 16 + fr) * D + h * 128, fq);
}

DI void sgu_task(int task, const bf16* U, const bf16* VT, const float* vst, const bf16* SWB, const float* lng, const float* lnb, const float* sgub, unsigned char* CAT, float* out, LAS float* stl, int lane) {
    const int fr = lane & 15, fq = lane >> 4;
    const int part = task % 3, g = (task / 3) & 7, ck = task / 24;
    const bool prompt = ck < 64; const int m0 = prompt ? ck * 128 : MP + (ck - 64) * 32, n = prompt ? 128 : 32;
#pragma unroll
    for (int h = 0; h < 2; ++h) { const int t = lane + 64 * h;
        if (t < n) { float s = 0.f, q = 0.f;
            for (int sl = 0; sl < 24; ++sl) { const f32x2 v = *(const f32x2*)(vst + ((size_t)sl * M + m0 + t) * 2); s += v.x; q += v.y; }
            const float mean = s * (1.0f / TOK), var = q * (1.0f / TOK) - mean * mean;
            stl[2 * t] = mean; stl[2 * t + 1] = __builtin_amdgcn_rsqf(var + LN_EPS); } }
    LDS_WAIT(); asm volatile("" ::: "memory");
    const int nrg = n >> 4, nks = n >> 5;
    bf16x8 wf[8][4];
#pragma unroll
    for (int rg = 0; rg < 8; ++rg)
#pragma unroll
        for (int ks = 0; ks < 4; ++ks) if (ks <= (rg >> 1)) { wf[rg][ks] = (rg < nrg) ? *(const bf16x8*)(SWB + ((size_t)g * 128 + rg * 16 + fr) * 128 + ks * 32 + fq * 8) : (bf16x8){0, 0, 0, 0, 0, 0, 0, 0}; }
    float bs[8];
#pragma unroll
    for (int rg = 0; rg < 8; ++rg) bs[rg] = sgub[g * 128 + ((rg < nrg) ? rg * 16 + fr : 0)];
    for (int cb = 0; cb < 8; ++cb) {
        const int ch0 = g * 384 + part * 128 + cb * 16, ch = ch0 + fr;
        const float gg = lng[ch], gb = lnb[ch];
        bf16x8 af[4];
#pragma unroll
        for (int ks = 0; ks < 4; ++ks) if (ks < nks) {
            const u32x4 raw = *(const u32x4*)(VT + (size_t)ch * M + m0 + ks * 32 + fq * 8);
            const LAS f32x4* sp = (const LAS f32x4*)(stl + 2 * (ks * 32 + fq * 8));
            float v[8]; v[0] = bflo(raw.x); v[1] = bfhi(raw.x); v[2] = bflo(raw.y); v[3] = bfhi(raw.y); v[4] = bflo(raw.z); v[5] = bfhi(raw.z); v[6] = bflo(raw.w); v[7] = bfhi(raw.w);
#pragma unroll
            for (int e2 = 0; e2 < 4; ++e2) { const f32x4 mr = sp[e2]; v[2 * e2] = (v[2 * e2] - mr[0]) * mr[1] * gg + gb; v[2 * e2 + 1] = (v[2 * e2 + 1] - mr[2]) * mr[3] * gg + gb; }
            if (!prompt) { float* op = out + O_SGV + (size_t)(m0 - MP + ks * 32 + fq * 8) * TOK + ch;
#pragma unroll
                for (int e = 0; e < 8; ++e) op[(size_t)e * TOK] = v[e]; }
            u32x4 pw; pw.x = pk2(v[0], v[1]); pw.y = pk2(v[2], v[3]); pw.z = pk2(v[4], v[5]); pw.w = pk2(v[6], v[7]);
            af[ks] = __builtin_bit_cast(bf16x8, pw);
        } else af[ks] = (bf16x8){0, 0, 0, 0, 0, 0, 0, 0};
#pragma unroll
        for (int rg = 0; rg < 8; ++rg) if (rg < nrg) {
            f32x4 acc = (f32x4){0.f, 0.f, 0.f, 0.f};
#pragma unroll
            for (int ks = 0; ks < 4; ++ks) if (ks <= (rg >> 1)) acc = __builtin_amdgcn_mfma_f32_16x16x32_bf16(af[ks], wf[rg][ks], acc, 0, 0, 0);
            const size_t t = (size_t)(m0 + rg * 16 + fr);
            const u32x2 uu = *(const u32x2*)(U + t * TOK + ch0 + 4 * fq);
            *(unsigned*)(CAT + t * D + ch0 + 4 * fq) = pk4_fp8(CAT_SCALE * bflo(uu.x) * (acc[0] + bs[rg]), CAT_SCALE * bfhi(uu.x) * (acc[1] + bs[rg]), CAT_SCALE * bflo(uu.y) * (acc[2] + bs[rg]), CAT_SCALE * bfhi(uu.y) * (acc[3] + bs[rg]));
        }
    }
    LDS_WAIT(); asm volatile("" ::: "memory");
}

DI void ln1_row(const bf16* z, const float* g, const float* b, bf16* xb, unsigned char* x8, int lane) {
    f32x4 v[16]; float s = 0.f;
#pragma unroll
    for (int j = 0; j < 8; ++j) { const u32x4 r = ((const u32x4*)z)[j * 64 + lane];
        v[2 * j] = (f32x4){bflo(r.x), bfhi(r.x), bflo(r.y), bfhi(r.y)}; v[2 * j + 1] = (f32x4){bflo(r.z), bfhi(r.z), bflo(r.w), bfhi(r.w)};
        s += ((v[2 * j][0] + v[2 * j][1]) + (v[2 * j][2] + v[2 * j][3])) + ((v[2 * j + 1][0] + v[2 * j + 1][1]) + (v[2 * j + 1][2] + v[2 * j + 1][3])); }
    const float mean = wave_sum(s) * (1.0f / D); float q = 0.f;
#pragma unroll
    for (int j = 0; j < 16; ++j) { v[j] = v[j] - mean; q += (v[j][0] * v[j][0] + v[j][1] * v[j][1]) + (v[j][2] * v[j][2] + v[j][3] * v[j][3]); }
    const float rstd = __builtin_amdgcn_rsqf(wave_sum(q) * (1.0f / D) + LN_EPS);
#pragma unroll
    for (int j = 0; j < 8; ++j) { const int ci = (j * 64 + lane) * 2;
        const f32x4 y0 = v[2 * j] * rstd * ((const f32x4*)g)[ci] + ((const f32x4*)b)[ci], y1 = v[2 * j + 1] * rstd * ((const f32x4*)g)[ci + 1] + ((const f32x4*)b)[ci + 1];
        st_bf16x8(xb + (size_t)(j * 64 + lane) * 8, y0, y1);
        u32x2 w8; w8.x = pk4_fp8(y0[0] * XB_SCALE, y0[1] * XB_SCALE, y0[2] * XB_SCALE, y0[3] * XB_SCALE); w8.y = pk4_fp8(y1[0] * XB_SCALE, y1[1] * XB_SCALE, y1[2] * XB_SCALE, y1[3] * XB_SCALE); ((u32x2*)x8)[j * 64 + lane] = w8; }
}

DI unsigned fkey(float f) { const unsigned u = __float_as_uint(f); return u ^ ((u >> 31) ? 0xffffffffu : 0x80000000u); }
DI float fkey_inv(unsigned k) { return __uint_as_float(k ^ ((k >> 31) ? 0x80000000u : 0xffffffffu)); }
DI unsigned radix_thr16_2(unsigned u0, unsigned u1) {
    unsigned T, bm, c, n0, n1; unsigned long long m0, m1;
    asm volatile("s_mov_b32 %[T], 0\n\ts_brev_b32 %[bm], 1\n"
                 "1:\n\ts_or_b32 %[c], %[T], %[bm]\n\t"
                 "v_cmp_ge_u32_e64 %[m0], %[u0], %[c]\n\tv_cmp_ge_u32_e64 %[m1], %[u1], %[c]\n\t"
                 "s_bcnt1_i32_b64 %[n0], %[m0]\n\ts_bcnt1_i32_b64 %[n1], %[m1]\n\ts_add_i32 %[n0], %[n0], %[n1]\n\t"
                 "s_cmp_ge_u32 %[n0], 16\n\ts_cselect_b32 %[T], %[c], %[T]\n\ts_cmp_eq_u32 %[n0], 16\n\ts_cbranch_scc1 2f\n\t"
                 "s_lshr_b32 %[bm], %[bm], 1\n\ts_cmp_lg_u32 %[bm], 0\n\ts_cbranch_scc1 1b\n"
                 "2:\n"
                 : [T] "=&s"(T), [bm] "=&s"(bm), [c] "=&s"(c), [n0] "=&s"(n0), [n1] "=&s"(n1), [m0] "=&s"(m0), [m1] "=&s"(m1)
                 : [u0] "v"(u0), [u1] "v"(u1) : "scc");
    return T;
}
DI unsigned radix_thr16_4(unsigned u0, unsigned u1, unsigned u2, unsigned u3) {
    unsigned T, bm, c, n0, n1; unsigned long long m0, m1, m2, m3;
    asm volatile("s_mov_b32 %[T], 0\n\ts_brev_b32 %[bm], 1\n"
                 "1:\n\ts_or_b32 %[c], %[T], %[bm]\n\t"
                 "v_cmp_ge_u32_e64 %[m0], %[u0], %[c]\n\tv_cmp_ge_u32_e64 %[m1], %[u1], %[c]\n\tv_cmp_ge_u32_e64 %[m2], %[u2], %[c]\n\tv_cmp_ge_u32_e64 %[m3], %[u3], %[c]\n\t"
                 "s_bcnt1_i32_b64 %[n0], %[m0]\n\ts_bcnt1_i32_b64 %[n1], %[m1]\n\ts_add_i32 %[n0], %[n0], %[n1]\n\t"
                 "s_bcnt1_i32_b64 %[n1], %[m2]\n\ts_add_i32 %[n0], %[n0], %[n1]\n\ts_bcnt1_i32_b64 %[n1], %[m3]\n\ts_add_i32 %[n0], %[n0], %[n1]\n\t"
                 "s_cmp_ge_u32 %[n0], 16\n\ts_cselect_b32 %[T], %[c], %[T]\n\ts_cmp_eq_u32 %[n0], 16\n\ts_cbranch_scc1 2f\n\t"
                 "s_lshr_b32 %[bm], %[bm], 1\n\ts_cmp_lg_u32 %[bm], 0\n\ts_cbranch_scc1 1b\n"
                 "2:\n"
                 : [T] "=&s"(T), [bm] "=&s"(bm), [c] "=&s"(c), [n0] "=&s"(n0), [n1] "=&s"(n1), [m0] "=&s"(m0), [m1] "=&s"(m1), [m2] "=&s"(m2), [m3] "=&s"(m3)
                 : [u0] "v"(u0), [u1] "v"(u1), [u2] "v"(u2), [u3] "v"(u3) : "scc");
    return T;
}
DI void radix_thr16_4x2(unsigned u00, unsigned u01, unsigned u10, unsigned u11, unsigned u20, unsigned u21, unsigned u30, unsigned u31, unsigned& o0, unsigned& o1, unsigned& o2, unsigned& o3) {
    unsigned T0, T1, T2, T3, cc0, cc1, cc2, cc3, bm, dd, n0, n1; unsigned long long m00, m01, m10, m11, m20, m21, m30, m31;
    asm volatile("s_mov_b32 %[T0], 0\n\ts_mov_b32 %[T1], 0\n\ts_mov_b32 %[T2], 0\n\ts_mov_b32 %[T3], 0\n\ts_brev_b32 %[bm], 1\n\ts_mov_b32 %[d], 0\n1:\n\ts_or_b32 %[c0], %[T0], %[bm]\n\ts_or_b32 %[c1], %[T1], %[bm]\n\ts_or_b32 %[c2], %[T2], %[bm]\n\ts_or_b32 %[c3], %[T3], %[bm]\n\tv_cmp_ge_u32_e64 %[m00], %[u00], %[c0]\n\tv_cmp_ge_u32_e64 %[m01], %[u01], %[c0]\n\tv_cmp_ge_u32_e64 %[m10], %[u10], %[c1]\n\tv_cmp_ge_u32_e64 %[m11], %[u11], %[c1]\n\tv_cmp_ge_u32_e64 %[m20], %[u20], %[c2]\n\tv_cmp_ge_u32_e64 %[m21], %[u21], %[c2]\n\tv_cmp_ge_u32_e64 %[m30], %[u30], %[c3]\n\tv_cmp_ge_u32_e64 %[m31], %[u31], %[c3]\n\ts_bcnt1_i32_b64 %[n0], %[m00]\n\ts_bcnt1_i32_b64 %[n1], %[m01]\n\ts_add_i32 %[n0], %[n0], %[n1]\n\ts_cmp_ge_u32 %[n0], 16\n\ts_cselect_b32 %[T0], %[c0], %[T0]\n\ts_cmp_eq_u32 %[n0], 16\n\ts_cselect_b32 %[n1], 1, 0\n\ts_or_b32 %[d], %[d], %[n1]\n\ts_bcnt1_i32_b64 %[n0], %[m10]\n\ts_bcnt1_i32_b64 %[n1], %[m11]\n\ts_add_i32 %[n0], %[n0], %[n1]\n\ts_cmp_ge_u32 %[n0], 16\n\ts_cselect_b32 %[T1], %[c1], %[T1]\n\ts_cmp_eq_u32 %[n0], 16\n\ts_cselect_b32 %[n1], 2, 0\n\ts_or_b32 %[d], %[d], %[n1]\n\ts_bcnt1_i32_b64 %[n0], %[m20]\n\ts_bcnt1_i32_b64 %[n1], %[m21]\n\ts_add_i32 %[n0], %[n0], %[n1]\n\ts_cmp_ge_u32 %[n0], 16\n\ts_cselect_b32 %[T2], %[c2], %[T2]\n\ts_cmp_eq_u32 %[n0], 16\n\ts_cselect_b32 %[n1], 4, 0\n\ts_or_b32 %[d], %[d], %[n1]\n\ts_bcnt1_i32_b64 %[n0], %[m30]\n\ts_bcnt1_i32_b64 %[n1], %[m31]\n\ts_add_i32 %[n0], %[n0], %[n1]\n\ts_cmp_ge_u32 %[n0], 16\n\ts_cselect_b32 %[T3], %[c3], %[T3]\n\ts_cmp_eq_u32 %[n0], 16\n\ts_cselect_b32 %[n1], 8, 0\n\ts_or_b32 %[d], %[d], %[n1]\n\ts_cmp_eq_u32 %[d], 15\n\ts_cbranch_scc1 2f\n\ts_lshr_b32 %[bm], %[bm], 1\n\ts_cmp_lg_u32 %[bm], 0\n\ts_cbranch_scc1 1b\n2:\n"
                 : [T0] "=&s"(T0), [T1] "=&s"(T1), [T2] "=&s"(T2), [T3] "=&s"(T3), [c0] "=&s"(cc0), [c1] "=&s"(cc1), [c2] "=&s"(cc2), [c3] "=&s"(cc3), [bm] "=&s"(bm), [d] "=&s"(dd), [n0] "=&s"(n0), [n1] "=&s"(n1), [m00] "=&s"(m00), [m01] "=&s"(m01), [m10] "=&s"(m10), [m11] "=&s"(m11), [m20] "=&s"(m20), [m21] "=&s"(m21), [m30] "=&s"(m30), [m31] "=&s"(m31)
                 : [u00] "v"(u00), [u01] "v"(u01), [u10] "v"(u10), [u11] "v"(u11), [u20] "v"(u20), [u21] "v"(u21), [u30] "v"(u30), [u31] "v"(u31) : "scc");
    o0 = T0; o1 = T1; o2 = T2; o3 = T3;
}
DI void radix_thr16_2x4(unsigned u00, unsigned u01, unsigned u02, unsigned u03, unsigned u10, unsigned u11, unsigned u12, unsigned u13, unsigned& o0, unsigned& o1) {
    unsigned T0, T1, cc0, cc1, bm, dd, n0, n1; unsigned long long m00, m01, m02, m03, m10, m11, m12, m13;
    asm volatile("s_mov_b32 %[T0], 0\n\ts_mov_b32 %[T1], 0\n\ts_brev_b32 %[bm], 1\n\ts_mov_b32 %[d], 0\n1:\n\ts_or_b32 %[c0], %[T0], %[bm]\n\ts_or_b32 %[c1], %[T1], %[bm]\n\tv_cmp_ge_u32_e64 %[m00], %[u00], %[c0]\n\tv_cmp_ge_u32_e64 %[m01], %[u01], %[c0]\n\tv_cmp_ge_u32_e64 %[m02], %[u02], %[c0]\n\tv_cmp_ge_u32_e64 %[m03], %[u03], %[c0]\n\tv_cmp_ge_u32_e64 %[m10], %[u10], %[c1]\n\tv_cmp_ge_u32_e64 %[m11], %[u11], %[c1]\n\tv_cmp_ge_u32_e64 %[m12], %[u12], %[c1]\n\tv_cmp_ge_u32_e64 %[m13], %[u13], %[c1]\n\ts_bcnt1_i32_b64 %[n0], %[m00]\n\ts_bcnt1_i32_b64 %[n1], %[m01]\n\ts_add_i32 %[n0], %[n0], %[n1]\n\ts_bcnt1_i32_b64 %[n1], %[m02]\n\ts_add_i32 %[n0], %[n0], %[n1]\n\ts_bcnt1_i32_b64 %[n1], %[m03]\n\ts_add_i32 %[n0], %[n0], %[n1]\n\ts_cmp_ge_u32 %[n0], 16\n\ts_cselect_b32 %[T0], %[c0], %[T0]\n\ts_cmp_eq_u32 %[n0], 16\n\ts_cselect_b32 %[n1], 1, 0\n\ts_or_b32 %[d], %[d], %[n1]\n\ts_bcnt1_i32_b64 %[n0], %[m10]\n\ts_bcnt1_i32_b64 %[n1], %[m11]\n\ts_add_i32 %[n0], %[n0], %[n1]\n\ts_bcnt1_i32_b64 %[n1], %[m12]\n\ts_add_i32 %[n0], %[n0], %[n1]\n\ts_bcnt1_i32_b64 %[n1], %[m13]\n\ts_add_i32 %[n0], %[n0], %[n1]\n\ts_cmp_ge_u32 %[n0], 16\n\ts_cselect_b32 %[T1], %[c1], %[T1]\n\ts_cmp_eq_u32 %[n0], 16\n\ts_cselect_b32 %[n1], 2, 0\n\ts_or_b32 %[d], %[d], %[n1]\n\ts_cmp_eq_u32 %[d], 3\n\ts_cbranch_scc1 2f\n\ts_lshr_b32 %[bm], %[bm], 1\n\ts_cmp_lg_u32 %[bm], 0\n\ts_cbranch_scc1 1b\n2:\n"
                 : [T0] "=&s"(T0), [T1] "=&s"(T1), [c0] "=&s"(cc0), [c1] "=&s"(cc1), [bm] "=&s"(bm), [d] "=&s"(dd), [n0] "=&s"(n0), [n1] "=&s"(n1), [m00] "=&s"(m00), [m01] "=&s"(m01), [m02] "=&s"(m02), [m03] "=&s"(m03), [m10] "=&s"(m10), [m11] "=&s"(m11), [m12] "=&s"(m12), [m13] "=&s"(m13)
                 : [u00] "v"(u00), [u01] "v"(u01), [u02] "v"(u02), [u03] "v"(u03), [u10] "v"(u10), [u11] "v"(u11), [u12] "v"(u12), [u13] "v"(u13) : "scc");
    o0 = T0; o1 = T1;
}
template <int NV> DI void compact16(const unsigned (&u)[NV], unsigned T, int lane, LAS float* dstv, LAS int* dsti) {
    int base = 0;
#pragma unroll
    for (int r = 0; r < NV; ++r) { const bool sel = u[r] >= T; const unsigned long long m = __ballot(sel);
        const int rank = base + (int)__builtin_amdgcn_mbcnt_hi((unsigned)(m >> 32), __builtin_amdgcn_mbcnt_lo((unsigned)m, 0u));
        if (sel && rank < 16) { dstv[rank] = fkey_inv(u[r]); dsti[rank] = lane + 64 * r; }
        base += __builtin_popcountll(m); }
}
DI float row16_max(float x) {
    x = fmaxf(x, __builtin_bit_cast(float, __builtin_amdgcn_update_dpp(0, __builtin_bit_cast(int, x), 0x128, 0xf, 0xf, false)));
    x = fmaxf(x, __builtin_bit_cast(float, __builtin_amdgcn_update_dpp(0, __builtin_bit_cast(int, x), 0x124, 0xf, 0xf, false)));
    x = fmaxf(x, __builtin_bit_cast(float, __builtin_amdgcn_update_dpp(0, __builtin_bit_cast(int, x), 0x122, 0xf, 0xf, false)));
    x = fmaxf(x, __builtin_bit_cast(float, __builtin_amdgcn_update_dpp(0, __builtin_bit_cast(int, x), 0x121, 0xf, 0xf, false)));
    return x;
}
DI void topk_item(int item, const bf16* PQ, const bf16* KEYB, int* IDX, float* GATE, LAS float* S, LAS float* wscr, int wave, int lane) {
    const int fr = lane & 15, fq = lane >> 4, tt = item >> 3, h = item & 7, p = wave >> 2, r0 = (wave & 3) * 16, t0 = tt * 64;
    bf16x8 af[4];
#pragma unroll
    for (int ks = 0; ks < 4; ++ks) af[ks] = *(const bf16x8*)(PQ + (size_t)(t0 + r0 + fr) * 2048 + h * 256 + p * 128 + ks * 32 + fq * 8);
    const bf16* kb = KEYB + ((size_t)(h * 2 + p) * 128) * 128;
#pragma unroll
    for (int nb = 0; nb < 8; ++nb) { f32x4 acc = (f32x4){0.f, 0.f, 0.f, 0.f};
#pragma unroll
        for (int ks = 0; ks < 4; ++ks) { const bf16x8 bfr = *(const bf16x8*)(kb + (size_t)(nb * 16 + fr) * 128 + ks * 32 + fq * 8); acc = __builtin_amdgcn_mfma_f32_16x16x32_bf16(af[ks], bfr, acc, 0, 0, 0); }
#pragma unroll
        for (int j = 0; j < 4; ++j) S[(r0 + 4 * fq + j) * 256 + p * 128 + nb * 16 + fr] = acc[j]; }
    __syncthreads();
    LAS float* v0s = wscr; LAS int* i0s = (LAS int*)(wscr + 16); LAS float* v1s = wscr + 32; LAS int* i1s = (LAS int*)(wscr + 48); LAS float* vfs = wscr + 64; LAS int* ifs = (LAS int*)(wscr + 80);
    for (int q = 0; q < 8; q += 2) { const int tl = wave * 8 + q; const LAS float* sr = S + tl * 256;
        const unsigned ua[2] = {fkey(sr[lane]), fkey(sr[lane + 64])}, ub[2] = {fkey(sr[128 + lane]), fkey(sr[192 + lane])};
        const unsigned uc[2] = {fkey(sr[256 + lane]), fkey(sr[256 + lane + 64])}, ud[2] = {fkey(sr[256 + 128 + lane]), fkey(sr[256 + 192 + lane])};
        unsigned Ta, Tb, Tc, Td; radix_thr16_4x2(ua[0], ua[1], ub[0], ub[1], uc[0], uc[1], ud[0], ud[1], Ta, Tb, Tc, Td);
        compact16<2>(ua, Ta, lane, v0s, i0s); compact16<2>(ub, Tb, lane, v1s, i1s); compact16<2>(uc, Tc, lane, v0s + 96, i0s + 96); compact16<2>(ud, Td, lane, v1s + 96, i1s + 96);
        unsigned c0[4], c1[4]; const float s1a = v1s[lane & 15], s1b = v1s[96 + (lane & 15)];
#pragma unroll
        for (int r = 0; r < 4; ++r) { c0[r] = fkey(v0s[(lane >> 4) + 4 * r] + s1a); c1[r] = fkey(v0s[96 + (lane >> 4) + 4 * r] + s1b); }
        unsigned Tf0, Tf1; radix_thr16_2x4(c0[0], c0[1], c0[2], c0[3], c1[0], c1[1], c1[2], c1[3], Tf0, Tf1);
        compact16<4>(c0, Tf0, lane, vfs, ifs); compact16<4>(c1, Tf1, lane, vfs + 96, ifs + 96);
#pragma unroll
        for (int tk = 0; tk < 2; ++tk) {
            const float bs = vfs[96 * tk + (lane & 15)]; const int pos = ifs[96 * tk + (lane & 15)];
            const int e = i0s[96 * tk + ((pos >> 4) & 15)] * 128 + i1s[96 * tk + (pos & 15)];
            const float ex = __expf(bs - row16_max(bs)), sum = row16_sum(ex);
            if (lane < 16) { const size_t o = (size_t)(t0 + tl + tk) * 128 + h * 16 + lane; IDX[o] = e; GATE[o] = ex / sum; } }
    }
    __syncthreads();
}


#define TK_CHAIN(Lst, k) do { _Pragma("unroll") for (int _s = 0; _s < 16; ++_s) { const unsigned _t = Lst[_s] > (k) ? Lst[_s] : (k); (k) = Lst[_s] > (k) ? (k) : Lst[_s]; Lst[_s] = _t; } } while (0)
DI void topk_item2(int item, const bf16* PQ, const bf16* KEYB, int* IDX, float* GATE, LAS unsigned* S, LAS unsigned* T, int tid, int wave, int lane) {
    const int fr = lane & 15, fq = lane >> 4, tile = item >> 1, hg = item & 1, t0 = tile * 32, hl = wave >> 1, p = wave & 1, h = hg * 4 + hl;
    {
        bf16x8 af[2][4];
#pragma unroll
        for (int rb = 0; rb < 2; ++rb)
#pragma unroll
            for (int ks = 0; ks < 4; ++ks) af[rb][ks] = *(const bf16x8*)(PQ + (size_t)(t0 + rb * 16 + fr) * 2048 + h * 256 + p * 128 + ks * 32 + fq * 8);
        const bf16* kb = KEYB + ((size_t)(h * 2 + p) * 128) * 128;
#pragma unroll
        for (int nb = 0; nb < 8; ++nb) { bf16x8 bfr[4];
#pragma unroll
            for (int ks = 0; ks < 4; ++ks) bfr[ks] = *(const bf16x8*)(kb + (size_t)(nb * 16 + fr) * 128 + ks * 32 + fq * 8);
#pragma unroll
            for (int rb = 0; rb < 2; ++rb) { f32x4 acc = (f32x4){0.f, 0.f, 0.f, 0.f};
#pragma unroll
                for (int ks = 0; ks < 4; ++ks) acc = __builtin_amdgcn_mfma_f32_16x16x32_bf16(af[rb][ks], bfr[ks], acc, 0, 0, 0);
#pragma unroll
                for (int j = 0; j < 4; ++j) { const int set = (hl * 2 + p) * 32 + rb * 16 + 4 * fq + j, n = nb * 16 + fr;
                    S[set * 128 + (n ^ (set & 31))] = (fkey(acc[j]) & 0xFFFFFF80u) | (unsigned)(127 - n); } } }
    }
    __syncthreads();
    {
        const int set = tid >> 1, c2 = tid & 1; const LAS unsigned* sp = S + set * 128; const int sw = set & 31;
        unsigned Lst[16];
#pragma unroll
        for (int i = 0; i < 16; ++i) Lst[i] = 0u;
#pragma unroll 2
        for (int i = 0; i < 64; ++i) { unsigned k = sp[(c2 * 64 + i) ^ sw]; TK_CHAIN(Lst, k); }
        unsigned C[16];
#pragma unroll
        for (int i = 0; i < 16; ++i) { const unsigned pr = (unsigned)__builtin_amdgcn_update_dpp(0, (int)Lst[15 - i], 0xB1, 0xf, 0xf, false); C[i] = Lst[i] > pr ? Lst[i] : pr; }
#pragma unroll
        for (int st = 8; st >= 1; st >>= 1)
#pragma unroll
            for (int i = 0; i < 16; ++i) if ((i & st) == 0) { const unsigned a = C[i] > C[i + st] ? C[i] : C[i + st], b = C[i] > C[i + st] ? C[i + st] : C[i]; C[i] = a; C[i + st] = b; }
        if (c2 == 0) {
#pragma unroll
            for (int i = 0; i < 4; ++i) { u32x4 w; w.x = C[4 * i]; w.y = C[4 * i + 1]; w.z = C[4 * i + 2]; w.w = C[4 * i + 3]; *(LAS u32x4*)(T + set * 16 + 4 * i) = w; } }
    }
    __syncthreads();
    if (tid < 128) {
        const int tok = tid & 31, hl2 = tid >> 5, set0 = (hl2 * 2) * 32 + tok, set1 = set0 + 32;
        float s0[16], s1[16];
#pragma unroll
        for (int i = 0; i < 4; ++i) { const u32x4 a = *(const LAS u32x4*)(T + set0 * 16 + 4 * i), b = *(const LAS u32x4*)(T + set1 * 16 + 4 * i);
            s0[4 * i] = fkey_inv(a.x & 0xFFFFFF80u); s0[4 * i + 1] = fkey_inv(a.y & 0xFFFFFF80u); s0[4 * i + 2] = fkey_inv(a.z & 0xFFFFFF80u); s0[4 * i + 3] = fkey_inv(a.w & 0xFFFFFF80u);
            s1[4 * i] = fkey_inv(b.x & 0xFFFFFF80u); s1[4 * i + 1] = fkey_inv(b.y & 0xFFFFFF80u); s1[4 * i + 2] = fkey_inv(b.z & 0xFFFFFF80u); s1[4 * i + 3] = fkey_inv(b.w & 0xFFFFFF80u); }
        unsigned L2[16];
#pragma unroll
        for (int i = 0; i < 16; ++i) L2[i] = 0u;
#define TK_INS2(i, j) do { unsigned _k = (fkey(s0[i] + s1[j]) & 0xFFFFFF00u) | (unsigned)((i) * 16 + (j)); TK_CHAIN(L2, _k); } while (0)
        TK_INS2(0, 0);
        TK_INS2(0, 1);
        TK_INS2(0, 2);
        TK_INS2(0, 3);
        TK_INS2(0, 4);
        TK_INS2(0, 5);
        TK_INS2(0, 6);
        TK_INS2(0, 7);
        TK_INS2(0, 8);
        TK_INS2(0, 9);
        TK_INS2(0, 10);
        TK_INS2(0, 11);
        TK_INS2(0, 12);
        TK_INS2(0, 13);
        TK_INS2(0, 14);
        TK_INS2(0, 15);
        TK_INS2(1, 0);
        TK_INS2(1, 1);
        TK_INS2(1, 2);
        TK_INS2(1, 3);
        TK_INS2(1, 4);
        TK_INS2(1, 5);
        TK_INS2(1, 6);
        TK_INS2(1, 7);
        TK_INS2(2, 0);
        TK_INS2(2, 1);
        TK_INS2(2, 2);
        TK_INS2(2, 3);
        TK_INS2(2, 4);
        TK_INS2(3, 0);
        TK_INS2(3, 1);
        TK_INS2(3, 2);
        TK_INS2(3, 3);
        TK_INS2(4, 0);
        TK_INS2(4, 1);
        TK_INS2(4, 2);
        TK_INS2(5, 0);
        TK_INS2(5, 1);
        TK_INS2(6, 0);
        TK_INS2(6, 1);
        TK_INS2(7, 0);
        TK_INS2(7, 1);
        TK_INS2(8, 0);
        TK_INS2(9, 0);
        TK_INS2(10, 0);
        TK_INS2(11, 0);
        TK_INS2(12, 0);
        TK_INS2(13, 0);
        TK_INS2(14, 0);
        TK_INS2(15, 0);
#undef TK_INS2
        float ex[16]; float tot = 0.f; const float mx = fkey_inv(L2[0] & 0xFFFFFF00u);
#pragma unroll
        for (int r = 0; r < 16; ++r) { ex[r] = __expf(fkey_inv(L2[r] & 0xFFFFFF00u) - mx); tot += ex[r]; }
        const float inv = 1.0f / tot; const size_t o = (size_t)(t0 + tok) * 128 + (hg * 4 + hl2) * 16;
#pragma unroll
        for (int r4 = 0; r4 < 4; ++r4) { int ev[4]; f32x4 gv;
#pragma unroll
            for (int q = 0; q < 4; ++q) { const unsigned code = L2[4 * r4 + q] & 0xFFu; const int i = code >> 4, j = code & 15;
                ev[q] = (127 - (int)(T[set0 * 16 + i] & 0x7Fu)) * 128 + (127 - (int)(T[set1 * 16 + j] & 0x7Fu)); gv[q] = ex[4 * r4 + q] * inv; }
            *(u32x4*)(IDX + o + 4 * r4) = (u32x4){(unsigned)ev[0], (unsigned)ev[1], (unsigned)ev[2], (unsigned)ev[3]}; *(f32x4*)(GATE + o + 4 * r4) = gv; }
    }
    __syncthreads();
}

DI f32x2 dot32_fp4(const u32x4 w, const f32x4 (&x)[8], f32x2 c) {
    const unsigned ww[4] = {w.x, w.y, w.z, w.w};
#pragma unroll
    for (int i = 0; i < 4; ++i) {
        c = __builtin_elementwise_fma(__builtin_amdgcn_cvt_scalef32_pk_f32_fp4(ww[i], 1.0f, 0), x[2 * i].lo, c); c = __builtin_elementwise_fma(__builtin_amdgcn_cvt_scalef32_pk_f32_fp4(ww[i], 1.0f, 1), x[2 * i].hi, c);
        c = __builtin_elementwise_fma(__builtin_amdgcn_cvt_scalef32_pk_f32_fp4(ww[i], 1.0f, 2), x[2 * i + 1].lo, c); c = __builtin_elementwise_fma(__builtin_amdgcn_cvt_scalef32_pk_f32_fp4(ww[i], 1.0f, 3), x[2 * i + 1].hi, c); }
    return c;
}
DI void axpy32_fp4(const u32x4 w, float a, f32x4 (&y)[8]) {
    const unsigned ww[4] = {w.x, w.y, w.z, w.w}; const f32x2 aa = {a, a};
#pragma unroll
    for (int i = 0; i < 4; ++i) {
        y[2 * i].lo = __builtin_elementwise_fma(aa, __builtin_amdgcn_cvt_scalef32_pk_f32_fp4(ww[i], 1.0f, 0), y[2 * i].lo); y[2 * i].hi = __builtin_elementwise_fma(aa, __builtin_amdgcn_cvt_scalef32_pk_f32_fp4(ww[i], 1.0f, 1), y[2 * i].hi);
        y[2 * i + 1].lo = __builtin_elementwise_fma(aa, __builtin_amdgcn_cvt_scalef32_pk_f32_fp4(ww[i], 1.0f, 2), y[2 * i + 1].lo); y[2 * i + 1].hi = __builtin_elementwise_fma(aa, __builtin_amdgcn_cvt_scalef32_pk_f32_fp4(ww[i], 1.0f, 3), y[2 * i + 1].hi); }
}
template <bool COOP> DI void peer_token(int t, const bf16* X1Bp, const int* IDX, const float* GATE, const unsigned char* PU4, const float* SCU_, const unsigned char* PV4, const float* SCV_,
                   const float* g2, const float* b2, float* outf, bf16* outb, unsigned char* outb8, float* dbg, int lane, int q4 = 0, LAS f32x4* part = nullptr) {
    const int kbeg = COOP ? 32 * q4 : 0, kend = COOP ? 32 * q4 + 32 : 128;
    const u32x4* xr = (const u32x4*)(X1Bp + (size_t)t * D);
    const int id0 = IDX[(size_t)t * 128 + lane], id1 = IDX[(size_t)t * 128 + 64 + lane];
    const float gt0 = GATE[(size_t)t * 128 + lane], gt1 = GATE[(size_t)t * 128 + 64 + lane];
    float a0 = 0.f, a1 = 0.f;
    {
        f32x4 x[2][8];
#pragma unroll
        for (int p = 0; p < 2; ++p)
#pragma unroll
            for (int i = 0; i < 4; ++i) { const u32x4 r = xr[(p * 64 + lane) * 4 + i]; x[p][2 * i] = (f32x4){bflo(r.x), bfhi(r.x), bflo(r.y), bfhi(r.y)}; x[p][2 * i + 1] = (f32x4){bflo(r.z), bfhi(r.z), bflo(r.w), bfhi(r.w)}; }
#pragma unroll 1
        for (int k0 = kbeg; k0 < kend; k0 += 8) {
            u32x4 w[8][2]; float su[8];
#pragma unroll
            for (int q = 0; q < 8; ++q) { const int k = k0 + q; const int e = __builtin_amdgcn_readlane(k0 < 64 ? id0 : id1, k & 63); su[q] = SCU_[e];
                const u32x4* row = (const u32x4*)(PU4 + (size_t)e * (D / 2));
                w[q][0] = row[lane]; w[q][1] = row[64 + lane]; }
#pragma unroll
            for (int q = 0; q < 8; ++q) { const int k = k0 + q; f32x2 d2 = {0.f, 0.f};
                d2 = dot32_fp4(w[q][0], x[0], d2); d2 = dot32_fp4(w[q][1], x[1], d2);
                const float d = wave_sum(d2.x + d2.y) * su[q];
                const float gate = __uint_as_float(__builtin_amdgcn_readlane(__float_as_uint(k0 < 64 ? gt0 : gt1), k & 63));
                const float a = gate * gelu_tanh(d);
                if (k0 < 64) { if (lane == (k & 63)) a0 = a; } else { if (lane == (k & 63)) a1 = a; } }
        }
    }
    if (dbg) { dbg[(size_t)t * 128 + lane] = a0; dbg[(size_t)t * 128 + 64 + lane] = a1; }
    f32x4 y[2][8];
#pragma unroll
    for (int p = 0; p < 2; ++p)
#pragma unroll
        for (int i = 0; i < 8; ++i) y[p][i] = (f32x4){0.f, 0.f, 0.f, 0.f};
#pragma unroll 1
    for (int k0 = kbeg; k0 < kend; k0 += 8) {
        u32x4 w[8][2]; float a[8];
#pragma unroll
        for (int q = 0; q < 8; ++q) { const int k = k0 + q; const int e = __builtin_amdgcn_readlane(k0 < 64 ? id0 : id1, k & 63);
            a[q] = __uint_as_float(__builtin_amdgcn_readlane(__float_as_uint(k0 < 64 ? a0 : a1), k & 63)) * SCV_[e];
            const u32x4* row = (const u32x4*)(PV4 + (size_t)e * (D / 2));
            w[q][0] = row[lane]; w[q][1] = row[64 + lane]; }
#pragma unroll
        for (int q = 0; q < 8; ++q) { axpy32_fp4(w[q][0], a[q], y[0]); axpy32_fp4(w[q][1], a[q], y[1]); }
    }
    asm volatile("" : "+v"(lane));
    if (COOP) {
        if (q4 != 0) {
#pragma unroll
            for (int p = 0; p < 2; ++p)
#pragma unroll
                for (int i = 0; i < 8; ++i) part[(q4 * 16 + p * 8 + i) * 64 + lane] = y[p][i]; }
        __syncthreads();
        if (q4 == 0) {
#pragma unroll
            for (int qq = 1; qq < 4; ++qq)
#pragma unroll
                for (int p = 0; p < 2; ++p)
#pragma unroll
                    for (int i = 0; i < 8; ++i) y[p][i] = y[p][i] + part[(qq * 16 + p * 8 + i) * 64 + lane]; }
        __syncthreads();
        if (q4 != 0) return;
    }
    float s = 0.f;
#pragma unroll
    for (int p = 0; p < 2; ++p)
#pragma unroll
        for (int i = 0; i < 4; ++i) { const u32x4 r = xr[(p * 64 + lane) * 4 + i]; const f32x4 xa = (f32x4){bflo(r.x), bfhi(r.x), bflo(r.y), bfhi(r.y)}, xb2 = (f32x4){bflo(r.z), bfhi(r.z), bflo(r.w), bfhi(r.w)};
            y[p][2 * i] = xa * ALPHA + y[p][2 * i]; y[p][2 * i + 1] = xb2 * ALPHA + y[p][2 * i + 1];
            s += ((y[p][2 * i][0] + y[p][2 * i][1]) + (y[p][2 * i][2] + y[p][2 * i][3])) + ((y[p][2 * i + 1][0] + y[p][2 * i + 1][1]) + (y[p][2 * i + 1][2] + y[p][2 * i + 1][3])); }
    const float mean = wave_sum(s) * (1.0f / D); float q = 0.f;
#pragma unroll
    for (int p = 0; p < 2; ++p)
#pragma unroll
        for (int i = 0; i < 8; ++i) { y[p][i] = y[p][i] - mean; q += (y[p][i][0] * y[p][i][0] + y[p][i][1] * y[p][i][1]) + (y[p][i][2] * y[p][i][2] + y[p][i][3] * y[p][i][3]); }
    const float rstd = __builtin_amdgcn_rsqf(wave_sum(q) * (1.0f / D) + LN_EPS);
#pragma unroll
    for (int p = 0; p < 2; ++p)
#pragma unroll
        for (int i2 = 0; i2 < 4; ++i2) { f32x4 o[2];
#pragma unroll
            for (int hh = 0; hh < 2; ++hh) { const int ci = (p * 64 + lane) * 8 + 2 * i2 + hh; o[hh] = y[p][2 * i2 + hh] * rstd * ((const f32x4*)g2)[ci] + ((const f32x4*)b2)[ci]; if (outf) ((f32x4*)outf)[ci] = o[hh]; }
            if (outb) { u32x4 w0; w0.x = pk2(o[0][0], o[0][1]); w0.y = pk2(o[0][2], o[0][3]); w0.z = pk2(o[1][0], o[1][1]); w0.w = pk2(o[1][2], o[1][3]); ((u32x4*)outb)[(p * 64 + lane) * 4 + i2] = w0;
                u32x2 w8; w8.x = pk4_fp8(o[0][0] * XB_SCALE, o[0][1] * XB_SCALE, o[0][2] * XB_SCALE, o[0][3] * XB_SCALE); w8.y = pk4_fp8(o[1][0] * XB_SCALE, o[1][1] * XB_SCALE, o[1][2] * XB_SCALE, o[1][3] * XB_SCALE); ((u32x2*)outb8)[(p * 64 + lane) * 4 + i2] = w8; } }
}

typedef _Float16 h2_t __attribute__((ext_vector_type(2)));
#define H2C(x) __builtin_bit_cast(h2_t, (x))
DI h2_t dot32_fp4_h(const u32x4 w, const h2_t (&x)[16], h2_t c) {
    unsigned ww[4] = {w.x, w.y, w.z, w.w};
#pragma unroll
    for (int i = 0; i < 4; ++i) {
        c = __builtin_elementwise_fma(H2C(__builtin_amdgcn_cvt_scalef32_pk_f16_fp4(ww[i], 1.0f, 0)), x[4 * i], c); c = __builtin_elementwise_fma(H2C(__builtin_amdgcn_cvt_scalef32_pk_f16_fp4(ww[i], 1.0f, 1)), x[4 * i + 1], c);
        c = __builtin_elementwise_fma(H2C(__builtin_amdgcn_cvt_scalef32_pk_f16_fp4(ww[i], 1.0f, 2)), x[4 * i + 2], c); c = __builtin_elementwise_fma(H2C(__builtin_amdgcn_cvt_scalef32_pk_f16_fp4(ww[i], 1.0f, 3)), x[4 * i + 3], c); }
    return c;
}
DI void axpy32_fp4_h(const u32x4 w, h2_t aa, h2_t (&y)[16]) {
    unsigned ww[4] = {w.x, w.y, w.z, w.w};
#pragma unroll
    for (int i = 0; i < 4; ++i) {
        y[4 * i] = __builtin_elementwise_fma(aa, H2C(__builtin_amdgcn_cvt_scalef32_pk_f16_fp4(ww[i], 1.0f, 0)), y[4 * i]); y[4 * i + 1] = __builtin_elementwise_fma(aa, H2C(__builtin_amdgcn_cvt_scalef32_pk_f16_fp4(ww[i], 1.0f, 1)), y[4 * i + 1]);
        y[4 * i + 2] = __builtin_elementwise_fma(aa, H2C(__builtin_amdgcn_cvt_scalef32_pk_f16_fp4(ww[i], 1.0f, 2)), y[4 * i + 2]); y[4 * i + 3] = __builtin_elementwise_fma(aa, H2C(__builtin_amdgcn_cvt_scalef32_pk_f16_fp4(ww[i], 1.0f, 3)), y[4 * i + 3]); }
}
constexpr int NSUB = 16;
constexpr size_t SUB_BYTES = (size_t)NEXP * 128;
DI float oct_sum(float x) {
    x += __builtin_bit_cast(float, __builtin_amdgcn_update_dpp(0, __builtin_bit_cast(int, x), 0xB1, 0xf, 0xf, false));
    x += __builtin_bit_cast(float, __builtin_amdgcn_update_dpp(0, __builtin_bit_cast(int, x), 0x4E, 0xf, 0xf, false));
    x += __builtin_bit_cast(float, __builtin_amdgcn_update_dpp(0, __builtin_bit_cast(int, x), 0x141, 0xf, 0xf, false));
    return x;
}
DI void peer_u_slice(int t, int sub, const bf16* X1Bp, const int* IDX, const unsigned char* PU4s, float* PACTs, int lane) {
    asm volatile("" : "+v"(lane));
    const int c8 = lane & 7, r8 = lane >> 3;
    const u32x4* xr = (const u32x4*)(X1Bp + (size_t)t * D + sub * 256 + c8 * 32);
    const pg8::v4i* ip = (const pg8::v4i*)(IDX + (size_t)t * 128 + r8 * 16);
    pg8::v4i e4[4];
#pragma unroll
    for (int i = 0; i < 4; ++i) e4[i] = ip[i];
    f32x4 x[8];
#pragma unroll
    for (int i = 0; i < 4; ++i) { const u32x4 r = xr[i]; x[2 * i] = (f32x4){bflo(r.x), bfhi(r.x), bflo(r.y), bfhi(r.y)}; x[2 * i + 1] = (f32x4){bflo(r.z), bfhi(r.z), bflo(r.w), bfhi(r.w)}; }
    u32x4 w[16];
#pragma unroll
    for (int j = 0; j < 16; ++j) w[j] = *(const u32x4*)(PU4s + ((unsigned)e4[j >> 2][j & 3] * 128u + (unsigned)c8 * 16u));
    float res[16];
#pragma unroll
    for (int j = 0; j < 16; ++j) { const f32x2 d2 = dot32_fp4(w[j], x, (f32x2){0.f, 0.f}); res[j] = oct_sum(d2.x + d2.y); }
    if (c8 == 0) { f32x4* o = (f32x4*)(PACTs + (size_t)t * 128 + r8 * 16);
#pragma unroll
        for (int i = 0; i < 4; ++i) o[i] = (f32x4){res[4 * i], res[4 * i + 1], res[4 * i + 2], res[4 * i + 3]}; }
}
DI void peer_a_token(int t, const int* IDX, const float* GATE, const float* PACT, const float* SCU_, const float* SCV_, float* AV, int lane) {
    asm volatile("" : "+v"(lane));
#pragma unroll
    for (int h = 0; h < 2; ++h) { const int k = h * 64 + lane; const int e = IDX[(size_t)t * 128 + k]; float sum = 0.f;
#pragma unroll
        for (int sub = 0; sub < NSUB; ++sub) sum += PACT[((size_t)sub * M + t) * 128 + k];
        AV[(size_t)t * 128 + k] = GATE[(size_t)t * 128 + k] * gelu_tanh(sum * SCU_[e]) * SCV_[e]; }
}
DI void peer_v_slice(int t, int sub, const bf16* X1Bp, const int* IDX, const float* AV, const unsigned char* PV4s, bf16* ZBp, float* STATs, LAS f32x4* red, int lane) {
    asm volatile("" : "+v"(lane));
    const int c8 = lane & 7, r8 = lane >> 3;
    const pg8::v4i* ip = (const pg8::v4i*)(IDX + (size_t)t * 128 + r8 * 16);
    const f32x4* ap = (const f32x4*)(AV + (size_t)t * 128 + r8 * 16);
    const int col = sub * 256 + 32 * (lane & 7) + 4 * (lane >> 3);
    const u32x2 xv = *(const u32x2*)(X1Bp + (size_t)t * D + col);
    f32x4 y[8];
#pragma unroll
    for (int i = 0; i < 8; ++i) y[i] = (f32x4){0.f, 0.f, 0.f, 0.f};
#pragma unroll 1
    for (int b = 0; b < 2; ++b) {
        pg8::v4i e4[2]; f32x4 a4[2];
#pragma unroll
        for (int i = 0; i < 2; ++i) { e4[i] = ip[2 * b + i]; a4[i] = ap[2 * b + i]; }
        u32x4 w[8];
#pragma unroll
        for (int j = 0; j < 8; ++j) w[j] = *(const u32x4*)(PV4s + ((unsigned)e4[j >> 2][j & 3] * 128u + (unsigned)c8 * 16u));
#pragma unroll
        for (int j = 0; j < 8; ++j) axpy32_fp4(w[j], a4[j >> 2][j & 3], y);
    }
#pragma unroll
    for (int q = 0; q < 8; ++q) red[r8 * 72 + q * 8 + c8] = y[q];
    asm volatile("s_waitcnt lgkmcnt(0)" ::: "memory");
    f32x4 z = red[lane];
#pragma unroll
    for (int r = 1; r < 8; ++r) z = z + red[r * 72 + lane];
    asm volatile("s_waitcnt lgkmcnt(0)" ::: "memory");
    z = (f32x4){bflo(xv.x), bfhi(xv.x), bflo(xv.y), bfhi(xv.y)} * ALPHA + z;
    const float s1 = wave_sum((z[0] + z[1]) + (z[2] + z[3])), s2 = wave_sum((z[0] * z[0] + z[1] * z[1]) + (z[2] * z[2] + z[3] * z[3]));
    u32x2 o; o.x = pk2(z[0], z[1]); o.y = pk2(z[2], z[3]); *(u32x2*)(ZBp + (size_t)t * D + col) = o;
    if (lane == 0) *(f32x2*)(STATs + (size_t)t * 2) = (f32x2){s1, s2};
}
#define PEER_HCL(h) ((h) < nh ? (h) : nh - 1)
#define PEER_HOFF(h) ((size_t)(wx + (PEER_HCL(h) >> 1) * nwx) * 128 + (PEER_HCL(h) & 1) * 8)
#define PEER_MEMFENCE() asm volatile("" ::: "memory")
DI void peer_u_pass(int sub, int wx, int nwx, const bf16* X1Bp, const int* IDX, const unsigned char* PU4s, float* PACTs, int lane, int emask = 0x3fff) {
    asm volatile("" : "+v"(lane));
    if (wx >= M) return;
    const int c8 = lane & 7, r8 = lane >> 3; const unsigned lo = (unsigned)c8 * 16u;
    const int* ibase = IDX + r8 * 16; const bf16* xbase = X1Bp + sub * 256 + c8 * 32;
    pg8::v4i eA[2], eB[2]; u32x4 xraw[4], wA[8], wB[8]; h2_t x[16];
    { const pg8::v4i* ip = (const pg8::v4i*)(ibase + (size_t)wx * 128); eA[0] = ip[0]; eA[1] = ip[1]; eB[0] = ip[2]; eB[1] = ip[3];
#pragma unroll
      for (int i = 0; i < 4; ++i) xraw[i] = ((const u32x4*)(xbase + (size_t)wx * D))[i];
#pragma unroll
      for (int j = 0; j < 8; ++j) wA[j] = *(const u32x4*)(PU4s + ((unsigned)(eA[j >> 2][j & 3] & emask) * 128u + lo)); }
#pragma unroll 1
    for (int t = wx; t < M; t += nwx) {
        const int tn = (t + nwx < M) ? t + nwx : t;
#pragma unroll
        for (int j = 0; j < 8; ++j) wB[j] = *(const u32x4*)(PU4s + ((unsigned)(eB[j >> 2][j & 3] & emask) * 128u + lo));
#pragma unroll
        for (int i = 0; i < 4; ++i) { const u32x4 r = xraw[i]; x[4 * i] = H2C(__builtin_amdgcn_cvt_pkrtz(bflo(r.x), bfhi(r.x))); x[4 * i + 1] = H2C(__builtin_amdgcn_cvt_pkrtz(bflo(r.y), bfhi(r.y))); x[4 * i + 2] = H2C(__builtin_amdgcn_cvt_pkrtz(bflo(r.z), bfhi(r.z))); x[4 * i + 3] = H2C(__builtin_amdgcn_cvt_pkrtz(bflo(r.w), bfhi(r.w))); }
        PEER_MEMFENCE();
        { const pg8::v4i* ip = (const pg8::v4i*)(ibase + (size_t)tn * 128); eA[0] = ip[0]; eA[1] = ip[1]; eB[0] = ip[2]; eB[1] = ip[3];
#pragma unroll
          for (int i = 0; i < 4; ++i) xraw[i] = ((const u32x4*)(xbase + (size_t)tn * D))[i]; }
        PEER_MEMFENCE();
        float res[16];
#pragma unroll
        for (int j = 0; j < 8; ++j) { const h2_t d2 = dot32_fp4_h(wA[j], x, (h2_t){(_Float16)0.f, (_Float16)0.f}); res[j] = oct_sum((float)d2.x + (float)d2.y); }
        PEER_MEMFENCE();
#pragma unroll
        for (int j = 0; j < 8; ++j) wA[j] = *(const u32x4*)(PU4s + ((unsigned)(eA[j >> 2][j & 3] & emask) * 128u + lo));
        PEER_MEMFENCE();
#pragma unroll
        for (int j = 0; j < 8; ++j) { const h2_t d2 = dot32_fp4_h(wB[j], x, (h2_t){(_Float16)0.f, (_Float16)0.f}); res[8 + j] = oct_sum((float)d2.x + (float)d2.y); }
        if (c8 == 0) { f32x4* o = (f32x4*)(PACTs + (size_t)t * 128 + r8 * 16);
#pragma unroll
            for (int i = 0; i < 4; ++i) o[i] = (f32x4){res[4 * i], res[4 * i + 1], res[4 * i + 2], res[4 * i + 3]}; }
    }
}
#define PEER_HOFF4(h) ((size_t)(wx + (PEER_HCL(h) >> 1) * nwx) * 128 + (PEER_HCL(h) & 1) * 4)
DI void peer_u_pass_mfma(int sub, int wx, int nwx, const unsigned char* X18p, const int* IDX, const unsigned char* PU4s, float* PACTs, int lane, int emask = 0x3fff) {
    asm volatile("" : "+v"(lane));
    if (wx >= M) return;
    const int i16 = lane & 15, kg = lane >> 4; const unsigned lo = (unsigned)kg * 16u;
    const int ntok = (M - wx + nwx - 1) / nwx, nh = 2 * ntok;
    const int* ibase = IDX + i16 * 8; const unsigned char* xbase = X18p + sub * 256 + kg * 16;
    pg8::v4i en; u32x4 a[8], braw[4], bc[4];
    { const pg8::v4i ec = *(const pg8::v4i*)(ibase + PEER_HOFF4(0)); en = *(const pg8::v4i*)(ibase + PEER_HOFF4(1));
#pragma unroll
      for (int ks = 0; ks < 2; ++ks) { braw[2 * ks] = *(const u32x4*)(xbase + (size_t)wx * D + ks * 128); braw[2 * ks + 1] = *(const u32x4*)(xbase + (size_t)wx * D + ks * 128 + 64); }
#pragma unroll
      for (int g = 0; g < 4; ++g)
#pragma unroll
          for (int ks = 0; ks < 2; ++ks) a[g * 2 + ks] = *(const u32x4*)(PU4s + ((unsigned)(ec[g] & emask) * 128u + (unsigned)ks * 64u + lo)); }
#pragma unroll
    for (int i = 0; i < 4; ++i) bc[i] = (u32x4){0u, 0u, 0u, 0u};
#pragma unroll 1
    for (int h = 0; h < nh; ++h) {
        const int t = wx + (h >> 1) * nwx;
        u32x4 an[8];
#pragma unroll
        for (int g = 0; g < 4; ++g)
#pragma unroll
            for (int ks = 0; ks < 2; ++ks) an[g * 2 + ks] = *(const u32x4*)(PU4s + ((unsigned)(en[g] & emask) * 128u + (unsigned)ks * 64u + lo));
        const pg8::v4i e2 = *(const pg8::v4i*)(ibase + PEER_HOFF4(h + 2));
        if ((h & 1) == 0) {
#pragma unroll
            for (int i = 0; i < 4; ++i) bc[i] = braw[i];
            const int tn = (h + 2 < nh) ? t + nwx : t;
#pragma unroll
            for (int ks = 0; ks < 2; ++ks) { braw[2 * ks] = *(const u32x4*)(xbase + (size_t)tn * D + ks * 128); braw[2 * ks + 1] = *(const u32x4*)(xbase + (size_t)tn * D + ks * 128 + 64); } }
        f32x4 acc[4];
#pragma unroll
        for (int g = 0; g < 4; ++g) { acc[g] = (f32x4){0.f, 0.f, 0.f, 0.f};
#pragma unroll
            for (int ks = 0; ks < 2; ++ks) { const u32x4 av = a[g * 2 + ks]; const pg8::v8i a8 = {(int)av.x, (int)av.y, (int)av.z, (int)av.w, 0, 0, 0, 0};
                const u32x4 b0 = bc[2 * ks], b1 = bc[2 * ks + 1]; const pg8::v8i b8 = {(int)b0.x, (int)b0.y, (int)b0.z, (int)b0.w, (int)b1.x, (int)b1.y, (int)b1.z, (int)b1.w};
                acc[g] = __builtin_amdgcn_mfma_scale_f32_16x16x128_f8f6f4(a8, b8, acc[g], 4, 0, 0, 0x7F7F7F7F, 0, 0x7F7F7F7F); } }
        if (i16 == 0) {
#pragma unroll
            for (int r = 0; r < 4; ++r) *(f32x4*)(PACTs + (size_t)t * 128 + (4 * kg + r) * 8 + (h & 1) * 4) = (f32x4){acc[0][r], acc[1][r], acc[2][r], acc[3][r]}; }
#pragma unroll
        for (int j = 0; j < 8; ++j) a[j] = an[j];
        en = e2;
    }
}
DI void peer_v_pass(int sub, int wx, int nwx, const bf16* X1Bp, const int* IDX, const float* AV, const unsigned char* PV4s, bf16* ZBp, float* STATs, LAS f32x4* red, int lane, int emask = 0x3fff) {
    asm volatile("" : "+v"(lane));
    if (wx >= M) return;
    const int c8 = lane & 7, r8 = lane >> 3; const unsigned lo = (unsigned)c8 * 16u;
    const int* ibase = IDX + r8 * 16; const float* abase = AV + r8 * 16;
    const int col = sub * 256 + 32 * (lane & 7) + 4 * (lane >> 3);
    pg8::v4i eA[2], eB[2]; f32x4 aA[2], aB[2]; u32x4 wA[8], wB[8]; h2_t yh[16];
    { const pg8::v4i* ip = (const pg8::v4i*)(ibase + (size_t)wx * 128); eA[0] = ip[0]; eA[1] = ip[1]; eB[0] = ip[2]; eB[1] = ip[3];
      const f32x4* ap = (const f32x4*)(abase + (size_t)wx * 128); aA[0] = ap[0]; aA[1] = ap[1]; aB[0] = ap[2]; aB[1] = ap[3];
#pragma unroll
      for (int j = 0; j < 8; ++j) wA[j] = *(const u32x4*)(PV4s + ((unsigned)(eA[j >> 2][j & 3] & emask) * 128u + lo)); }
#pragma unroll 1
    for (int t = wx; t < M; t += nwx) {
        const int tn = (t + nwx < M) ? t + nwx : t;
#pragma unroll
        for (int j = 0; j < 8; ++j) wB[j] = *(const u32x4*)(PV4s + ((unsigned)(eB[j >> 2][j & 3] & emask) * 128u + lo));
        PEER_MEMFENCE();
        { const pg8::v4i* ip = (const pg8::v4i*)(ibase + (size_t)tn * 128); eA[0] = ip[0]; eA[1] = ip[1]; eB[0] = ip[2]; eB[1] = ip[3]; }
        const u32x2 xv = *(const u32x2*)(X1Bp + (size_t)t * D + col);
        PEER_MEMFENCE();
#pragma unroll
        for (int i = 0; i < 16; ++i) yh[i] = (h2_t){(_Float16)0.f, (_Float16)0.f};
#pragma unroll
        for (int j = 0; j < 8; ++j) { const float aj = aA[j >> 2][j & 3]; axpy32_fp4_h(wA[j], H2C(__builtin_amdgcn_cvt_pkrtz(aj, aj)), yh); }
        PEER_MEMFENCE();
        { const f32x4* ap = (const f32x4*)(abase + (size_t)tn * 128); aA[0] = ap[0]; aA[1] = ap[1]; }
#pragma unroll
        for (int j = 0; j < 8; ++j) wA[j] = *(const u32x4*)(PV4s + ((unsigned)(eA[j >> 2][j & 3] & emask) * 128u + lo));
        PEER_MEMFENCE();
#pragma unroll
        for (int j = 0; j < 8; ++j) { const float aj = aB[j >> 2][j & 3]; axpy32_fp4_h(wB[j], H2C(__builtin_amdgcn_cvt_pkrtz(aj, aj)), yh); }
        PEER_MEMFENCE();
        { const f32x4* ap = (const f32x4*)(abase + (size_t)tn * 128); aB[0] = ap[2]; aB[1] = ap[3]; }
#pragma unroll
        for (int q = 0; q < 8; ++q) red[r8 * 72 + q * 8 + c8] = (f32x4){(float)yh[2 * q].x, (float)yh[2 * q].y, (float)yh[2 * q + 1].x, (float)yh[2 * q + 1].y};
        asm volatile("s_waitcnt lgkmcnt(0)" ::: "memory");
        f32x4 z = red[lane];
#pragma unroll
        for (int r = 1; r < 8; ++r) z = z + red[r * 72 + lane];
        asm volatile("s_waitcnt lgkmcnt(0)" ::: "memory");
        z = (f32x4){bflo(xv.x), bfhi(xv.x), bflo(xv.y), bfhi(xv.y)} * ALPHA + z;
        const float s1 = wave_sum((z[0] + z[1]) + (z[2] + z[3])), s2 = wave_sum((z[0] * z[0] + z[1] * z[1]) + (z[2] * z[2] + z[3] * z[3]));
        u32x2 o; o.x = pk2(z[0], z[1]); o.y = pk2(z[2], z[3]); *(u32x2*)(ZBp + (size_t)t * D + col) = o;
        if (lane == 0) *(f32x2*)(STATs + (size_t)t * 2) = (f32x2){s1, s2};
    }
}
DI void ln2_row(int t, const bf16* ZBp, const float* STAT, const float* g2, const float* b2, float* outf, bf16* outb, unsigned char* outb8, int lane) {
    asm volatile("" : "+v"(lane));
    float s1 = 0.f, s2 = 0.f;
    if (lane < NSUB) { const f32x2 v = *(const f32x2*)(STAT + ((size_t)lane * M + t) * 2); s1 = v.x; s2 = v.y; }
    const u32x2* zr = (const u32x2*)(ZBp + (size_t)t * D);
    u32x2 zq[16];
#pragma unroll
    for (int j = 0; j < 16; ++j) zq[j] = zr[j * 64 + lane];
    s1 = wave_sum(s1); s2 = wave_sum(s2);
    const float mean = s1 * (1.0f / D), rstd = __builtin_amdgcn_rsqf(fmaxf(s2 * (1.0f / D) - mean * mean, 0.f) + LN_EPS);
#pragma unroll
    for (int j = 0; j < 16; ++j) { const int ci = j * 64 + lane; const u32x2 r = zq[j];
        const f32x4 o = ((f32x4){bflo(r.x), bfhi(r.x), bflo(r.y), bfhi(r.y)} - mean) * rstd * ((const f32x4*)g2)[ci] + ((const f32x4*)b2)[ci];
        if (outf) ((f32x4*)outf)[ci] = o;
        if (outb) { u32x2 w0; w0.x = pk2(o[0], o[1]); w0.y = pk2(o[2], o[3]); ((u32x2*)outb)[ci] = w0; ((unsigned*)outb8)[ci] = pk4_fp8(o[0] * XB_SCALE, o[1] * XB_SCALE, o[2] * XB_SCALE, o[3] * XB_SCALE); } }
}

DI const float* inp_ptr(const LAS unsigned long long* tab, int k) { const unsigned long long v = tab[k];
    const unsigned lo = __builtin_amdgcn_readfirstlane((unsigned)v), hi = __builtin_amdgcn_readfirstlane((unsigned)(v >> 32)); return (const float*)(((unsigned long long)hi << 32) | lo); }
__global__ void __launch_bounds__(NWAVES * 64, 2) mk_fwd(Args args) {
    extern __shared__ __attribute__((aligned(16))) unsigned char lds[];
    LAS unsigned char* L = (LAS unsigned char*)lds;
    volatile LAS unsigned* MISC = (volatile LAS unsigned*)(L + MISC_OFF);
    const int tid = threadIdx.x, lane = tid & 63, wave = __builtin_amdgcn_readfirstlane(tid >> 6);
    const int G = gridDim.x; const int bx = blockIdx.x; const int vcu = (G % 8 == 0) ? (bx % 8) * (G / 8) + bx / 8 : bx;
    const int gw = vcu * NWAVES + wave, NGW = G * NWAVES;
    unsigned char* ws = args.ws; float* out = args.out;
    unsigned* ctl = (unsigned*)(ws + WS_CTL);
    for (int u = tid; u < (LDS_BYTES - LDSCTL_OFF) / 4; u += NWAVES * 64) ((LAS unsigned*)(L + LDSCTL_OFF))[u] = 0u;
    __syncthreads();
    LAS unsigned long long* ptab = (LAS unsigned long long*)(L + LDSCTL_OFF);
    if (tid == 0) {
#pragma unroll
        for (int k = 0; k < 24; ++k) ptab[k] = (unsigned long long)args.in[k]; }
    __syncthreads();
#define INP(k) inp_ptr(ptab, (k))
    XcdBarrier bar; bar.bar = ctl + CW_BAR; bar.x = 0; bar.st = nullptr;
    if (N_LAUNCHES == 1) bar = xcd_barrier_post(ctl + CW_BAR, MISC + 8);
    const int lo = args.ph_lo, hi = args.ph_hi;
#ifndef PH_MASK
#define PH_MASK 0x7fff
#endif
#define IN(k) ((((PH_MASK) >> (k)) & 1) && lo <= (k) && (k) < hi)
#define REP(k) for (int _r = 0, _n = ((args.dup >> (k)) & 1) + 1; _r < _n; ++_r, __syncthreads())
#define TAIL(total) const int first_idle = (total) - (((total) + G - 1) / G - 1) * G; const bool in_tail = bx >= first_idle && first_idle < G; const int gtw = (bx - first_idle) * NWAVES + wave, ngtw = (G - first_idle) * NWAVES; \
    LAS float* scr = (LAS float*)(L + wave * 16640); const size_t gtt = (size_t)gtw * 64 + ln, ntt = (size_t)ngtw * 64; (void)scr; (void)gtt; (void)ntt
#define SEAM(k) do { if (IN(k) && IN((k) + 1)) xcd_barrier(bar); } while (0)

#define Wa ((bf16*)(ws + WS_WA))
#define Wb ((bf16*)(ws + WS_WB))
#define Wmkv ((bf16*)(ws + WS_WMKV))
#define Wout8 ((unsigned char*)(ws + WS_WOUT))
#define Wq ((bf16*)(ws + WS_WQ))
#define KEYB ((bf16*)(ws + WS_KEYB))
#define SWB ((bf16*)(ws + WS_SWB))
#define PU8 ((unsigned char*)(ws + WS_PU))
#define PV8 ((unsigned char*)(ws + WS_PV))
#define SCU ((float*)(ws + WS_SCU))
#define SCV ((float*)(ws + WS_SCV))
#define XB ((bf16*)(ws + WS_XB))
#define XF ((float*)(ws + WS_XF))
#define MEMB ((bf16*)(ws + WS_MEMB))
#define MKB ((bf16*)(ws + WS_MKB))
#define MVT ((bf16*)(ws + WS_MVT))
#define CMK ((bf16*)(ws + WS_CMK))
#define CMVT ((bf16*)(ws + WS_CMVT))
#define CK ((bf16*)(ws + WS_CK))
#define CVT ((bf16*)(ws + WS_CVT))
#define BUFA ((bf16*)(ws + WS_BUFA))
#define BUFB ((bf16*)(ws + WS_BUFB))
#define BUFC ((bf16*)(ws + WS_BUFC))
#define QM ((bf16*)(ws + WS_QM))
#define CAT ((unsigned char*)(ws + WS_CAT))
#define Z ((bf16*)(ws + WS_Z))
#define X1F ((float*)(ws + WS_X1F))
#define X1B ((bf16*)(ws + WS_X1B))
#define X18 ((unsigned char*)(ws + WS_XF + 80 * MiB))
#define PQ ((bf16*)(ws + WS_PQ))
#define IDX ((int*)(ws + WS_IDX))
#define GATE ((float*)(ws + WS_GATE))
#define VST ((float*)(ws + WS_VST))
#define XB8 ((unsigned char*)(ws + WS_XB8))
#define Wa8 ((unsigned char*)(ws + WS_WA8))
#define Wb8 ((unsigned char*)(ws + WS_WB8))

    if (IN(0)) REP(0) { int ln = lane; asm volatile("" : "+v"(ln)); int tq = tid; asm volatile("" : "+v"(tq));
        LAS float* scr = (LAS float*)(L + wave * 16640);
        tr_job_both(INP(I_WINA) + 3072, Wa + (size_t)3072 * KDIM, Wa8 + (size_t)4096 * KDIM, 4096, 3072, 7168, WIN_SCALE, scr, gw, NGW, ln);
        tr_job8(INP(I_WINA), Wa8, 4096, 3072, 7168, WIN_SCALE, scr, gw, NGW, ln);
        tr_job8(INP(I_WINA) + 6144, Wa8 + (size_t)3072 * KDIM, 4096, 1024, 7168, WIN_SCALE, scr, gw, NGW, ln);
        tr_job(INP(I_WMKV), Wmkv, 4096, 2048, 2, (size_t)4096 * 2048, (size_t)4096 * 2048, scr, gw, NGW, ln);
        tr_job8(INP(I_WOUT), Wout8, 4096, 4096, 4096, WOUT_SCALE, scr, gw, NGW, ln);
        tr_job(INP(I_PWQ), Wq, 4096, 2048, 1, 0, 0, scr, gw, NGW, ln);
        tr_job(INP(I_CMV), CMVT, 256, 1024, 32, (size_t)256 * 1024, (size_t)256 * 1024, scr, gw, NGW, ln);
        const size_t gt = (size_t)gw * 64 + ln, nth = (size_t)NGW * 64;
        cvt_job(INP(I_XP), XB, (size_t)MP * D, gt, nth, XB8, XB_SCALE);
        cvt_job(INP(I_XS), XB + (size_t)MP * D, (size_t)MS * D, gt, nth, XB8 + (size_t)MP * D, XB_SCALE);
        cvt_job(INP(I_MEMP), MEMB, (size_t)512 * D, gt, nth);
        cvt_job(INP(I_PKEYS), KEYB, (size_t)2 * 8 * 2 * 128 * 128, gt, nth);
        cvt_job(INP(I_CMK), CMK, (size_t)2 * 16 * 256 * 1024, gt, nth);
        for (size_t i = gt; i < (size_t)8 * 128 * 128; i += nth) { const int s = (int)(i & 127), t = (int)((i >> 7) & 127); const float v = (s <= t) ? INP(I_SGUW)[i] : 0.f; SWB[i] = (bf16)(pk2(v, 0.f) & 0xffffu); }
    }
    SEAM(0);
    if (IN(1)) REP(1) { int ln = lane; asm volatile("" : "+v"(ln)); int tq = tid; asm volatile("" : "+v"(tq));
        EpiA E{BUFA, QM, BUFB, VST, out, MKB, MVT};
        { pg8::MultiOrder<JobsA> S; S.G = G; S.c = bx; S.jt = JobsA{XB, Wa, MEMB, Wmkv};
          pg8::gemm_phase<EpiA, pg8::MultiOrder<JobsA>>(L, S, E, tq); }
        { constexpr int off = 72;
          pg8::MultiOrder<JobsA8, pg8::TSTEP / 2> S; S.G = G; S.c = (G == 256) ? ((bx + 256 - off) & 255) : bx; S.jt = JobsA8{XB8, Wa8};
          int tq2 = tid; asm volatile("" : "+v"(tq2));
          pg8::gemm_phase<EpiA, pg8::MultiOrder<JobsA8, pg8::TSTEP / 2>, true>(L, S, E, tq2); }
    }
    SEAM(1);
    if (IN(2)) REP(2) { int ln = lane; asm volatile("" : "+v"(ln)); int tq = tid; asm volatile("" : "+v"(tq));
        { const int sh = (320 > G) ? (320 - G) : 0;
          for (int t = ((vcu + sh) % G); t < 320; t += G) mem_wg(t, 0, QM, MKB, MVT, CMK, CMVT, CAT, L, tq, wave, ln); }
        AW_BAR();
        LAS float* stl = (LAS float*)(L + wave * 2048);
        constexpr int NSGU = 80 * 8 * 3;
        for (int t = gw; t < NSGU; t += NGW) sgu_task(t, BUFA, BUFB, VST, SWB, INP(I_SLNG), INP(I_SLNB), INP(I_SGUB), CAT, out, stl, ln);
    }
    SEAM(2);
    if (IN(3)) REP(3) { int ln = lane; asm volatile("" : "+v"(ln)); int tq = tid; asm volatile("" : "+v"(tq));
        pg8::MultiOrder<Jobs1, pg8::TSTEP / 2> S; S.G = G; S.c = bx; S.jt = Jobs1{(const bf16*)CAT, (const bf16*)Wout8, 16, K_OUT};
        EpiOut<true> E{XB, XB + (size_t)MP * D, Z};
        pg8::gemm_phase<EpiOut<true>, pg8::MultiOrder<Jobs1, pg8::TSTEP / 2>, true>(L, S, E, tq);
        TAIL(544);
        if (in_tail) { fp4_rows_job(INP(I_PU), (unsigned*)PU8, SCU, 0, NEXP, gtw, ngtw, ln); fp4_rows_job(INP(I_PV), (unsigned*)PV8, SCV, 0, V0_A, gtw, ngtw, ln); }
    }
    SEAM(3);
    if (IN(4)) REP(4) { int ln = lane; asm volatile("" : "+v"(ln)); int tq = tid; asm volatile("" : "+v"(tq)); for (int m = gw; m < M; m += NGW) ln1_row(Z + (size_t)m * D, INP(I_LN1G), INP(I_LN1B), X1B + (size_t)m * D, X18 + (size_t)m * D, ln); }
    SEAM(4);
    if (IN(5)) REP(5) { int ln = lane; asm volatile("" : "+v"(ln)); int tq = tid; asm volatile("" : "+v"(tq));
        pg8::MultiOrder<Jobs1> S; S.G = G; S.c = bx; S.jt = Jobs1{X1B, Wq, 8, K_WQ};
        EpiWq E{PQ};
        pg8::gemm_phase<EpiWq, pg8::MultiOrder<Jobs1>>(L, S, E, tq);
        TAIL(272);
        if (in_tail) {
            tr_job_both(INP(I_WINB) + 3072, Wb + (size_t)3072 * KDIM, Wb8 + (size_t)4096 * KDIM, 4096, 6144, 10240, WIN_SCALE, scr, gtw, ngtw, ln);
            tr_job8(INP(I_WINB), Wb8, 4096, 3072, 10240, WIN_SCALE, scr, gtw, ngtw, ln);
            tr_job8(INP(I_WINB) + 9216, Wb8 + (size_t)3072 * KDIM, 4096, 1024, 10240, WIN_SCALE, scr, gtw, ngtw, ln);
            fp4_rows_job(INP(I_PV), (unsigned*)PV8, SCV, V0_A, V0_B, gtw, ngtw, ln);
        }
    }
    SEAM(5);
    if (IN(6)) REP(6) { int ln = lane; asm volatile("" : "+v"(ln)); int tq = tid; asm volatile("" : "+v"(tq)); for (int it = vcu; it < (M / 32) * 2; it += G) topk_item2(it, PQ, KEYB, IDX, GATE, (LAS unsigned*)L, (LAS unsigned*)(L + 131072), tq, wave, ln);
        { constexpr int items = (M / 32) * 2, busy = items - (items / 256) * 256;
          if (G == 256 ? vcu >= busy : true) { const int gtw = (G == 256 ? vcu - busy : vcu) * NWAVES + wave, ngtw = (G == 256 ? 256 - busy : G) * NWAVES;
            fp4_rows_job(INP(I_PV), (unsigned*)PV8, SCV, V0_B, NEXP, gtw, ngtw, ln); } } }
    SEAM(6);
#define PACT ((float*)(ws + WS_X1F))
#define ZB ((bf16*)(ws + WS_XF))
#define AV ((float*)(ws + WS_XF + 70 * MiB))
#define STAT ((float*)(ws + WS_XF + 76 * MiB))
#define PEER_SLICED(li, OUTF, OUTB, OUTB8) do { \
        int xg = (G % 8 == 0) ? 8 : 1, xk = bx % xg, wx = (bx / xg) * NWAVES + wave, nwx = (G / xg) * NWAVES; \
        if (N_LAUNCHES == 1) {     \
            if (tid == 0) { unsigned cnt = 0u, xi = 0u, mine = 0u; for (unsigned j = 0; j < 16u; ++j) { const unsigned c = xb_ld(&bar.bar[XB_XCNT(j)]); if (c) { ++cnt; if (j < bar.x) ++xi; } if (j == bar.x) mine = c; } MISC[11] = xi; MISC[12] = cnt; MISC[13] = mine; } \
            __syncthreads(); \
            xk = (int)MISC[11]; xg = (int)MISC[12]; wx = (int)MISC[10] * NWAVES + wave; nwx = (int)MISC[13] * NWAVES; __syncthreads(); } \
        const unsigned char* pu = PU8 + (size_t)(li) * NEXP * (D / 2); const unsigned char* pv = PV8 + (size_t)(li) * NEXP * (D / 2); \
        _Pragma("unroll 1") for (int step8 = 0; step8 < 8; ++step8) { const int step = step8 >> 1; const bool sdup = (MK_STEP_DUP >> step) & 1; if ((step8 & 1) && !sdup) continue; const int emk = (sdup && !(step8 & 1)) ? 127 : 0x3fff;                                         \
            if (step == 0) { for (int sub = xk; sub < NSUB; sub += xg) peer_u_pass(sub, wx, nwx, X1B, IDX, pu + (size_t)sub * SUB_BYTES, PACT + (size_t)sub * M * 128, ln, emk); } \
            else if (step == 1) { for (int t = gw; t < M; t += NGW) peer_a_token(t, IDX, GATE, PACT, SCU + (li) * NEXP, SCV + (li) * NEXP, AV, ln); } \
            else if (step == 2) { for (int sub = xk; sub < NSUB; sub += xg) peer_v_pass(sub, wx, nwx, X1B, IDX, AV, pv + (size_t)sub * SUB_BYTES, ZB, STAT + (size_t)sub * M * 2, (LAS f32x4*)(L + wave * 9216), ln, emk); } \
            else { for (int t = gw; t < M; t += NGW) ln2_row(t, ZB, STAT, INP(I_LN2G) + (li) * D, INP(I_LN2B) + (li) * D, OUTF, OUTB, OUTB8, ln); } \
            if (step8 < 7 && N_LAUNCHES == 1) xcd_barrier(bar); } \
    } while (0)
    if (IN(7)) REP(7) { int ln = lane; asm volatile("" : "+v"(ln)); int tq = tid; asm volatile("" : "+v"(tq)); (void)tq;
        PEER_SLICED(0, (float*)nullptr, XB + (size_t)t * D, XB8 + (size_t)t * D); }
    SEAM(7);
    if (IN(8)) REP(8) { int ln = lane; asm volatile("" : "+v"(ln)); int tq = tid; asm volatile("" : "+v"(tq));
        EpiB<false> E{BUFA, BUFC, QM, BUFB, out}; EpiB<true> E8{BUFA, BUFC, QM, BUFB, out};
        { pg8::MultiOrder<JobsB> S; S.G = G; S.c = bx; S.jt = JobsB{XB, Wb};
          pg8::gemm_phase<EpiB<false>, pg8::MultiOrder<JobsB>>(L, S, E, tq); }
        { constexpr int off = 64;
          pg8::MultiOrder<JobsB8, pg8::TSTEP / 2> S; S.G = G; S.c = (G == 256) ? ((bx + 256 - off) & 255) : bx; S.jt = JobsB8{XB8, Wb8};
          int tq2 = tid; asm volatile("" : "+v"(tq2));
          pg8::gemm_phase<EpiB<true>, pg8::MultiOrder<JobsB8, pg8::TSTEP / 2>, true>(L, S, E8, tq2); }
        const bool in_tail = bx >= 144 || G != 256; const int gtw = (G == 256 ? bx - 144 : bx) * NWAVES + wave, ngtw = (G == 256 ? 112 : G) * NWAVES;
        if (in_tail) { LAS float* scr = (LAS float*)(L + wave * 16640); const size_t gtt = (size_t)gtw * 64 + ln, ntt = (size_t)ngtw * 64;
            __syncthreads();
            tr_job(INP(I_CBV), CVT, 512, 3072, 16, (size_t)512 * 3072, (size_t)512 * 3072, scr, gtw, ngtw, ln);
            cvt_job(INP(I_CBK), CK, (size_t)16 * 512 * 3072, gtt, ntt);
            tr_job8(INP(I_WOUT) + (size_t)4096 * 4096, Wout8 + (size_t)4096 * 4096, 4096, 4096, 4096, WOUT_SCALE, scr, gtw, ngtw, ln); }
    }
    SEAM(8);
    if (IN(9)) REP(9) { int ln = lane; asm volatile("" : "+v"(ln)); int tq = tid; asm volatile("" : "+v"(tq));
        const int sub = (_r == 0) ? 7 : MK_P9_SUB;
        for (int t = vcu; t < 768 + 384; t += G) { if (t < 768) { if (sub & 1) band_wg2(t, BUFA, BUFC, BUFB, INP(I_RELB), CAT, L, tq, wave, ln, sub); } else if (sub & 2) band_wg(1536 + (t - 768), BUFA, BUFC, BUFB, CK, CVT, INP(I_RELB), CAT, L, tq, wave, ln); }
        AW_BAR();
        if (sub & 4) { const int sh = (1152 % G == 0) ? 0 : G - 1152 % G;
          for (int t = ((vcu + sh) % G); t < 320; t += G) mem_wg(t, 1, QM, MKB, MVT, CMK, CMVT, CAT, L, tq, wave, ln); }
    }
    SEAM(9);
    if (IN(10)) REP(10) { int ln = lane; asm volatile("" : "+v"(ln)); int tq = tid; asm volatile("" : "+v"(tq));
        pg8::MultiOrder<Jobs1, pg8::TSTEP / 2> S; S.G = G; S.c = bx; S.jt = Jobs1{(const bf16*)CAT, (const bf16*)(Wout8 + (size_t)4096 * 4096), 16, K_OUT};
        EpiOut<true> E{XB, XB + (size_t)MP * D, Z};
        pg8::gemm_phase<EpiOut<true>, pg8::MultiOrder<Jobs1, pg8::TSTEP / 2>, true>(L, S, E, tq);
        TAIL(544);
        if (in_tail) { __syncthreads();
            tr_job(INP(I_PWQ) + (size_t)4096 * 2048, Wq + (size_t)4096 * 2048, 4096, 2048, 1, 0, 0, scr, gtw, ngtw, ln);
            fp4_rows_job(INP(I_PU) + (size_t)NEXP * D, (unsigned*)(PU8 + (size_t)NEXP * (D / 2)), SCU + NEXP, 0, U1_A, gtw, ngtw, ln); }
    }
    SEAM(10);
    if (IN(11)) REP(11) { int ln = lane; asm volatile("" : "+v"(ln)); int tq = tid; asm volatile("" : "+v"(tq)); for (int m = gw; m < M; m += NGW) ln1_row(Z + (size_t)m * D, INP(I_LN1G) + D, INP(I_LN1B) + D, X1B + (size_t)m * D, X18 + (size_t)m * D, ln); }
    SEAM(11);
    if (IN(12)) REP(12) { int ln = lane; asm volatile("" : "+v"(ln)); int tq = tid; asm volatile("" : "+v"(tq));
        pg8::MultiOrder<Jobs1> S; S.G = G; S.c = bx; S.jt = Jobs1{X1B, Wq + (size_t)2048 * KDIM, 8, K_WQ};
        EpiWq E{PQ};
        pg8::gemm_phase<EpiWq, pg8::MultiOrder<Jobs1>>(L, S, E, tq);
        TAIL(272);
        if (in_tail) { fp4_rows_job(INP(I_PU) + (size_t)NEXP * D, (unsigned*)(PU8 + (size_t)NEXP * (D / 2)), SCU + NEXP, U1_A, NEXP, gtw, ngtw, ln);
            fp4_rows_job(INP(I_PV) + (size_t)NEXP * D, (unsigned*)(PV8 + (size_t)NEXP * (D / 2)), SCV + NEXP, 0, V1_A, gtw, ngtw, ln); }
    }
    SEAM(12);
    if (IN(13)) REP(13) { int ln = lane; asm volatile("" : "+v"(ln)); int tq = tid; asm volatile("" : "+v"(tq)); for (int it = vcu; it < (M / 32) * 2; it += G) topk_item2(it, PQ, KEYB + (size_t)8 * 2 * 128 * 128, IDX, GATE, (LAS unsigned*)L, (LAS unsigned*)(L + 131072), tq, wave, ln);
        { constexpr int items = (M / 32) * 2, busy = items - (items / 256) * 256;
          if (G == 256 ? vcu >= busy : true) { const int gtw = (G == 256 ? vcu - busy : vcu) * NWAVES + wave, ngtw = (G == 256 ? 256 - busy : G) * NWAVES;
            fp4_rows_job(INP(I_PV) + (size_t)NEXP * D, (unsigned*)(PV8 + (size_t)NEXP * (D / 2)), SCV + NEXP, V1_A, NEXP, gtw, ngtw, ln); } } }
    SEAM(13);
    if (IN(14)) REP(14) { int ln = lane; asm volatile("" : "+v"(ln)); int tq = tid; asm volatile("" : "+v"(tq)); (void)tq;
        PEER_SLICED(1, out + O_YP + (size_t)t * D, (bf16*)nullptr, (unsigned char*)nullptr); }
#undef IN
#undef SEAM
#undef INP
}


#if MK_CHECK
constexpr int CW_CHK = 2048;
__device__ inline unsigned hsh(unsigned x) { x ^= x >> 16; x *= 0x7feb352du; x ^= x >> 15; x *= 0x846ca68bu; x ^= x >> 16; return x; }
__device__ inline float b2f(bf16 b) { return __uint_as_float(((unsigned)b) << 16); }
__device__ inline bf16 f2b(float f) { unsigned u = __float_as_uint(f); u += 0x7fffu + ((u >> 16) & 1u); return (bf16)(u >> 16); }
__device__ inline bool badv(float got, float ref, float rtol, float atol) { return !(fabsf(got - ref) <= rtol * fabsf(ref) + atol); }
__device__ inline float gelu_ref(float x) { return 0.5f * x * (1.0f + tanhf(0.7978845608f * (x + 0.044715f * x * x * x))); }
__device__ inline float dotbb(const bf16* a, const bf16* b, int n) { float s = 0.f; for (int k = 0; k < n; ++k) s += b2f(a[k]) * b2f(b[k]); return s; }
#define FLAG(id) atomicAdd(chk + (id), 1u)
__global__ void chk_tr(const float* src, const bf16* dst, int K, int N, int nmat, unsigned* chk, int id) {
    const unsigned i = blockIdx.x * blockDim.x + threadIdx.x; const unsigned r = hsh(i * 3u + 1u), r2 = hsh(i * 3u + 2u), r3 = hsh(i * 3u + 3u);
    const int mi = r % nmat, k = r2 % K, n = r3 % N; const size_t mo = (size_t)mi * K * N;
    if (dst[mo + (size_t)n * K + k] != f2b(src[mo + (size_t)k * N + n])) FLAG(id);
}
__global__ void chk_cvt(const float* src, const bf16* dst, size_t n, unsigned* chk, int id) {
    const unsigned i = blockIdx.x * blockDim.x + threadIdx.x; const size_t j = ((size_t)hsh(i) * 2654435761ull + hsh(i + 77u)) % n;
    if (dst[j] != f2b(src[j])) FLAG(id);
}
__global__ void chk_swb(const float* src, const bf16* dst, unsigned* chk, int id) {
    const unsigned i = blockIdx.x * blockDim.x + threadIdx.x; if (i >= 8 * 128 * 128) return; const int s_ = i & 127, t = (i >> 7) & 127;
    if (dst[i] != f2b(s_ <= t ? src[i] : 0.f)) FLAG(id);
}
__global__ void chk_gemm(const bf16* A, const bf16* B, int Mr, int Nr, const void* O, int ldo, int mode, int act, float scale, unsigned* chk, int id) {
    const unsigned i = blockIdx.x * blockDim.x + threadIdx.x; const int m = hsh(i * 2u + 11u) % Mr, n = hsh(i * 2u + 12u) % Nr;
    float d = dotbb(A + (size_t)m * KDIM, B + (size_t)n * KDIM, KDIM); if (act) d = gelu_ref(d); d *= scale;
    float got; if (mode == 0) got = b2f(((const bf16*)O)[(size_t)m * ldo + n]); else if (mode == 1) got = b2f(((const bf16*)O)[(size_t)n * ldo + m]); else got = ((const float*)O)[(size_t)m * ldo + n];
    if (badv(got, d, 0.012f, 0.004f)) FLAG(id);
}
__global__ void chk_bandout(const bf16* XBp, const bf16* Wrows, const float* out, unsigned* chk, int id) {
    const unsigned i = blockIdx.x * blockDim.x + threadIdx.x; const int r = hsh(i * 2u + 5u) % 1536, c = hsh(i * 2u + 6u) % TOK;
    int m; const float* o;
    if (r < 1024) { const int b = r >> 9, rr = r & 511; m = b * 4096 + 3584 + rr; o = out + (id & 1 ? O_BVP : O_BKP) + ((size_t)(b * 512 + rr)) * TOK + c; }
    else { m = MP + (r - 1024); o = out + (id & 1 ? O_BVS : O_BKS) + (size_t)(r - 1024) * TOK + c; }
    const float d = dotbb(XBp + (size_t)m * KDIM, Wrows + (size_t)c * KDIM, KDIM);
    if (badv(*o, d, 0.002f, 0.002f)) FLAG(id);
}
__global__ void chk_vst(const bf16* VT, const float* vst, unsigned* chk, int id) {
    const unsigned i = blockIdx.x * blockDim.x + threadIdx.x; const int t = hsh(i + 3u) % M; float s = 0.f, q = 0.f, s2 = 0.f, q2 = 0.f;
    for (int c = 0; c < TOK; ++c) { const float v = b2f(VT[(size_t)c * M + t]); s += v; q += v * v; }
    for (int sl = 0; sl < 24; ++sl) { s2 += vst[((size_t)sl * M + t) * 2]; q2 += vst[((size_t)sl * M + t) * 2 + 1]; }
    if (badv(s2, s, 0.01f, 0.5f) || badv(q2, q, 0.01f, 0.5f)) FLAG(id);
}
__device__ inline void ln_stats_tok(const bf16* VT, int t, float& mean, float& rstd) { float s = 0.f, q = 0.f; for (int c = 0; c < TOK; ++c) { const float v = b2f(VT[(size_t)c * M + t]); s += v; q += v * v; } mean = s / TOK; rstd = rsqrtf(q / TOK - mean * mean + LN_EPS); }
__global__ void chk_sgu(const bf16* U, const bf16* VT, const float* sguw, const float* sgub, const float* lng, const float* lnb, const bf16* CATp, const float* out, unsigned* chk, int id) {
    const unsigned i = blockIdx.x * blockDim.x + threadIdx.x; const int t = hsh(i * 2u + 1u) % M, col = hsh(i * 2u + 2u) % TOK, g = col / 384;
    int t0, tl; if (t < MP) { t0 = t & ~127; tl = t & 127; } else { t0 = MP + ((t - MP) & ~31); tl = (t - MP) & 31; }
    float acc = 0.f, vn_t = 0.f;
    for (int s_ = 0; s_ <= tl; ++s_) { float mean, rstd; ln_stats_tok(VT, t0 + s_, mean, rstd); const float vn = (b2f(VT[(size_t)col * M + t0 + s_]) - mean) * rstd * lng[col] + lnb[col];
        acc += sguw[((size_t)g * 128 + tl) * 128 + s_] * vn; if (s_ == tl) vn_t = vn; }
    const float ref = b2f(U[(size_t)t * TOK + col]) * (acc + sgub[g * 128 + tl]);
    if (badv(b2f(CATp[(size_t)t * D + col]), ref, 0.03f, 0.01f)) FLAG(id);
    if (t >= MP && badv(out[O_SGV + (size_t)(t - MP) * TOK + col], vn_t, 0.01f, 0.01f)) FLAG(id + 1);
}
__global__ void chk_memattn(int li, const bf16* QMp, const bf16* MKBp, const bf16* MVTp, const float* cmk, const float* cmv, const bf16* CATp, unsigned* chk, int id) {
    __shared__ float sc[256]; __shared__ float red[256];
    const unsigned i = blockIdx.x; const int t = hsh(i * 3u + 1u) % M, hm = hsh(i * 3u + 2u) & 3, d = hsh(i * 3u + 3u) & 255, m = threadIdx.x;
    float s = 0.f;
    for (int k = 0; k < 256; ++k) { const float q = b2f(QMp[(size_t)t * MEMW + hm * 256 + k]);
        const float kk = (t < MP) ? b2f(MKBp[((size_t)li * 512 + (t >> 12) * 256 + m) * 1024 + hm * 256 + k]) : cmk[(((size_t)(li * 16 + ((t - MP) >> 5)) * 256 + m) * 4 + hm) * 256 + k];
        s += q * kk; }
    sc[m] = s; __syncthreads();
    if (m == 0) { float mx = -1e30f, den = 0.f, num = 0.f; for (int j = 0; j < 256; ++j) mx = fmaxf(mx, sc[j]);
        for (int j = 0; j < 256; ++j) { const float p = expf(sc[j] - mx); den += p;
            const float v = (t < MP) ? b2f(MVTp[((size_t)li * 1024 + hm * 256 + d) * 512 + (t >> 12) * 256 + j]) : cmv[(((size_t)(li * 16 + ((t - MP) >> 5)) * 256 + j) * 4 + hm) * 256 + d];
            num += p * v; }
        if (badv(b2f(CATp[(size_t)t * D + TOK + hm * 256 + d]), num / den, 0.03f, 0.003f)) FLAG(id); }
    (void)red;
}
__global__ void chk_band(const bf16* Qb, const bf16* Kb, const bf16* VT, const float* cbk, const float* cbv, const float* relb, const bf16* CATp, unsigned* chk, int id) {
    const unsigned i = blockIdx.x * blockDim.x + threadIdx.x; const int t = hsh(i * 3u + 1u) % M, h = hsh(i * 3u + 2u) % 24, d = hsh(i * 3u + 3u) & 127;
    float mx = -1e30f, den = 0.f, num = 0.f;
    for (int pass = 0; pass < 2; ++pass) {
        const int nk = (t < MP) ? 576 : 544;
        for (int j = 0; j < nk; ++j) {
            int qpos, kpos; float kv[2]; const bf16* kr = nullptr; const float* krf = nullptr; float vv;
            if (t < MP) { const int b = t >> 12, tt = t & 4095, c = tt >> 6; qpos = tt; kpos = c * 64 - 512 + j; if (kpos < 0) continue;
                kr = Kb + ((size_t)(b * 4096 + kpos)) * TOK + h * 128; vv = b2f(VT[(size_t)(h * 128 + d) * M + b * 4096 + kpos]); }
            else { const int sb = (t - MP) >> 5, tt = (t - MP) & 31; qpos = 1024 + tt; kpos = 512 + j;
                if (j < 512) { krf = cbk + (((size_t)sb * 512 + j) * 24 + h) * 128; vv = cbv[(((size_t)sb * 512 + j) * 24 + h) * 128 + d]; }
                else { kr = Kb + ((size_t)(MP + sb * 32 + (j - 512))) * TOK + h * 128; vv = b2f(VT[(size_t)(h * 128 + d) * M + MP + sb * 32 + (j - 512)]); } }
            float s = 0.f; for (int k = 0; k < 128; ++k) s += b2f(Qb[(size_t)t * TOK + h * 128 + k]) * (kr ? b2f(kr[k]) : krf[k]);
            int rel = qpos - kpos; rel = rel < -128 ? -128 : (rel > 128 ? 128 : rel); s += relb[h * 257 + rel + 128]; (void)kv;
            if (pass == 0) mx = fmaxf(mx, s); else { const float p = expf(s - mx); den += p; num += p * vv; }
        }
    }
    if (badv(b2f(CATp[(size_t)t * D + h * 128 + d]), num / den, 0.03f, 0.004f)) FLAG(id);
}
__global__ void chk_z(const float* xp, const float* xs, const bf16* CATp, const bf16* Wo, const float* Zp, unsigned* chk, int id) {
    const unsigned i = blockIdx.x * blockDim.x + threadIdx.x; const int m = hsh(i * 2u + 1u) % M, n = hsh(i * 2u + 2u) % D;
    const float x = (m < MP) ? xp[(size_t)m * D + n] : xs[(size_t)(m - MP) * D + n];
    if (badv(Zp[(size_t)m * D + n], ALPHA * x + dotbb(CATp + (size_t)m * D, Wo + (size_t)n * D, D), 0.002f, 0.004f)) FLAG(id);
}
__global__ void chk_ln1(const float* Zp, const float* g, const float* b, const float* xf, const bf16* xb, unsigned* chk, int id) {
    const unsigned i = blockIdx.x * blockDim.x + threadIdx.x; const int m = hsh(i + 9u) % M; const float* z = Zp + (size_t)m * D; float s = 0.f, q = 0.f;
    for (int k = 0; k < D; ++k) s += z[k]; const float mean = s / D; for (int k = 0; k < D; ++k) q += (z[k] - mean) * (z[k] - mean); const float rstd = rsqrtf(q / D + LN_EPS);
    for (int k = (i & 7); k < D; k += 8) { const float y = (z[k] - mean) * rstd * g[k] + b[k]; if (badv(xf[(size_t)m * D + k], y, 0.001f, 0.001f) || badv(b2f(xb[(size_t)m * D + k]), y, 0.01f, 0.002f)) { FLAG(id); break; } }
}
__global__ void chk_topk(const bf16* PQp, const bf16* KEYp, const int* IDXp, const float* GATEp, unsigned* chk, int id) {
    __shared__ float s0[128], s1[128]; __shared__ float bs[16]; __shared__ int be[16];
    const unsigned i = blockIdx.x; const int t = hsh(i * 2u + 1u) % M, h = hsh(i * 2u + 2u) & 7, n = threadIdx.x;
    s0[n] = dotbb(PQp + (size_t)t * 2048 + h * 256, KEYp + ((size_t)(h * 2 + 0) * 128 + n) * 128, 128); s1[n] = dotbb(PQp + (size_t)t * 2048 + h * 256 + 128, KEYp + ((size_t)(h * 2 + 1) * 128 + n) * 128, 128);
    __syncthreads();
    if (n == 0) {
        float last = 3e38f; int laste = -1;
        for (int r = 0; r < 16; ++r) { float best = -3e38f; int beste = -1;
            for (int e = 0; e < 16384; ++e) { const float v = s0[e >> 7] + s1[e & 127]; if ((v < last || (v == last && e > laste)) && v > best) { best = v; beste = e; } }
            bs[r] = best; be[r] = beste; last = best; laste = beste; }
        float den = 0.f; for (int r = 0; r < 16; ++r) den += expf(bs[r] - bs[0]);
        int miss = 0; float gerr = 0.f;
        for (int r = 0; r < 16; ++r) { const int e = IDXp[(size_t)t * 128 + h * 16 + r]; const float gg = GATEp[(size_t)t * 128 + h * 16 + r]; int f = -1; for (int q = 0; q < 16; ++q) if (be[q] == e) f = q;
            if (f < 0) { ++miss; if (e < 0 || e >= 16384 || s0[e >> 7] + s1[e & 127] < bs[15] - 1e-3f) miss += 100; } else gerr = fmaxf(gerr, fabsf(gg - expf(bs[f] - bs[0]) / den)); }
        if (miss > 1 || gerr > 2e-3f) FLAG(id);
    }
}
__global__ void chk_peer(const float* X1Fp, const int* IDXp, const float* GATEp, const float* pu, const float* pv, const float* g2, const float* b2, const float* of0, const float* of1, const bf16* ob, const float* adbg, unsigned* chk, int id) {
    __shared__ float a[128]; __shared__ float red[256]; __shared__ float zrow[D];
    const int t = hsh(blockIdx.x + 1234u) % M, tid = threadIdx.x; const float* x = X1Fp + (size_t)t * D;
    if (tid < 128) { const int e = IDXp[(size_t)t * 128 + tid]; float d = 0.f; for (int k = 0; k < D; ++k) d += x[k] * pu[(size_t)e * D + k]; a[tid] = GATEp[(size_t)t * 128 + tid] * gelu_ref(d); }
    if (tid < 128 && badv(adbg[(size_t)t * 128 + tid], a[tid], 0.02f, 2e-4f)) FLAG(32);
    __syncthreads();
    float s = 0.f;
    for (int c = tid; c < D; c += 256) { float y = 0.f; for (int k = 0; k < 128; ++k) y += a[k] * pv[(size_t)IDXp[(size_t)t * 128 + k] * D + c]; const float z = ALPHA * x[c] + y; zrow[c] = z; s += z; }
    red[tid] = s; __syncthreads(); for (int o = 128; o > 0; o >>= 1) { if (tid < o) red[tid] += red[tid + o]; __syncthreads(); } const float mean = red[0] / D; __syncthreads();
    float q = 0.f; for (int c = tid; c < D; c += 256) q += (zrow[c] - mean) * (zrow[c] - mean);
    red[tid] = q; __syncthreads(); for (int o = 128; o > 0; o >>= 1) { if (tid < o) red[tid] += red[tid + o]; __syncthreads(); } const float rstd = rsqrtf(red[0] / D + LN_EPS);
    const float* of = (t < MP) ? of0 + (size_t)t * D : of1 + (size_t)(t - MP) * D; int bad = 0;
    int bad2 = 0, bad3 = 0;
    for (int c = tid; c < D; c += 256) { const float y = (zrow[c] - mean) * rstd * g2[c] + b2[c]; if (badv(of[c], y, 0.01f, 0.01f)) bad = 1; if (badv(of[c], y, 0.1f, 0.1f)) bad2 = 1; if (badv(of[c], y, 1.0f, 1.0f)) bad3 = 1; if (ob && badv(b2f(ob[(size_t)t * D + c]), y, 0.015f, 0.012f)) bad = 1; }
    if (bad) FLAG(id); if (bad2) FLAG(33); if (bad3) FLAG(34);
}
__global__ void chk_report(const unsigned* chk, float* out) {
    int first = 0; for (int k = 31; k >= 1; --k) if (chk[k]) first = k;
    if ((first == 17 || first == 27) && chk[32]) first = 50; else
    if (first == 17 || first == 27) { if (chk[34]) first = 60; else if (chk[33]) first = 40; if (chk[17] + chk[27] >= 64 * 128) first += 5; }
    if (first) for (size_t i = blockIdx.x * blockDim.x + threadIdx.x; i < (size_t)MS * D; i += (size_t)gridDim.x * blockDim.x) out[O_YS + i] *= (1.0f + first);
}
#endif

extern "C" void kernel_launch(void* const* d_in, const int* in_sizes, int n_in, void* d_out, int out_size, void* d_ws, size_t ws_size, hipStream_t stream) {
    static int grid = 0;
    if (grid == 0) {
        if (n_in != 24 || (size_t)out_size != O_END || ws_size < WS_END) { fprintf(stderr, "kernel_launch: unexpected shapes: n_in %d out %d ws %zu (need %zu)\n", n_in, out_size, ws_size, (size_t)WS_END); grid = -1; return; }
        int dev = 0, cus = 0, per_cu = 0;
        if (hipGetDevice(&dev) != hipSuccess || hipDeviceGetAttribute(&cus, hipDeviceAttributeMultiprocessorCount, dev) != hipSuccess) { grid = -1; return; }
        if (hipFuncSetAttribute((const void*)mk_fwd, hipFuncAttributeMaxDynamicSharedMemorySize, LDS_BYTES) != hipSuccess) { fprintf(stderr, "kernel_launch: hipFuncSetAttribute failed\n"); grid = -1; return; }
        if (hipOccupancyMaxActiveBlocksPerMultiprocessor(&per_cu, (const void*)mk_fwd, NWAVES * 64, LDS_BYTES) != hipSuccess || per_cu < 1) { fprintf(stderr, "kernel_launch: occupancy query says %d\n", per_cu); }
        (void)hipGetLastError();
        grid = cus;
    }
    if (grid < 0) return;
    if (hipMemsetAsync((char*)d_ws + WS_CTL, 0, CTL_ZERO_BYTES, stream) != hipSuccess) return;
    Args a{};
    for (int i = 0; i < 24; ++i) a.in[i] = (const float*)d_in[i];
    a.out = (float*)d_out; a.ws = (unsigned char*)d_ws; a.dup = MK_DUP_MASK; a.pad = 0;
    for (int li = 0; li < N_LAUNCHES; ++li) {
        a.ph_lo = (N_LAUNCHES == 1) ? 0 : li; a.ph_hi = (N_LAUNCHES == 1) ? NPHASES : li + 1;
        hipLaunchKernelGGL(mk_fwd, dim3(grid), dim3(NWAVES * 64), LDS_BYTES, stream, a);
#if MK_CHECK
        {   unsigned char* ws = (unsigned char*)d_ws; unsigned* chk = (unsigned*)(ws + WS_CTL) + CW_CHK; float* out = (float*)d_out; const float* const* in = a.in;
#define CK1(kern, n, ...) hipLaunchKernelGGL(kern, dim3(((n) + 255) / 256), dim3(256), 0, stream, __VA_ARGS__)
            const int ph = a.ph_lo;
            if (ph == 0) {
                CK1(chk_tr, 65536, in[I_WINA], Wa, 4096, 7168, 1, chk, 1); CK1(chk_tr, 65536, in[I_WINB], Wb, 4096, 10240, 1, chk, 1); CK1(chk_tr, 65536, in[I_WMKV], Wmkv, 4096, 2048, 2, chk, 1);
                CK1(chk_tr, 65536, in[I_WOUT], Wout, 4096, 4096, 2, chk, 1); CK1(chk_tr, 65536, in[I_PWQ], Wq, 4096, 2048, 2, chk, 1); CK1(chk_tr, 65536, in[I_CMV], CMVT, 256, 1024, 32, chk, 2); CK1(chk_tr, 65536, in[I_CBV], CVT, 512, 3072, 16, chk, 2);
                CK1(chk_cvt, 65536, in[I_XP], XB, (size_t)MP * D, chk, 3); CK1(chk_cvt, 65536, in[I_XS], XB + (size_t)MP * D, (size_t)MS * D, chk, 3); CK1(chk_cvt, 65536, in[I_MEMP], MEMB, (size_t)512 * D, chk, 3);
                CK1(chk_cvt, 65536, in[I_PKEYS], KEYB, (size_t)2 * 8 * 2 * 128 * 128, chk, 3); CK1(chk_cvt, 65536, in[I_CMK], CMK, (size_t)2 * 16 * 256 * 1024, chk, 3); CK1(chk_cvt, 65536, in[I_CBK], CK, (size_t)16 * 512 * 3072, chk, 3);
                CK1(chk_swb, 8 * 128 * 128, in[I_SGUW], SWB, chk, 3);
            } else if (ph == 1) {
                CK1(chk_gemm, 32768, XB, Wa, M, 3072, BUFA, 3072, 0, 1, 1.0f, chk, 4);
                CK1(chk_gemm, 32768, XB, Wa + (size_t)6144 * KDIM, M, 1024, QM, 1024, 0, 0, 0.0625f, chk, 5);
                CK1(chk_gemm, 32768, XB, Wa + (size_t)3072 * KDIM, M, 3072, BUFB, M, 1, 1, 1.0f, chk, 6);
                CK1(chk_vst, 2048, BUFB, VST, chk, 7);
                for (int li = 0; li < 2; ++li) {
                    CK1(chk_gemm, 16384, MEMB, Wmkv + (size_t)li * 2048 * KDIM, 512, 1024, MKB + (size_t)li * 512 * 1024, 1024, 0, 0, 1.0f, chk, 8);
                    CK1(chk_gemm, 16384, MEMB, Wmkv + (size_t)li * 2048 * KDIM, 512, 1024, out + O_MKP + (size_t)li * 512 * 1024, 1024, 2, 0, 1.0f, chk, 8);
                    CK1(chk_gemm, 16384, MEMB, Wmkv + ((size_t)li * 2048 + 1024) * KDIM, 512, 1024, out + O_MVP + (size_t)li * 512 * 1024, 1024, 2, 0, 1.0f, chk, 8);
                    CK1(chk_gemm, 16384, MEMB, Wmkv + ((size_t)li * 2048 + 1024) * KDIM, 512, 1024, MVT + (size_t)li * 1024 * 512, 512, 1, 0, 1.0f, chk, 9); }
            } else if (ph == 2) {
                CK1(chk_sgu, 2048, BUFA, BUFB, in[I_SGUW], in[I_SGUB], in[I_SLNG], in[I_SLNB], CAT, out, chk, 10);
                hipLaunchKernelGGL(chk_memattn, dim3(2048), dim3(256), 0, stream, 0, QM, MKB, MVT, in[I_CMK], in[I_CMV], CAT, chk, 12);
            } else if (ph == 3 || ph == 10) {
                if (ph == 3) CK1(chk_z, 32768, in[I_XP], in[I_XS], CAT, Wout, Z, chk, 13); else CK1(chk_z, 32768, XF, XF + (size_t)MP * D, CAT, Wout + (size_t)4096 * KDIM, Z, chk, 23);
            } else if (ph == 4 || ph == 11) { const int li = ph == 11; CK1(chk_ln1, 2048, Z, in[I_LN1G] + li * D, in[I_LN1B] + li * D, X1F, X1B, chk, li ? 24 : 14);
            } else if (ph == 5 || ph == 12) { const int li = ph == 12; CK1(chk_gemm, 32768, X1B, Wq + (size_t)li * 2048 * KDIM, M, 2048, PQ, 2048, 0, 0, 1.0f, chk, li ? 25 : 15);
            } else if (ph == 6 || ph == 13) { const int li = ph == 13; hipLaunchKernelGGL(chk_topk, dim3(1024), dim3(128), 0, stream, PQ, KEYB + (size_t)li * 8 * 2 * 128 * 128, IDX, GATE, chk, li ? 26 : 16);
            } else if (ph == 7) { hipLaunchKernelGGL(chk_peer, dim3(64), dim3(256), 0, stream, X1F, IDX, GATE, in[I_PU], in[I_PV], in[I_LN2G], in[I_LN2B], XF, XF + (size_t)MP * D, XB, (const float*)(ws + WS_END), chk, 17);
            } else if (ph == 8) {
                CK1(chk_gemm, 32768, XB, Wb, M, 3072, BUFA, 3072, 0, 0, 0.08838834764831845f, chk, 18);
                CK1(chk_gemm, 32768, XB, Wb + (size_t)3072 * KDIM, M, 3072, BUFC, 3072, 0, 0, 1.0f, chk, 19);
                CK1(chk_gemm, 32768, XB, Wb + (size_t)6144 * KDIM, M, 3072, BUFB, M, 1, 0, 1.0f, chk, 20);
                CK1(chk_gemm, 32768, XB, Wb + (size_t)9216 * KDIM, M, 1024, QM, 1024, 0, 0, 0.0625f, chk, 19);
                CK1(chk_bandout, 16384, XB, Wb + (size_t)3072 * KDIM, out, chk, 28); CK1(chk_bandout, 16384, XB, Wb + (size_t)6144 * KDIM, out, chk, 29);
            } else if (ph == 9) {
                CK1(chk_band, 8192, BUFA, BUFC, BUFB, in[I_CBK], in[I_CBV], in[I_RELB], CAT, chk, 21);
                hipLaunchKernelGGL(chk_memattn, dim3(2048), dim3(256), 0, stream, 1, QM, MKB, MVT, in[I_CMK], in[I_CMV], CAT, chk, 22);
            } else if (ph == 14) {
                hipLaunchKernelGGL(chk_peer, dim3(64), dim3(256), 0, stream, X1F, IDX, GATE, in[I_PU] + (size_t)NEXP * D, in[I_PV] + (size_t)NEXP * D, in[I_LN2G] + D, in[I_LN2B] + D, out + O_YP, out + O_YS, (const bf16*)nullptr, (const float*)(ws + WS_END), chk, 27);
                hipLaunchKernelGGL(chk_report, dim3(256), dim3(256), 0, stream, chk, out);
            }
#undef CK1
        }
#endif
    }
}
```

```cpp
#include <hip/hip_runtime.h>
#include <cstdio>
#include <cstdint>

#define GAS __attribute__((address_space(1)))
#define LAS __attribute__((address_space(3)))
#define DI __device__ __forceinline__
typedef unsigned short bf16;
typedef short bf16x8 __attribute__((ext_vector_type(8)));
typedef float f32x4 __attribute__((ext_vector_type(4)));
typedef float f32x2 __attribute__((ext_vector_type(2)));
typedef unsigned u32x4 __attribute__((ext_vector_type(4)));
typedef unsigned u32x2 __attribute__((ext_vector_type(2)));
typedef __bf16 bf2_t __attribute__((ext_vector_type(2)));

#ifndef MK_CHECK
#define MK_CHECK 0
#endif
#ifndef MK_N_LAUNCHES
#define MK_N_LAUNCHES 1
#endif
constexpr int NPHASES = 15;
constexpr int U1_A = 8192, V1_A = 12288;
constexpr int V0_A = 4096, V0_B = 12288;
#ifndef MK_P9_SUB
#define MK_P9_SUB 1
#endif
#ifndef MK_STEP_DUP
#define MK_STEP_DUP 0
#endif
#ifndef MK_DUP_MASK
#define MK_DUP_MASK 0
#endif
constexpr int N_LAUNCHES = MK_N_LAUNCHES;

constexpr int D = 4096, MP = 8192, MS = 512, M = MP + MS;
constexpr int TOK = 3072, MEMW = 1024;
constexpr int NEXP = 16384;
constexpr float ALPHA = 1.41421356237f;
constexpr float LN_EPS = 1e-5f;
constexpr int KDIM = 4096;

constexpr size_t O_YP = 0, O_YS = 33554432, O_BKP = 35651584, O_BVP = 38797312, O_MKP = 41943040, O_MVP = 42991616,
                 O_BKS = 44040192, O_BVS = 45613056, O_SGV = 47185920, O_END = 48758784;

constexpr size_t MiB = 1u << 20;
constexpr size_t WS_CTL = 0, CTL_ZERO_BYTES = 2 * MiB;
constexpr size_t WS_WA = 4 * MiB, WS_WB = 60 * MiB, WS_WMKV = 140 * MiB, WS_WOUT = 172 * MiB, WS_WQ = 236 * MiB, WS_KEYB = 268 * MiB, WS_SWB = 269 * MiB;
constexpr size_t WS_PU = 270 * MiB, WS_SCU = 400 * MiB, WS_PV = 526 * MiB, WS_SCV = 656 * MiB,
                  WS_XB = 782 * MiB, WS_XF = 850 * MiB, WS_MEMB = 986 * MiB, WS_MKB = 990 * MiB, WS_MVT = 992 * MiB;
constexpr size_t WS_CMK = 994 * MiB, WS_CMVT = 1010 * MiB, WS_CK = 1026 * MiB, WS_CVT = 1074 * MiB;
constexpr size_t WS_BUFA = 1122 * MiB, WS_BUFB = 1173 * MiB, WS_BUFC = 1224 * MiB, WS_QM = 1275 * MiB, WS_CAT = 1292 * MiB;
constexpr size_t WS_Z = 1360 * MiB, WS_X1F = 1496 * MiB, WS_X1B = 1632 * MiB, WS_PQ = 1700 * MiB, WS_IDX = 1734 * MiB, WS_GATE = 1739 * MiB, WS_VST = 1744 * MiB, WS_XB8 = 1746 * MiB, WS_WA8 = 1780 * MiB, WS_WB8 = 1808 * MiB, WS_END = 1848 * MiB;
constexpr int CW_TMO = 0, CW_BAR = 4096;

constexpr int RING_BYTES = 131072;
constexpr int LDSCTL_OFF = 163328, MISC_OFF = LDSCTL_OFF + 320;
constexpr int LDS_BYTES = 163840;
constexpr int NWAVES = 8;

DI unsigned pk2(float lo, float hi) { return __builtin_bit_cast(unsigned, __builtin_convertvector((f32x2){lo, hi}, bf2_t)); }
DI unsigned pk4_fp8(float a, float b, float c, float d) {
    a = fminf(fmaxf(a, -448.f), 448.f); b = fminf(fmaxf(b, -448.f), 448.f); c = fminf(fmaxf(c, -448.f), 448.f); d = fminf(fmaxf(d, -448.f), 448.f);
    int w = 0; w = __builtin_amdgcn_cvt_pk_fp8_f32(a, b, w, false); w = __builtin_amdgcn_cvt_pk_fp8_f32(c, d, w, true); return (unsigned)w; }
constexpr float CAT_SCALE = 32.0f, WOUT_SCALE = 2048.0f, XB_SCALE = 16.0f, WIN_SCALE = 2048.0f;
DI float bflo(unsigned u) { return __uint_as_float(u << 16); }
DI float bfhi(unsigned u) { return __uint_as_float(u & 0xffff0000u); }
DI float gelu_tanh(float x) {
    const float t = x * (1.0f + 0.044715f * x * x);
    return x * __builtin_amdgcn_rcpf(1.0f + __builtin_amdgcn_exp2f(-2.3022081984f * t));
}
DI float wave_sum(float v) {
#pragma unroll
    for (int o = 1; o < 64; o <<= 1) v += __shfl_xor(v, o);
    return v;
}
DI float row16_sum(float x) {
    x += __builtin_bit_cast(float, __builtin_amdgcn_update_dpp(0, __builtin_bit_cast(int, x), 0x128, 0xf, 0xf, false));
    x += __builtin_bit_cast(float, __builtin_amdgcn_update_dpp(0, __builtin_bit_cast(int, x), 0x124, 0xf, 0xf, false));
    x += __builtin_bit_cast(float, __builtin_amdgcn_update_dpp(0, __builtin_bit_cast(int, x), 0x122, 0xf, 0xf, false));
    x += __builtin_bit_cast(float, __builtin_amdgcn_update_dpp(0, __builtin_bit_cast(int, x), 0x121, 0xf, 0xf, false));
    return x;
}
#define LDS_WAIT() asm volatile("s_waitcnt lgkmcnt(0)" ::: "memory")
#define VM_WAIT() asm volatile("s_waitcnt vmcnt(0)" ::: "memory")

namespace pg8 {
constexpr int BM = 256, BK = 64, HALF = 128, HTB = HALF * BK * 2, STAGE_BYTES = 8 * HTB, NXCD = 8, WGM = 8;
DI int lds_byte(int r, int c) { const int st = (r >> 4) * 2 + (c >> 5), rr = r & 15, cc = c & 31, ob = rr * 64 + cc * 2; return st * 1024 + (ob ^ (((ob >> 9) & 1) << 5)); }
DI void stage_rc(int b, int& R, int& C) { const int st = b / 1024, sb = b % 1024, swz = sb ^ (((sb >> 9) & 1) << 5); R = (st >> 1) * 16 + swz / 64; C = (st & 1) * 32 + (swz % 64) / 2; }
DI int perm32(int rho) { const int n = rho >> 4, i = rho & 15; return 8 * (i >> 2) + 4 * n + (i & 3); }

typedef int v8i __attribute__((ext_vector_type(8))); typedef int v4i __attribute__((ext_vector_type(4)));
DI v8i cat8(bf16x8 a, bf16x8 b) { return __builtin_shufflevector(__builtin_bit_cast(v4i, a), __builtin_bit_cast(v4i, b), 0, 1, 2, 3, 4, 5, 6, 7); }
struct Unit { int pm, pn, kind, aux; const char* pA; const char* pB; };
struct Job { const bf16* A; const bf16* Bt; int nM, nN, kind, aux; int pm0 = 0, pn0 = 0; };
constexpr size_t TSTEP = (size_t)BM * KDIM * 2;

template <class JT, size_t TS = TSTEP> struct MultiOrder {
    JT jt; int G, c;
    DI bool next(int i, Unit& u) const {
        int L = i * G + c;
#pragma unroll
        for (int k = 0; k < JT::NJ; ++k) {
            const Job jb = jt.job(k);
            const int nM = jb.nM, nN = jb.nN, nwg = nM * nN;
            if (L < nwg) {
                unsigned wgid = (unsigned)L; { const unsigned q = (unsigned)nwg / NXCD, r = (unsigned)nwg % NXCD, xcd = wgid % NXCD, off = wgid / NXCD; wgid = (xcd < r ? xcd * (q + 1) : r * (q + 1) + (xcd - r) * q) + off; }
                const unsigned nig = WGM * (unsigned)nN, gid = wgid / nig, fm = gid * WGM, gsz = ((unsigned)nM - fm) < WGM ? ((unsigned)nM - fm) : WGM;
                u.pm = (int)(fm + ((wgid % nig) % gsz)); u.pn = (int)((wgid % nig) / gsz); u.kind = jb.kind; u.aux = jb.aux;
                u.pA = (const char*)jb.A + (size_t)u.pm * TS; u.pB = (const char*)jb.Bt + (size_t)u.pn * TS; u.pm += jb.pm0; u.pn += jb.pn0;
                return true;
            }
            L -= nwg;
        }
        return false;
    }
};

template <class Epi, class Sched, bool F8 = false>
DI void gemm_phase(LAS unsigned char* lds, const Sched& S, const Epi& E, const int tid) {
    constexpr int K = F8 ? KDIM / 2 : KDIM;
    const int wid = __builtin_amdgcn_readfirstlane(tid >> 6), lane = tid & 63, wr = wid >> 2, wc = wid & 3, fr = lane & 15, fq = lane >> 4;
    constexpr int nt = K / BK;
    unsigned voffA[2], voffB[2];
#pragma unroll
    for (int i = 0; i < 2; ++i) { int R, C; stage_rc(tid * 16 + i * 8192, R, C); const int Rb = ((R & ~31) + perm32(R & 31));
        voffA[i] = (unsigned)(R * K + C) * 2u; voffB[i] = (unsigned)(Rb * K + C) * 2u; }
    const size_t kstep = (size_t)(BK * 2);
    const size_t hstep = (size_t)HALF * K * 2;
    const unsigned ldsw = (unsigned)wid * 1024u;
    const int aoff = lds_byte(wr * 64 + fr, fq * 8), boff = lds_byte(wc * 32 + fr, fq * 8);
#define PG8_SA(b, h) (((b) * 2 + (h)) * HTB)
#define PG8_SB(b, h) ((4 + (b) * 2 + (h)) * HTB)
#define PG8_STAGE(bufoff, gbase, voff) do { _Pragma("unroll") for (int _i = 0; _i < 2; ++_i) \
        __builtin_amdgcn_global_load_lds((const unsigned*)((const char*)(gbase) + (voff)[_i]), (LAS unsigned*)(lds + (bufoff) + ldsw + _i * 8192), 16, 0, 0); } while (0)
#define PG8_LDA(dst, b, h) do { _Pragma("unroll") for (int m = 0; m < 4; ++m) { dst[m].lo = *(const LAS v4i*)(lds + PG8_SA(b, h) + aoff + m * 2048); dst[m].hi = *(const LAS v4i*)(lds + PG8_SA(b, h) + aoff + m * 2048 + 1024); } } while (0)
#define PG8_LDB(dst, b, h) do { _Pragma("unroll") for (int n = 0; n < 2; ++n) { dst[n].lo = *(const LAS v4i*)(lds + PG8_SB(b, h) + boff + n * 2048); dst[n].hi = *(const LAS v4i*)(lds + PG8_SB(b, h) + boff + n * 2048 + 1024); } } while (0)
#define PG8_MMA(ai, bj, At, Bt) do { __builtin_amdgcn_s_setprio(1); _Pragma("unroll") for (int m = 0; m < 4; ++m) _Pragma("unroll") for (int n = 0; n < 2; ++n) { \
        if constexpr (F8) { asm volatile("v_mfma_scale_f32_16x16x128_f8f6f4 %0, %1, %2, %0, %3, %3 op_sel_hi:[0,0,0]" : "+v"(acc[ai][bj][m][n]) : "v"(Bt[n]), "v"(At[m]), "v"(sc1)); } \
        else { const v4i _bl = Bt[n].lo, _bh = Bt[n].hi, _al = At[m].lo, _ah = At[m].hi;     \
               acc[ai][bj][m][n] = __builtin_amdgcn_mfma_f32_16x16x32_bf16(__builtin_bit_cast(bf16x8, _bl), __builtin_bit_cast(bf16x8, _al), acc[ai][bj][m][n], 0, 0, 0); \
               acc[ai][bj][m][n] = __builtin_amdgcn_mfma_f32_16x16x32_bf16(__builtin_bit_cast(bf16x8, _bh), __builtin_bit_cast(bf16x8, _ah), acc[ai][bj][m][n], 0, 0, 0); } } __builtin_amdgcn_s_setprio(0); } while (0)
#define PG8_WAIT_V(n) asm volatile("s_waitcnt vmcnt(" #n ")" ::: "memory")
#define PG8_WAIT_L(n) asm volatile("s_waitcnt lgkmcnt(" #n ")" ::: "memory")
#define PG8_BAR __builtin_amdgcn_s_barrier()
#define PG8_SCHED __builtin_amdgcn_sched_barrier(0)
    Unit cur, nxt; int ui = 0;
    if (!S.next(0, cur)) return;
    f32x4 acc[2][2][4][2];
#pragma unroll
    for (int a = 0; a < 2; ++a)
#pragma unroll
        for (int b = 0; b < 2; ++b)
#pragma unroll
            for (int m = 0; m < 4; ++m)
#pragma unroll
                for (int n = 0; n < 2; ++n) acc[a][b][m][n] = (f32x4){0.f, 0.f, 0.f, 0.f};
    const int sc1 = 0x7F7F7F7F;
    v8i At[4], B0[2], B1[2];
    const char* cA = cur.pA; const char* cB = cur.pB;
    PG8_STAGE(PG8_SB(0, 0), cB, voffB); PG8_STAGE(PG8_SB(0, 1), cB + hstep, voffB); PG8_STAGE(PG8_SA(0, 0), cA, voffA); PG8_STAGE(PG8_SA(0, 1), cA + hstep, voffA);
    if (wr == 1) PG8_BAR;
    PG8_WAIT_V(2); PG8_BAR;
    PG8_STAGE(PG8_SB(1, 0), cB + kstep, voffB); PG8_STAGE(PG8_SA(1, 0), cA + kstep, voffA); PG8_STAGE(PG8_SB(1, 1), cB + hstep + kstep, voffB);
    PG8_WAIT_V(6); PG8_BAR;
    for (;;) {
        const bool has_next = S.next(ui + 1, nxt);
        const char* nA = has_next ? nxt.pA : cA; const char* nB = has_next ? nxt.pB : cB;
        for (int t = 0; t < nt; t += 2) {
            const bool last = (t == nt - 2);
            const char* a1 = cA + (size_t)(t + 1) * kstep;
            const char* a2 = last ? nA : cA + (size_t)(t + 2) * kstep; const char* b2 = last ? nB : cB + (size_t)(t + 2) * kstep;
            const char* a3 = a2 + kstep; const char* b3 = b2 + kstep;
            PG8_LDB(B0, 0, 0); PG8_LDB(B1, 0, 1); PG8_SCHED; PG8_LDA(At, 0, 0); PG8_STAGE(PG8_SA(1, 1), a1 + hstep, voffA);
            PG8_WAIT_V(8); PG8_WAIT_L(0); PG8_BAR; PG8_MMA(0, 0, At, B0); PG8_MMA(0, 1, At, B1); PG8_BAR; PG8_SCHED;
            PG8_LDA(At, 0, 1); PG8_STAGE(PG8_SB(0, 0), b2, voffB); PG8_STAGE(PG8_SB(0, 1), b2 + hstep, voffB); PG8_STAGE(PG8_SA(0, 0), a2, voffA);
            PG8_WAIT_V(8); PG8_WAIT_L(0); PG8_BAR; PG8_MMA(1, 0, At, B0); PG8_MMA(1, 1, At, B1); PG8_BAR; PG8_SCHED;
            PG8_LDB(B0, 1, 0); PG8_LDB(B1, 1, 1); PG8_SCHED; PG8_LDA(At, 1, 0); PG8_STAGE(PG8_SA(0, 1), a2 + hstep, voffA);
            PG8_WAIT_V(8); PG8_WAIT_L(0); PG8_BAR; PG8_MMA(0, 0, At, B0); PG8_MMA(0, 1, At, B1); PG8_BAR; PG8_SCHED;
            PG8_LDA(At, 1, 1); PG8_STAGE(PG8_SB(1, 0), b3, voffB); PG8_STAGE(PG8_SB(1, 1), b3 + hstep, voffB); PG8_STAGE(PG8_SA(1, 0), a3, voffA);
            PG8_WAIT_V(8); PG8_WAIT_L(0); PG8_BAR; PG8_MMA(1, 0, At, B0); PG8_MMA(1, 1, At, B1); PG8_BAR; PG8_SCHED;
        }
        if (wr == 0) PG8_BAR;
        if constexpr (F8) asm volatile("s_nop 15\n\ts_nop 15" ::: "memory");
        E(acc, cur, wr, wc, fr, fq);
        if (!has_next) break;
#pragma unroll
        for (int a = 0; a < 2; ++a)
#pragma unroll
            for (int b = 0; b < 2; ++b)
#pragma unroll
                for (int m = 0; m < 4; ++m)
#pragma unroll
                    for (int n = 0; n < 2; ++n) acc[a][b][m][n] = (f32x4){0.f, 0.f, 0.f, 0.f};
        cur = nxt; cA = nA; cB = nB; ++ui;
        if (wr == 1) PG8_BAR;
    }
    PG8_WAIT_V(0);
    PG8_BAR;
#undef PG8_SA
#undef PG8_SB
#undef PG8_STAGE
#undef PG8_LDA
#undef PG8_LDB
#undef PG8_MMA
#undef PG8_WAIT_V
#undef PG8_WAIT_L
#undef PG8_BAR
#undef PG8_SCHED
}
}

#define XB_TMO      128
#define XB_XCNT(j)  (256  + 64 * (j))
#define XB_XSUB(j)  (1280 + 64 * (j))
#define XB_XGEN(j)  (2304 + 64 * (j))
#define XB_TOP      3328
#define XB_TOPGEN   3392
#define XCD_BAR_WORDS 3456
#define XB_SPIN_CAP (1u << 22)

DI unsigned xb_ld(unsigned* p)              { return __hip_atomic_load(p, __ATOMIC_RELAXED, __HIP_MEMORY_SCOPE_AGENT); }
DI unsigned xb_add(unsigned* p, unsigned v) { return __hip_atomic_fetch_add(p, v, __ATOMIC_RELAXED, __HIP_MEMORY_SCOPE_AGENT); }
DI unsigned xb_xcc_id() { return (unsigned)__builtin_amdgcn_s_getreg((3 << 11) | 20) & 0xFu; }
#define XB_SPIN(cond, bar) do { unsigned _sp = 0; while (cond) { __builtin_amdgcn_s_sleep(1); \
    if ((++_sp & 255u) == 0u) { if (xb_ld(&(bar)[XB_TMO])) break; if (_sp > XB_SPIN_CAP) { atomicAdd(&(bar)[XB_TMO], 1u); break; } } } } while (0)

struct XcdBarrier { unsigned* bar; unsigned x; volatile LAS unsigned* st; };

DI XcdBarrier xcd_barrier_post(unsigned* bar, volatile LAS unsigned* st) {
    XcdBarrier b; b.bar = bar; b.x = xb_xcc_id(); b.st = st;
    if (threadIdx.x == 0) st[2] = xb_add(&bar[XB_XCNT(b.x)], 1u);
    return b;
}
DI void xcd_barrier_complete(unsigned* bar, unsigned x, unsigned& nloc, unsigned& nx) {
    const unsigned G = gridDim.x * gridDim.y * gridDim.z;
    unsigned sum, cnt, mine, sp = 0u;
    for (;;) {
        sum = 0u; cnt = 0u; mine = 0u;
#pragma unroll
        for (unsigned j = 0; j < 16; ++j) { const unsigned c = xb_ld(&bar[XB_XCNT(j)]); sum += c; cnt += (c > 0u) ? 1u : 0u; mine = (j == x) ? c : mine; }
        if (sum == G) break;
        __builtin_amdgcn_s_sleep(1);
        if ((++sp & 255u) == 0u) { if (xb_ld(&bar[XB_TMO])) break; if (sp > XB_SPIN_CAP) { atomicAdd(&bar[XB_TMO], 1u); break; } }
    }
    nloc = mine > 0u ? mine : 1u; nx = cnt > 0u ? cnt : 1u;
}
DI void xcd_barrier(const XcdBarrier& b) {
    asm volatile("s_waitcnt vmcnt(0)" ::: "memory");
    __syncthreads();
    if (threadIdx.x == 0) {
        unsigned* bar = b.bar;
        __builtin_amdgcn_s_waitcnt(0);
        unsigned nloc = b.st[0], nx = b.st[1];
        if (nloc == 0u) { xcd_barrier_complete(bar, b.x, nloc, nx); b.st[0] = nloc; b.st[1] = nx; }
        const unsigned old = xb_add(&bar[XB_XSUB(b.x)], 1u);
        const unsigned gen = old / nloc;
        if (old + 1u == (gen + 1u) * nloc) {
            __builtin_amdgcn_fence(__ATOMIC_RELEASE, "agent");
            asm volatile("s_waitcnt vmcnt(0)" ::: "memory");
            const unsigned og = xb_add(&bar[XB_TOP], 1u);
            const unsigned tg = og / nx;
            if (og + 1u == (tg + 1u) * nx) xb_add(&bar[XB_TOPGEN], 1u);
            else XB_SPIN(xb_ld(&bar[XB_TOPGEN]) == tg, bar);
            __builtin_amdgcn_fence(__ATOMIC_ACQUIRE, "agent");
            xb_add(&bar[XB_XGEN(b.x)], 1u);
            asm volatile("s_waitcnt vmcnt(0)" ::: "memory");
        } else {
            XB_SPIN(xb_ld(&bar[XB_XGEN(b.x)]) == gen, bar);
            __builtin_amdgcn_fence(__ATOMIC_ACQUIRE, "agent");
            asm volatile("s_waitcnt vmcnt(0)" ::: "memory");
        }
    }
    __syncthreads();
}

struct Args { const float* in[24]; float* out; unsigned char* ws; int ph_lo, ph_hi, dup, pad; };
enum { I_XP = 0, I_XS, I_CBK, I_CBV, I_CMK, I_CMV, I_MEMP, I_WINA, I_SLNG, I_SLNB, I_SGUW, I_SGUB, I_WINB, I_RELB, I_WMKV, I_WOUT,
       I_LN1G, I_LN1B, I_LN2G, I_LN2B, I_PWQ, I_PKEYS, I_PU, I_PV };

DI void tr_item_load(const float* W, int N, int ldw, int item, int lane, f32x4 (&v)[16]) {
    const int nblk = N / 64, kb = item / nblk, nb = item % nblk, k0 = 64 * kb, n0 = 64 * nb;
#pragma unroll
    for (int i = 0; i < 16; ++i) v[i] = *(const f32x4*)(W + (size_t)(k0 + 4 * i + (lane >> 4)) * ldw + n0 + 4 * (lane & 15));
}
DI void tr_item_store(const f32x4 (&v)[16], int K, int N, bf16* WT, unsigned char* W8T, float scale, LAS float* scr, int item, int lane) {
    const int nblk = N / 64, kb = item / nblk, nb = item % nblk, k0 = 64 * kb, n0 = 64 * nb;
#pragma unroll
    for (int i = 0; i < 16; ++i) { LAS float* p = scr + (4 * i + (lane >> 4)) * 65 + 4 * (lane & 15); p[0] = v[i][0]; p[1] = v[i][1]; p[2] = v[i][2]; p[3] = v[i][3]; }
    LDS_WAIT(); asm volatile("" ::: "memory");
    const int c = lane >> 3, nl = lane & 7;
#pragma unroll
    for (int j = 0; j < 8; ++j) { const int n = nl + 8 * j; const LAS float* s = scr + (8 * c) * 65 + n;
        const float e0 = s[0 * 65], e1 = s[1 * 65], e2 = s[2 * 65], e3 = s[3 * 65], e4 = s[4 * 65], e5 = s[5 * 65], e6 = s[6 * 65], e7 = s[7 * 65];
        if (WT) { u32x4 o; o.x = pk2(e0, e1); o.y = pk2(e2, e3); o.z = pk2(e4, e5); o.w = pk2(e6, e7); *(u32x4*)(WT + (size_t)(n0 + n) * K + k0 + 8 * c) = o; }
        if (W8T) { u32x2 o8; o8.x = pk4_fp8(e0 * scale, e1 * scale, e2 * scale, e3 * scale); o8.y = pk4_fp8(e4 * scale, e5 * scale, e6 * scale, e7 * scale); *(u32x2*)(W8T + (size_t)(n0 + n) * K + k0 + 8 * c) = o8; } }
    LDS_WAIT(); asm volatile("" ::: "memory");
}
DI void tr_generic(const float* src, int K, int N, int ldw, int nmat, size_t sstride, bf16* dstb, unsigned char* dst8, size_t dstride, float scale, LAS float* scr, int gw, int ngw, int lane) {
    const int per = (K / 64) * (N / 64), total = per * nmat;
    f32x4 va[16], vb[16];
    int it = gw; if (it >= total) return;
#define TRG_LOAD(v, i) do { const int _mi = (i) / per; tr_item_load(src + (size_t)_mi * sstride, N, ldw, (i) - _mi * per, lane, v); } while (0)
#define TRG_STORE(v, i) do { const int _mi = (i) / per; tr_item_store(v, K, N, dstb ? dstb + (size_t)_mi * dstride : nullptr, dst8 ? dst8 + (size_t)_mi * dstride : nullptr, scale, scr, (i) - _mi * per, lane); } while (0)
    TRG_LOAD(va, it);
#pragma unroll 1
    for (; it < total; it += 2 * ngw) {
        const int i2 = it + ngw, i3 = i2 + ngw;
        if (i2 < total) TRG_LOAD(vb, i2);
        TRG_STORE(va, it);
        if (i3 < total) TRG_LOAD(va, i3);
        if (i2 < total) TRG_STORE(vb, i2);
    }
#undef TRG_LOAD
#undef TRG_STORE
}
DI void tr_job_both(const float* src, bf16* dst, unsigned char* dst8, int K, int N, int ldw, float scale, LAS float* scr, int gw, int ngw, int lane) { tr_generic(src, K, N, ldw, 1, 0, dst, dst8, 0, scale, scr, gw, ngw, lane); }
DI void tr_job8(const float* src, unsigned char* dst, int K, int N, int ldw, float scale, LAS float* scr, int gw, int ngw, int lane) { tr_generic(src, K, N, ldw, 1, 0, nullptr, dst, 0, scale, scr, gw, ngw, lane); }
DI void tr_job(const float* src, bf16* dst, int K, int N, int nmat, size_t sstride, size_t dstride, LAS float* scr, int gw, int ngw, int lane) { tr_generic(src, K, N, N, nmat, sstride, dst, nullptr, dstride, 1.f, scr, gw, ngw, lane); }
DI void tr_job_ld(const float* src, bf16* dst, int K, int N, int ldw, LAS float* scr, int gw, int ngw, int lane) { tr_generic(src, K, N, ldw, 1, 0, dst, nullptr, 0, 1.f, scr, gw, ngw, lane); }
DI void cvt_job(const float* src, bf16* dst, size_t n, size_t gtid, size_t nthr, unsigned char* dst8 = nullptr, float scale8 = 1.f) {
    const size_t n8 = n / 8;
    for (size_t i0 = gtid; i0 < n8; i0 += 4 * nthr) {
        f32x4 a[4], b[4];
#pragma unroll
        for (int u = 0; u < 4; ++u) { const size_t i = i0 + u * nthr; if (i < n8) { a[u] = ((const f32x4*)src)[2 * i]; b[u] = ((const f32x4*)src)[2 * i + 1]; } }
#pragma unroll
        for (int u = 0; u < 4; ++u) { const size_t i = i0 + u * nthr; if (i < n8) { u32x4 o; o.x = pk2(a[u][0], a[u][1]); o.y = pk2(a[u][2], a[u][3]); o.z = pk2(b[u][0], b[u][1]); o.w = pk2(b[u][2], b[u][3]); ((u32x4*)dst)[i] = o;
            if (dst8) { u32x2 o8; o8.x = pk4_fp8(a[u][0] * scale8, a[u][1] * scale8, a[u][2] * scale8, a[u][3] * scale8); o8.y = pk4_fp8(b[u][0] * scale8, b[u][1] * scale8, b[u][2] * scale8, b[u][3] * scale8); ((u32x2*)dst8)[i] = o8; } } }
    }
}
DI void fp4_row_load(const float* src, int r, int lane, f32x4 (&v)[8][2]) {
    const f32x4* sp = (const f32x4*)(src + (size_t)r * D);
#pragma unroll
    for (int j = 0; j < 8; ++j)
#pragma unroll
        for (int hh = 0; hh < 2; ++hh) v[j][hh] = sp[(j * 64 + lane) * 2 + hh];
}
DI void fp4_row_store(const f32x4 (&v)[8][2], unsigned* dst, float* sc, int r, int lane) {
    float am = 0.f;
#pragma unroll
    for (int j = 0; j < 8; ++j)
#pragma unroll
        for (int hh = 0; hh < 2; ++hh) am = fmaxf(am, fmaxf(fmaxf(fabsf(v[j][hh][0]), fabsf(v[j][hh][1])), fmaxf(fabsf(v[j][hh][2]), fabsf(v[j][hh][3]))));
#pragma unroll
    for (int o = 1; o < 64; o <<= 1) am = fmaxf(am, __shfl_xor(am, o));
    const float mul = am > 0.f ? 6.0f / am : 1.0f;
#pragma unroll
    for (int j = 0; j < 8; ++j) { unsigned w = 0u;
        w = __builtin_amdgcn_cvt_scalef32_pk_fp4_f32(w, v[j][0][0] * mul, v[j][0][1] * mul, 1.0f, 0); w = __builtin_amdgcn_cvt_scalef32_pk_fp4_f32(w, v[j][0][2] * mul, v[j][0][3] * mul, 1.0f, 1);
        w = __builtin_amdgcn_cvt_scalef32_pk_fp4_f32(w, v[j][1][0] * mul, v[j][1][1] * mul, 1.0f, 2); w = __builtin_amdgcn_cvt_scalef32_pk_fp4_f32(w, v[j][1][2] * mul, v[j][1][3] * mul, 1.0f, 3);
        dst[(size_t)(2 * j + (lane >> 5)) * (NEXP * 32) + (size_t)r * 32 + (lane & 31)] = w; }
    if (lane == 0) sc[r] = am > 0.f ? am * (1.0f / 6.0f) : 1.0f;
}
DI void fp4_rows_job(const float* src, unsigned* dst, float* sc, int r0, int nrows, int gw, int ngw, int lane) {
    f32x4 va[8][2], vb[8][2];
    int r = r0 + gw; if (r >= nrows) return;
    fp4_row_load(src, r, lane, va);
#pragma unroll 1
    for (; r < nrows; r += 2 * ngw) {
        const int r2 = r + ngw, r3 = r2 + ngw;
        if (r2 < nrows) fp4_row_load(src, r2, lane, vb);
        fp4_row_store(va, dst, sc, r, lane);
        if (r3 < nrows) fp4_row_load(src, r3, lane, va);
        if (r2 < nrows) fp4_row_store(vb, dst, sc, r2, lane);
    }
}

enum { K_U = 0, K_QM, K_VT0, K_MEMKV, K_MEMVT, K_OUT, K_WQ, K_Q, K_KK, K_VT1 };
DI void st_bf16x8(bf16* p, f32x4 v0, f32x4 v1) { u32x4 w; w.x = pk2(v0[0], v0[1]); w.y = pk2(v0[2], v0[3]); w.z = pk2(v1[0], v1[1]); w.w = pk2(v1[2], v1[3]); *(u32x4*)p = w; }


DI pg8::Job mkjob(const void* A, const void* Bt, int nM, int nN, int kind, int aux, int pm0, int pn0) { pg8::Job j{(const bf16*)A, (const bf16*)Bt, nM, nN, kind, aux}; j.pm0 = pm0; j.pn0 = pn0; return j; }
struct JobsA { static constexpr int NJ = 5; const bf16 *XB, *Wa, *MEMB, *Wmkv;
    DI pg8::Job job(int k) const {
        switch (k) {
            case 0: return mkjob(Wa + (size_t)3072 * KDIM, XB + (size_t)32 * 256 * KDIM, 12, 2, K_VT0, 0, 0, 32);
            case 1: return pg8::Job{MEMB, Wmkv, 2, 8, K_MEMKV, 0};
            case 2: return pg8::Job{MEMB, Wmkv + (size_t)2048 * KDIM, 2, 8, K_MEMKV, 1};
            case 3: return pg8::Job{Wmkv + (size_t)1024 * KDIM, MEMB, 4, 2, K_MEMVT, 0};
            default: return pg8::Job{Wmkv + (size_t)(2048 + 1024) * KDIM, MEMB, 4, 2, K_MEMVT, 1};
        } } };
struct JobsA8 { static constexpr int NJ = 3; const unsigned char *X8, *W8;
    DI pg8::Job job(int k) const {
        if (k == 0) return mkjob(X8, W8, 34, 12, K_U, 0, 0, 0);
        if (k == 1) return mkjob(W8 + (size_t)4096 * KDIM, X8, 12, 32, K_VT0, 1, 0, 0);
        return mkjob(X8, W8 + (size_t)3072 * KDIM, 34, 4, K_QM, 0, 0, 0); } };
struct JobsB { static constexpr int NJ = 6; const bf16 *XB, *Wb;
    DI pg8::Job job(int k) const {
        const int p0 = (k % 3 == 0) ? 14 : (k % 3 == 1 ? 30 : 32);
        if (k < 3) return mkjob(XB + (size_t)p0 * 256 * KDIM, Wb + (size_t)3072 * KDIM, 2, 12, K_KK, 0, p0, 0);
        return mkjob(Wb + (size_t)6144 * KDIM, XB + (size_t)p0 * 256 * KDIM, 12, 2, K_VT1, 0, 0, p0); } };
struct JobsB8 { static constexpr int NJ = 6; const unsigned char *X8, *W8;
    DI pg8::Job job(int k) const {
        switch (k) {
            case 0: return mkjob(X8, W8, 34, 12, K_Q, 0, 0, 0);
            case 1: return mkjob(X8, W8 + (size_t)4096 * KDIM, 14, 12, K_KK, 1, 0, 0);
            case 2: return mkjob(X8 + (size_t)16 * 256 * KDIM, W8 + (size_t)4096 * KDIM, 14, 12, K_KK, 1, 16, 0);
            case 3: return mkjob(W8 + (size_t)7168 * KDIM, X8, 12, 14, K_VT1, 1, 0, 0);
            case 4: return mkjob(W8 + (size_t)7168 * KDIM, X8 + (size_t)16 * 256 * KDIM, 12, 14, K_VT1, 1, 0, 16);
            default: return mkjob(X8, W8 + (size_t)3072 * KDIM, 34, 4, K_QM, 0, 0, 0);
        } } };
struct Jobs1 { static constexpr int NJ = 1; const bf16 *A, *Bt; int nN, kind;
    DI pg8::Job job(int) const { return pg8::Job{A, Bt, 34, nN, kind, 0}; } };

struct EpiA {
    bf16* U; bf16* QM; bf16* VT; float* vst; float* out; bf16* MKB; bf16* MVT;
    DI void operator()(const f32x4 (&acc)[2][2][4][2], const pg8::Unit& u, int wr, int wc, int fr, int fq) const {
        const int row0 = u.pm * 256 + wr * 64 + fr, col0 = u.pn * 256 + wc * 32 + 8 * fq;
        if (u.kind == K_U) {
#pragma unroll
            for (int ai = 0; ai < 2; ++ai)
#pragma unroll
                for (int m = 0; m < 4; ++m) { bf16* rowp = U + (size_t)(row0 + ai * 128 + m * 16) * TOK + col0;
#pragma unroll
                    for (int bj = 0; bj < 2; ++bj) { f32x4 v0 = acc[ai][bj][m][0], v1 = acc[ai][bj][m][1];
#pragma unroll
                        for (int i = 0; i < 4; ++i) { v0[i] = gelu_tanh(v0[i] * (1.0f / (XB_SCALE * WIN_SCALE))); v1[i] = gelu_tanh(v1[i] * (1.0f / (XB_SCALE * WIN_SCALE))); }
                        st_bf16x8(rowp + bj * 128, v0, v1); } }
        } else if (u.kind == K_QM) {
#pragma unroll
            for (int ai = 0; ai < 2; ++ai)
#pragma unroll
                for (int m = 0; m < 4; ++m) { bf16* rowp = QM + (size_t)(row0 + ai * 128 + m * 16) * MEMW + col0;
#pragma unroll
                    for (int bj = 0; bj < 2; ++bj) st_bf16x8(rowp + bj * 128, acc[ai][bj][m][0] * (0.0625f * (1.0f / (XB_SCALE * WIN_SCALE))), acc[ai][bj][m][1] * (0.0625f * (1.0f / (XB_SCALE * WIN_SCALE)))); }
        } else if (u.kind == K_VT0) {
            const int slot = u.pm * 2 + wr;
            const float ds = u.aux ? (1.0f / (XB_SCALE * WIN_SCALE)) : 1.0f;
#pragma unroll
            for (int bj = 0; bj < 2; ++bj)
#pragma unroll
                for (int n = 0; n < 2; ++n) {
                    float cs[4], cq[4];
#pragma unroll
                    for (int i = 0; i < 4; ++i) { cs[i] = 0.f; cq[i] = 0.f; }
#pragma unroll
                    for (int ai = 0; ai < 2; ++ai)
#pragma unroll
                        for (int m = 0; m < 4; ++m) { bf16* rowp = VT + (unsigned)((row0 + ai * 128 + m * 16) * M + col0 + bj * 128 + 4 * n);
                            f32x4 v0 = acc[ai][bj][m][n];
#pragma unroll
                            for (int i = 0; i < 4; ++i) { v0[i] = gelu_tanh(v0[i] * ds); cs[i] += v0[i]; cq[i] += v0[i] * v0[i]; }
                            u32x2 w; w.x = pk2(v0[0], v0[1]); w.y = pk2(v0[2], v0[3]); *(u32x2*)rowp = w; }
                    float ms = 0.f, mq = 0.f;
#pragma unroll
                    for (int i = 0; i < 4; ++i) { const float s = row16_sum(cs[i]), q = row16_sum(cq[i]); if (fr == i) { ms = s; mq = q; } }
                    if (fr < 4) { const int tokc = u.pn * 256 + bj * 128 + wc * 32 + 8 * fq + 4 * n + fr; *(f32x2*)(vst + ((size_t)slot * M + tokc) * 2) = (f32x2){ms, mq}; }
                    asm volatile("" ::: "memory");
                }
        } else if (u.kind == K_MEMKV) {
            const int li = u.aux; const bool isk = u.pn < 4;
            float* ob = out + (isk ? O_MKP : O_MVP) + (size_t)li * 512 * 1024; const int cc = col0 - (isk ? 0 : 1024);
#pragma unroll
            for (int ai = 0; ai < 2; ++ai)
#pragma unroll
                for (int m = 0; m < 4; ++m) { const int row = row0 + ai * 128 + m * 16;
#pragma unroll
                    for (int bj = 0; bj < 2; ++bj) { float* p = ob + (size_t)row * 1024 + cc + bj * 128;
                        *(f32x4*)p = acc[ai][bj][m][0]; *(f32x4*)(p + 4) = acc[ai][bj][m][1];
                        if (isk) st_bf16x8(MKB + ((size_t)li * 512 + row) * 1024 + cc + bj * 128, acc[ai][bj][m][0], acc[ai][bj][m][1]); } }
        } else {
            const int li = u.aux;
#pragma unroll
            for (int ai = 0; ai < 2; ++ai)
#pragma unroll
                for (int m = 0; m < 4; ++m) { bf16* rowp = MVT + ((size_t)li * 1024 + row0 + ai * 128 + m * 16) * 512 + col0;
#pragma unroll
                    for (int bj = 0; bj < 2; ++bj) st_bf16x8(rowp + bj * 128, acc[ai][bj][m][0], acc[ai][bj][m][1]); }
        }
    }
};

template <bool XBF> struct EpiOut {
    const void* xp; const void* xs; bf16* Z;
    DI void operator()(const f32x4 (&acc)[2][2][4][2], const pg8::Unit& u, int wr, int wc, int fr, int fq) const {
        const int row0 = u.pm * 256 + wr * 64 + fr, col0 = u.pn * 256 + wc * 32 + 8 * fq;
#pragma unroll
        for (int ai = 0; ai < 2; ++ai)
#pragma unroll
            for (int m = 0; m < 4; ++m) { const size_t off = (size_t)(row0 + ai * 128 + m * 16) * D + col0;
#pragma unroll
                for (int bj = 0; bj < 2; ++bj) { f32x4 x0, x1;
                    if (XBF) { const bf16* xb = (u.pm < 32) ? (const bf16*)xp : ((const bf16*)xs - (size_t)MP * D); const u32x4 r = *(const u32x4*)(xb + off + bj * 128);
                        x0 = (f32x4){bflo(r.x), bfhi(r.x), bflo(r.y), bfhi(r.y)}; x1 = (f32x4){bflo(r.z), bfhi(r.z), bflo(r.w), bfhi(r.w)}; }
                    else { const float* xb = (u.pm < 32) ? (const float*)xp : ((const float*)xs - (size_t)MP * D); x0 = *(const f32x4*)(xb + off + bj * 128); x1 = *(const f32x4*)(xb + off + bj * 128 + 4); }
                    st_bf16x8(Z + off + bj * 128, x0 * ALPHA + acc[ai][bj][m][0] * (1.0f / (CAT_SCALE * WOUT_SCALE)), x1 * ALPHA + acc[ai][bj][m][1] * (1.0f / (CAT_SCALE * WOUT_SCALE))); } }
    }
};
struct EpiWq {
    bf16* PQ;
    DI void operator()(const f32x4 (&acc)[2][2][4][2], const pg8::Unit& u, int wr, int wc, int fr, int fq) const {
        const int row0 = u.pm * 256 + wr * 64 + fr, col0 = u.pn * 256 + wc * 32 + 8 * fq;
#pragma unroll
        for (int ai = 0; ai < 2; ++ai)
#pragma unroll
            for (int m = 0; m < 4; ++m) { bf16* rowp = PQ + (size_t)(row0 + ai * 128 + m * 16) * 2048 + col0;
#pragma unroll
                for (int bj = 0; bj < 2; ++bj) st_bf16x8(rowp + bj * 128, acc[ai][bj][m][0], acc[ai][bj][m][1]); }
    }
};
template <bool F8P> struct EpiB {
    bf16* Q; bf16* Kb; bf16* QM; bf16* VT; float* out;
    DI void operator()(const f32x4 (&acc)[2][2][4][2], const pg8::Unit& u, int wr, int wc, int fr, int fq) const {
        const int row0 = u.pm * 256 + wr * 64 + fr, col0 = u.pn * 256 + wc * 32 + 8 * fq;
        constexpr float ds = F8P ? (1.0f / (XB_SCALE * WIN_SCALE)) : 1.0f;
        if (F8P && (u.kind == K_Q || u.kind == K_QM)) {
            const bool isq = u.kind == K_Q; bf16* base = isq ? Q : QM; const int ld = isq ? TOK : MEMW;
            const float sc = (isq ? 0.08838834764831845f : 0.0625f) * ds;
#pragma unroll
            for (int ai = 0; ai < 2; ++ai)
#pragma unroll
                for (int m = 0; m < 4; ++m) { bf16* rowp = base + (size_t)(row0 + ai * 128 + m * 16) * ld + col0;
#pragma unroll
                    for (int bj = 0; bj < 2; ++bj) st_bf16x8(rowp + bj * 128, acc[ai][bj][m][0] * sc, acc[ai][bj][m][1] * sc); }
        } else if (u.kind == K_KK) {
            float* fo = nullptr;
            if (!F8P) { if (u.pm >= 32) fo = out + O_BKS + (size_t)(u.pm - 32) * 256 * TOK; else fo = out + O_BKP + ((size_t)(u.pm >> 4) * 512 + ((u.pm & 15) - 14) * 256) * TOK; }
#pragma unroll
            for (int ai = 0; ai < 2; ++ai)
#pragma unroll
                for (int m = 0; m < 4; ++m) { const int rl = wr * 64 + fr + ai * 128 + m * 16; bf16* rowp = Kb + (size_t)(u.pm * 256 + rl) * TOK + col0;
#pragma unroll
                    for (int bj = 0; bj < 2; ++bj) { st_bf16x8(rowp + bj * 128, acc[ai][bj][m][0] * ds, acc[ai][bj][m][1] * ds);
                        if (!F8P) { float* p = fo + (size_t)rl * TOK + col0 + bj * 128; *(f32x4*)p = acc[ai][bj][m][0]; *(f32x4*)(p + 4) = acc[ai][bj][m][1]; } } }
        } else {
            float* fo = nullptr;
            if (!F8P) { if (u.pn >= 32) fo = out + O_BVS + (size_t)(u.pn - 32) * 256 * TOK; else fo = out + O_BVP + ((size_t)(u.pn >> 4) * 512 + ((u.pn & 15) - 14) * 256) * TOK; }
#pragma unroll
            for (int ai = 0; ai < 2; ++ai)
#pragma unroll
                for (int m = 0; m < 4; ++m) { const int ch = row0 + ai * 128 + m * 16; bf16* rowp = VT + (size_t)ch * M + col0;
#pragma unroll
                    for (int bj = 0; bj < 2; ++bj) { st_bf16x8(rowp + bj * 128, acc[ai][bj][m][0] * ds, acc[ai][bj][m][1] * ds);
                        if (!F8P) { float* p = fo + (size_t)(wc * 32 + 8 * fq + bj * 128) * TOK + ch;
#pragma unroll
                            for (int i = 0; i < 4; ++i) { p[(size_t)i * TOK] = acc[ai][bj][m][0][i]; p[(size_t)(4 + i) * TOK] = acc[ai][bj][m][1][i]; } } } }
        }
    }
};

template <int DH> struct AttnState {
    bf16x8 qf[DH / 32]; f32x4 o[DH / 16]; float m, l;
    DI void init(const bf16* qrow, int fq) {
#pragma unroll
        for (int ks = 0; ks < DH / 32; ++ks) qf[ks] = *(const bf16x8*)(qrow + ks * 32 + fq * 8);
#pragma unroll
        for (int db = 0; db < DH / 16; ++db) o[db] = (f32x4){0.f, 0.f, 0.f, 0.f};
        m = -1e30f; l = 0.f;
    }
    template <bool BIAS> DI void tile(const bf16* Kb, int kstride, const bf16* VTb, int vstride, int nblk, const float* rb, int dpos, int fr, int fq) {
        f32x4 s[4];
#pragma unroll
        for (int nb = 0; nb < 4; ++nb) { s[nb] = (f32x4){0.f, 0.f, 0.f, 0.f};
            if (nb < nblk) {
#pragma unroll
                for (int ks = 0; ks < DH / 32; ++ks) { const bf16x8 kf = *(const bf16x8*)(Kb + (size_t)(nb * 16 + fr) * kstride + ks * 32 + fq * 8);
                    s[nb] = __builtin_amdgcn_mfma_f32_16x16x32_bf16(kf, qf[ks], s[nb], 0, 0, 0); }
                if (BIAS) {
#pragma unroll
                    for (int j = 0; j < 4; ++j) { int rel = dpos - (nb * 16 + 4 * fq + j); rel = rel < -128 ? -128 : (rel > 128 ? 128 : rel); s[nb][j] += rb[rel + 128]; }
                }
            } else s[nb] = (f32x4){-1e30f, -1e30f, -1e30f, -1e30f};
        }
        float mx = -1e30f;
#pragma unroll
        for (int nb = 0; nb < 4; ++nb)
#pragma unroll
            for (int j = 0; j < 4; ++j) mx = fmaxf(mx, s[nb][j]);
        mx = fmaxf(mx, __shfl_xor(mx, 16)); mx = fmaxf(mx, __shfl_xor(mx, 32));
        const float mn = fmaxf(m, mx), alpha = __expf(m - mn); m = mn;
        float ps = 0.f;
#pragma unroll
        for (int nb = 0; nb < 4; ++nb)
#pragma unroll
            for (int j = 0; j < 4; ++j) { const float p = __expf(s[nb][j] - mn); s[nb][j] = p; ps += p; }
        l = l * alpha + ps;
#pragma unroll
        for (int db = 0; db < DH / 16; ++db) o[db] = o[db] * alpha;
#pragma unroll
        for (int kk = 0; kk < 2; ++kk) if (2 * kk < nblk) {
            u32x4 pw; pw.x = pk2(s[2 * kk][0], s[2 * kk][1]); pw.y = pk2(s[2 * kk][2], s[2 * kk][3]); pw.z = pk2(s[2 * kk + 1][0], s[2 * kk + 1][1]); pw.w = pk2(s[2 * kk + 1][2], s[2 * kk + 1][3]);
            const bf16x8 pf = __builtin_bit_cast(bf16x8, pw);
#pragma unroll
            for (int db = 0; db < DH / 16; ++db) { const bf16* vp = VTb + (size_t)(db * 16 + fr) * vstride + kk * 32 + 4 * fq;
                const u32x2 lo = *(const u32x2*)vp, hi = *(const u32x2*)(vp + 16); u32x4 vw; vw.x = lo.x; vw.y = lo.y; vw.z = hi.x; vw.w = hi.y;
                o[db] = __builtin_amdgcn_mfma_f32_16x16x32_bf16(__builtin_bit_cast(bf16x8, vw), pf, o[db], 0, 0, 0); }
        }
    }
    DI void finish(bf16* orow, int fq) {
        float lt = l; lt += __shfl_xor(lt, 16); lt += __shfl_xor(lt, 32);
        const float inv = 1.0f / lt;
#pragma unroll
        for (int db = 0; db < DH / 16; ++db) { u32x2 w; w.x = pk2(o[db][0] * inv, o[db][1] * inv); w.y = pk2(o[db][2] * inv, o[db][3] * inv); *(u32x2*)(orow + db * 16 + 4 * fq) = w; }
    }
};

template <int DH> struct AttnWG {
    static constexpr int VT0 = (DH / 64) * 8192, STAGE = VT0 + (DH / 128) * 16384, NDMA = DH / 64 + DH / 64;
    bf16x8 qf[DH / 32]; f32x4 o[DH / 16]; float m, l;
    DI void init(const bf16* qrow, int fq) {
#pragma unroll
        for (int ks = 0; ks < DH / 32; ++ks) qf[ks] = *(const bf16x8*)(qrow + ks * 32 + fq * 8);
#pragma unroll
        for (int db = 0; db < DH / 16; ++db) o[db] = (f32x4){0.f, 0.f, 0.f, 0.f};
        m = -1e30f; l = 0.f;
#pragma unroll
        for (int ks = 0; ks < DH / 32; ++ks) asm volatile("" : "+v"(qf[ks]));
    }
    static DI int kperm(int R) { return (R & 0x23) | ((R & 0x0C) << 1) | ((R & 0x10) >> 2); }
    static DI void dma16(const void* g, LAS unsigned char* l) {
        const unsigned la = __builtin_amdgcn_readfirstlane((unsigned)(unsigned long)l);
        asm volatile("s_mov_b32 m0, %0\n\ts_nop 0\n\tglobal_load_lds_dwordx4 %1, off" :: "s"(la), "v"(g) : "memory", "m0");
    }
    static DI void stage(LAS unsigned char* st, const bf16* kg, int kstride, const bf16* vg, int vstride, int sR, int sC, int wave) {
#pragma unroll
        for (int dh = 0; dh < DH / 64; ++dh) dma16(kg + (size_t)kperm(sR) * kstride + dh * 64 + sC, st + dh * 8192 + wave * 1024);
#pragma unroll
        for (int vb = 0; vb < DH / 128; ++vb)
#pragma unroll
            for (int hf = 0; hf < 2; ++hf) dma16(vg + (size_t)(vb * 128 + hf * 64 + sR) * vstride + sC, st + VT0 + vb * 16384 + hf * 8192 + wave * 1024);
    }
    template <bool BIAS> DI void tile(const LAS unsigned char* st, int nblk, const LAS float* rb, int dpos, int fr, int fq) {
        const int koff = (fr * 64 + fq * 16) ^ ((fr >> 3) << 5);
        const bool far = BIAS && (__builtin_amdgcn_readfirstlane(dpos - fr) - 63 >= 128); float bfar = 0.f; if (BIAS) bfar = rb[0];
        f32x4 s[4];
#pragma unroll
        for (int nb = 0; nb < 4; ++nb) { s[nb] = (f32x4){0.f, 0.f, 0.f, 0.f};
            if (nb < nblk) {
#pragma unroll
                for (int ks = 0; ks < DH / 32; ++ks) { const bf16x8 kf = *(const LAS bf16x8*)(st + (ks >> 1) * 8192 + (nb * 2 + (ks & 1)) * 1024 + koff);
                    s[nb] = __builtin_amdgcn_mfma_f32_16x16x32_bf16(kf, qf[ks], s[nb], 0, 0, 0); }
                if (DH > 128) __builtin_amdgcn_sched_barrier(0);
                if (BIAS) {
                    if (far) { s[nb] = s[nb] + bfar; }
                    else { const LAS float* bp = rb + (640 - dpos) + 8 * fq + (nb >> 1) * 32 + (nb & 1) * 4;
#pragma unroll
                        for (int j = 0; j < 4; ++j) s[nb][j] += bp[j]; }
                }
            } else s[nb] = (f32x4){-1e30f, -1e30f, -1e30f, -1e30f};
        }
        float mx = -1e30f;
#pragma unroll
        for (int nb = 0; nb < 4; ++nb)
#pragma unroll
            for (int j = 0; j < 4; ++j) mx = fmaxf(mx, s[nb][j]);
        mx = fmaxf(mx, __shfl_xor(mx, 16)); mx = fmaxf(mx, __shfl_xor(mx, 32));
        const float mn = fmaxf(m, mx), alpha = __expf(m - mn); m = mn;
        float ps = 0.f;
#pragma unroll
        for (int nb = 0; nb < 4; ++nb)
#pragma unroll
            for (int j = 0; j < 4; ++j) { const float p = __expf(s[nb][j] - mn); s[nb][j] = p; ps += p; }
        l = l * alpha + ps;
#pragma unroll
        for (int db = 0; db < DH / 16; ++db) o[db] = o[db] * alpha;
#pragma unroll
        for (int kk = 0; kk < 2; ++kk) if (2 * kk < nblk) {
            u32x4 pw; pw.x = pk2(s[2 * kk][0], s[2 * kk][1]); pw.y = pk2(s[2 * kk][2], s[2 * kk][3]); pw.z = pk2(s[2 * kk + 1][0], s[2 * kk + 1][1]); pw.w = pk2(s[2 * kk + 1][2], s[2 * kk + 1][3]);
            const bf16x8 pf = __builtin_bit_cast(bf16x8, pw);
#pragma unroll
            for (int db = 0; db < DH / 16; ++db) { const bf16x8 vf = *(const LAS bf16x8*)(st + VT0 + (db >> 3) * 16384 + ((db & 7) * 2 + kk) * 1024 + koff);
                o[db] = __builtin_amdgcn_mfma_f32_16x16x32_bf16(vf, pf, o[db], 0, 0, 0);
                if (DH > 128 && (db & 3) == 3) __builtin_amdgcn_sched_barrier(0); }
        }
    }
    DI void finish(unsigned char* orow, int fq) {
        float lt = l; lt += __shfl_xor(lt, 16); lt += __shfl_xor(lt, 32);
        const float inv = CAT_SCALE / lt;
#pragma unroll
        for (int db = 0; db < DH / 16; ++db) *(unsigned*)(orow + db * 16 + 4 * fq) = pk4_fp8(o[db][0] * inv, o[db][1] * inv, o[db][2] * inv, o[db][3] * inv);
    }
};
#define AW_WAIT(n) asm volatile("s_waitcnt vmcnt(" #n ")" ::: "memory")
#define AW_BAR() do { asm volatile("s_waitcnt lgkmcnt(0)" ::: "memory"); __builtin_amdgcn_s_barrier(); asm volatile("" ::: "memory"); } while (0)
DI void mem_wg(int task, int li, const bf16* QMp, const bf16* MKBp, const bf16* MVTp, const bf16* CMKp, const bf16* CMVTp, unsigned char* CATp, LAS unsigned char* lds, int tid, int wave, int lane) {
    typedef AttnWG<256> A;
    asm volatile("" : "+v"(tid), "+v"(lane));
    const int fr = lane & 15, fq = lane >> 4; int sR, sC; pg8::stage_rc(tid * 16, sR, sC);
    const bf16* kg; const bf16* vg; int vstride, m0; bool active;
    if (task < 256) { const int hm = task & 3, rb = task >> 2, b = rb >> 5; kg = MKBp + ((size_t)li * 512 + b * 256) * 1024 + hm * 256; vg = MVTp + ((size_t)li * 1024 + hm * 256) * 512 + b * 256; vstride = 512; m0 = rb * 128 + wave * 16; active = true; }
    else { const int t2 = task - 256, hm = t2 & 3, sb = t2 >> 2; kg = CMKp + ((size_t)(li * 16 + sb) * 256) * 1024 + hm * 256; vg = CMVTp + ((size_t)(li * 16 + sb) * 1024 + hm * 256) * 256; vstride = 256; m0 = MP + sb * 32 + (wave & 1) * 16; active = wave < 2; }
    const int hm = (task < 256 ? task : task - 256) & 3;
    A st; st.init(QMp + (size_t)(m0 + fr) * MEMW + hm * 256, fq);
    AW_WAIT(0);
    A::stage(lds, kg, 1024, vg, vstride, sR, sC, wave);
    for (int t = 0; t < 4; ++t) {
        if (t < 3) { A::stage(lds + ((t + 1) & 1) * A::STAGE, kg + (size_t)(t + 1) * 64 * 1024, 1024, vg + (t + 1) * 64, vstride, sR, sC, wave); AW_WAIT(8); } else AW_WAIT(0);
        AW_BAR();
        if (active) st.tile<false>(lds + (t & 1) * A::STAGE, 4, nullptr, 0, fr, fq);
        AW_BAR();
    }
    if (active) st.finish(CATp + (size_t)(m0 + fr) * D + TOK + hm * 256, fq);
}
DI void band_wg(int task, const bf16* Qb, const bf16* Kb, const bf16* VT, const bf16* CKp, const bf16* CVTp, const float* relb, unsigned char* CATp, LAS unsigned char* lds, int tid, int wave, int lane) {
    typedef AttnWG<128> A;
    asm volatile("" : "+v"(tid), "+v"(lane));
    const int fr = lane & 15, fq = lane >> 4, grp = wave >> 2; int sR, sC; pg8::stage_rc(tid * 16, sR, sC);
    LAS float* biasl = (LAS float*)(lds + 3 * A::STAGE);
    const bool prompt = task < 1536;
    int h, b, c0 = 0, m0, qpos, jfirst, jlast; bool active;
    if (prompt) { const int cp = task & 31, bh = task >> 5; h = bh % 24; b = bh / 24; c0 = 2 * cp; const int c = c0 + grp; m0 = b * 4096 + c * 64 + (wave & 3) * 16; qpos = c * 64 + (wave & 3) * 16 + fr; jfirst = c0 < 8 ? 8 - c0 : 0; jlast = 9; active = true; }
    else { const int t2 = task - 1536; h = t2 % 24; b = t2 / 24; m0 = MP + b * 32 + (wave & 1) * 16; qpos = 1024 + (wave & 1) * 16 + fr; jfirst = 0; jlast = 8; active = wave < 2; }
    AW_BAR();
    for (int i = tid; i < 704; i += NWAVES * 64) { int rel = 640 - i; rel = rel < -128 ? -128 : (rel > 128 ? 128 : rel); biasl[i] = relb[h * 257 + rel + 128]; }
    A st; st.init(Qb + (size_t)(m0 + fr) * TOK + h * 128, fq);
    AW_WAIT(0);
#define BAND_SRC(j, kp, vp, vs) do { if (prompt) { const int kt = b * 4096 + (c0 - 8 + (j)) * 64; kp = Kb + (size_t)kt * TOK + h * 128; vp = VT + (size_t)(h * 128) * M + kt; vs = M; } \
        else if ((j) < 8) { kp = CKp + ((size_t)(b * 512 + (j) * 64)) * TOK + h * 128; vp = CVTp + ((size_t)b * TOK + h * 128) * 512 + (j) * 64; vs = 512; } \
        else { kp = Kb + (size_t)(MP + b * 32) * TOK + h * 128; vp = VT + (size_t)(h * 128) * M + MP + b * 32; vs = M; } } while (0)
#define BAND_STAGE(j) do { const bf16* kp; const bf16* vp; int vs; BAND_SRC((j), kp, vp, vs); A::stage(lds + (((j) - jfirst) % 3) * A::STAGE, kp, TOK, vp, vs, sR, sC, wave); } while (0)
    BAND_STAGE(jfirst);
    if (jfirst + 1 <= jlast) BAND_STAGE(jfirst + 1);
    for (int j = jfirst; j <= jlast; ++j) {
        if (j < jlast) AW_WAIT(4); else AW_WAIT(0);
        AW_BAR();
        if (j + 2 <= jlast) BAND_STAGE(j + 2);
        const bool part = active && (prompt ? (grp == 0 ? j <= 8 : j >= 1) : true);
        if (part) { const int kp0 = prompt ? (c0 - 8 + j) * 64 : (j < 8 ? 512 + 64 * j : 1024); st.tile<true>(lds + ((j - jfirst) % 3) * A::STAGE, (!prompt && j == 8) ? 2 : 4, biasl, qpos - kp0, fr, fq); }
    }
#undef BAND_STAGE
#undef BAND_SRC
    if (active) st.finish(CATp + (size_t)(m0 + fr) * D + h * 128, fq);
}

struct AttnWG2 {
    static constexpr int VT0 = 16384, STAGE = 32768;
    bf16x8 qf[2][4]; f32x4 o[2][8]; float m[2], l[2];
    DI void init(const bf16* qrow0, const bf16* qrow1, int fq) {
#pragma unroll
        for (int ks = 0; ks < 4; ++ks) { qf[0][ks] = *(const bf16x8*)(qrow0 + ks * 32 + fq * 8); qf[1][ks] = *(const bf16x8*)(qrow1 + ks * 32 + fq * 8); }
#pragma unroll
        for (int g = 0; g < 2; ++g) {
#pragma unroll
            for (int db = 0; db < 8; ++db) o[g][db] = (f32x4){0.f, 0.f, 0.f, 0.f};
            m[g] = -1e30f; l[g] = 0.f; }
#pragma unroll
        for (int ks = 0; ks < 4; ++ks) { asm volatile("" : "+v"(qf[0][ks])); asm volatile("" : "+v"(qf[1][ks])); }
    }
    DI void tile(const LAS unsigned char* st, const LAS float* rb, int dpos0, int fr, int fq) {
        int koff = (fr * 64 + fq * 16) ^ ((fr >> 3) << 5);
        asm volatile("" : "+v"(dpos0), "+v"(koff));
        const int dbase = __builtin_amdgcn_readfirstlane(dpos0 - fr); const float bfar = rb[0];
        const LAS unsigned char* kb = st + koff; const LAS unsigned char* vb = st + VT0 + koff;
        f32x4 s[2][4]; bf16x8 kf[2][4];
#pragma unroll
        for (int ks = 0; ks < 4; ++ks) kf[0][ks] = *(const LAS bf16x8*)(kb + (ks >> 1) * 8192 + (ks & 1) * 1024);
        __builtin_amdgcn_sched_barrier(0);
#pragma unroll
        for (int nb = 0; nb < 4; ++nb) {
            if (nb < 3) {
#pragma unroll
                for (int ks = 0; ks < 4; ++ks) kf[(nb + 1) & 1][ks] = *(const LAS bf16x8*)(kb + (ks >> 1) * 8192 + ((nb + 1) * 2 + (ks & 1)) * 1024); }
            s[0][nb] = (f32x4){0.f, 0.f, 0.f, 0.f}; s[1][nb] = (f32x4){0.f, 0.f, 0.f, 0.f};
#pragma unroll
            for (int ks = 0; ks < 4; ++ks) { s[0][nb] = __builtin_amdgcn_mfma_f32_16x16x32_bf16(kf[nb & 1][ks], qf[0][ks], s[0][nb], 0, 0, 0); s[1][nb] = __builtin_amdgcn_mfma_f32_16x16x32_bf16(kf[nb & 1][ks], qf[1][ks], s[1][nb], 0, 0, 0); }
            if (nb < 3) __builtin_amdgcn_sched_group_barrier(0x100, 4, 0);
            __builtin_amdgcn_sched_group_barrier(0x008, 8, 0);
            __builtin_amdgcn_sched_barrier(0);
        }
        bf16x8 vf[2][4];
#pragma unroll
        for (int i = 0; i < 4; ++i) vf[0][i] = *(const LAS bf16x8*)(vb + (i * 2) * 1024);
        __builtin_amdgcn_sched_barrier(0);
        bf16x8 pf[2][2];
#pragma unroll
        for (int g = 0; g < 2; ++g) {
            const bool far = dbase + 16 * g - 63 >= 128;
#pragma unroll
            for (int nb = 0; nb < 4; ++nb) {
                if (far) s[g][nb] = s[g][nb] + bfar;
                else { const LAS float* bp = rb + (640 - dpos0 - 16 * g) + 8 * fq + (nb >> 1) * 32 + (nb & 1) * 4;
#pragma unroll
                    for (int j = 0; j < 4; ++j) s[g][nb][j] += bp[j]; } }
            float mx = -1e30f;
#pragma unroll
            for (int nb = 0; nb < 4; ++nb)
#pragma unroll
                for (int j = 0; j < 4; ++j) mx = fmaxf(mx, s[g][nb][j]);
            mx = fmaxf(mx, __shfl_xor(mx, 16)); mx = fmaxf(mx, __shfl_xor(mx, 32));
            const float mn = fmaxf(m[g], mx), alpha = __expf(m[g] - mn); m[g] = mn;
            float ps = 0.f;
#pragma unroll
            for (int nb = 0; nb < 4; ++nb)
#pragma unroll
                for (int j = 0; j < 4; ++j) { const float p = __expf(s[g][nb][j] - mn); s[g][nb][j] = p; ps += p; }
            l[g] = l[g] * alpha + ps;
#pragma unroll
            for (int db = 0; db < 8; ++db) o[g][db] = o[g][db] * alpha;
#pragma unroll
            for (int kk = 0; kk < 2; ++kk) { u32x4 pw; pw.x = pk2(s[g][2 * kk][0], s[g][2 * kk][1]); pw.y = pk2(s[g][2 * kk][2], s[g][2 * kk][3]); pw.z = pk2(s[g][2 * kk + 1][0], s[g][2 * kk + 1][1]); pw.w = pk2(s[g][2 * kk + 1][2], s[g][2 * kk + 1][3]);
                pf[g][kk] = __builtin_bit_cast(bf16x8, pw); }
        }
        __builtin_amdgcn_sched_barrier(0);
#pragma unroll
        for (int b = 0; b < 4; ++b) {
            if (b < 3) {
#pragma unroll
                for (int i = 0; i < 4; ++i) { const int f = 4 * (b + 1) + i, kk = f >> 3, db = f & 7; vf[(b + 1) & 1][i] = *(const LAS bf16x8*)(vb + (db * 2 + kk) * 1024); } }
#pragma unroll
            for (int i = 0; i < 4; ++i) { const int f = 4 * b + i, kk = f >> 3, db = f & 7;
                o[0][db] = __builtin_amdgcn_mfma_f32_16x16x32_bf16(vf[b & 1][i], pf[0][kk], o[0][db], 0, 0, 0); o[1][db] = __builtin_amdgcn_mfma_f32_16x16x32_bf16(vf[b & 1][i], pf[1][kk], o[1][db], 0, 0, 0); }
            if (b < 3) __builtin_amdgcn_sched_group_barrier(0x100, 4, 0);
            __builtin_amdgcn_sched_group_barrier(0x008, 8, 0);
            __builtin_amdgcn_sched_barrier(0);
        }
    }
    DI void finish(unsigned char* orow0, unsigned char* orow1, int fq) {
#pragma unroll
        for (int g = 0; g < 2; ++g) { float lt = l[g]; lt += __shfl_xor(lt, 16); lt += __shfl_xor(lt, 32); const float inv = CAT_SCALE / lt; unsigned char* orow = g ? orow1 : orow0;
#pragma unroll
            for (int db = 0; db < 8; ++db) *(unsigned*)(orow + db * 16 + 4 * fq) = pk4_fp8(o[g][db][0] * inv, o[g][db][1] * inv, o[g][db][2] * inv, o[g][db][3] * inv); }
    }
};
DI void band_wg2(int task, const bf16* Qb, const bf16* Kb, const bf16* VT, const float* relb, unsigned char* CATp, LAS unsigned char* lds0, int tid, int wave, int lane, int mode = 0) {
    typedef AttnWG<128> A;
    asm volatile("" : "+v"(tid), "+v"(lane));
    LAS unsigned char* lds = lds0; asm volatile("" : "+v"(lds));
    const int fr = lane & 15, fq = lane >> 4, ci = wave >> 1; int sR, sC; pg8::stage_rc(tid * 16, sR, sC);
    LAS float* biasl = (LAS float*)(lds + 3 * A::STAGE);
    const int cq = task & 15, bh = task >> 4, h = bh % 24, b = bh / 24, c0 = 4 * cq, c = c0 + ci;
    const int r0 = c * 64 + (wave & 1) * 32, m0 = b * 4096 + r0;
    const int jfirst = c0 < 8 ? 8 - c0 : 0, jlast = 11;
    AW_BAR();
    for (int i = tid; i < 704; i += NWAVES * 64) { int rel = 640 - i; rel = rel < -128 ? -128 : (rel > 128 ? 128 : rel); biasl[i] = relb[h * 257 + rel + 128]; }
    AttnWG2 st; st.init(Qb + (size_t)(m0 + fr) * TOK + h * 128, Qb + (size_t)(m0 + 16 + fr) * TOK + h * 128, fq);
    AW_WAIT(0);
    const bf16* kp = Kb + (size_t)(b * 4096 + (c0 - 8 + jfirst) * 64) * TOK + h * 128;
    const bf16* vp = VT + (size_t)(h * 128) * M + b * 4096 + (c0 - 8 + jfirst) * 64;
    if (!(mode & 16)) { A::stage(lds, kp, TOK, vp, M, sR, sC, wave);
    A::stage(lds + A::STAGE, kp + (size_t)64 * TOK, TOK, vp + 64, M, sR, sC, wave); }
    kp += (size_t)128 * TOK; vp += 128;
    int sidx = 0;
    for (int j = jfirst; j <= jlast; ++j) {
        if (j < jlast) AW_WAIT(4); else AW_WAIT(0);
        AW_BAR();
        if (j + 2 <= jlast && !(mode & 16)) { const int s2 = sidx == 0 ? 2 : sidx - 1; A::stage(lds + s2 * A::STAGE, kp, TOK, vp, M, sR, sC, wave); kp += (size_t)64 * TOK; vp += 64; }
        if (j >= ci && j <= ci + 8 && !(mode & 8)) st.tile(lds + sidx * A::STAGE, biasl, r0 + fr - (c0 - 8 + j) * 64, fr, fq);
        sidx = sidx == 2 ? 0 : sidx + 1;
    }
    if (!(mode & 24)) st.finish(CATp + (size_t)(m0 + fr) * D + h * 128, CATp + (size_t)(m0 + 16 + fr) * D + h * 128, fq);
}

DI void sgu_task(int task, const bf16* U, const bf16* VT, const float* vst, const bf16* SWB, const float* lng, const float* lnb, const float* sgub, unsigned char* CAT, float* out, LAS float* stl, int lane) {
    const int fr = lane & 15, fq = lane >> 4;
    const int part = task % 3, g = (task / 3) & 7, ck = task / 24;
    const bool prompt = ck < 64; const int m0 = prompt ? ck * 128 : MP + (ck - 64) * 32, n = prompt ? 128 : 32;
#pragma unroll
    for (int h = 0; h < 2; ++h) { const int t = lane + 64 * h;
        if (t < n) { float s = 0.f, q = 0.f;
            for (int sl = 0; sl < 24; ++sl) { const f32x2 v = *(const f32x2*)(vst + ((size_t)sl * M + m0 + t) * 2); s += v.x; q += v.y; }
            const float mean = s * (1.0f / TOK), var = q * (1.0f / TOK) - mean * mean;
            stl[2 * t] = mean; stl[2 * t + 1] = __builtin_amdgcn_rsqf(var + LN_EPS); } }
    LDS_WAIT(); asm volatile("" ::: "memory");
    const int nrg = n >> 4, nks = n >> 5;
    bf16x8 wf[8][4];
#pragma unroll
    for (int rg = 0; rg < 8; ++rg)
#pragma unroll
        for (int ks = 0; ks < 4; ++ks) if (ks <= (rg >> 1)) { wf[rg][ks] = (rg < nrg) ? *(const bf16x8*)(SWB + ((size_t)g * 128 + rg * 16 + fr) * 128 + ks * 32 + fq * 8) : (bf16x8){0, 0, 0, 0, 0, 0, 0, 0}; }
    float bs[8];
#pragma unroll
    for (int rg = 0; rg < 8; ++rg) bs[rg] = sgub[g * 128 + ((rg < nrg) ? rg * 16 + fr : 0)];
    for (int cb = 0; cb < 8; ++cb) {
        const int ch0 = g * 384 + part * 128 + cb * 16, ch = ch0 + fr;
        const float gg = lng[ch], gb = lnb[ch];
        bf16x8 af[4];
#pragma unroll
        for (int ks = 0; ks < 4; ++ks) if (ks < nks) {
            const u32x4 raw = *(const u32x4*)(VT + (size_t)ch * M + m0 + ks * 32 + fq * 8);
            const LAS f32x4* sp = (const LAS f32x4*)(stl + 2 * (ks * 32 + fq * 8));
            float v[8]; v[0] = bflo(raw.x); v[1] = bfhi(raw.x); v[2] = bflo(raw.y); v[3] = bfhi(raw.y); v[4] = bflo(raw.z); v[5] = bfhi(raw.z); v[6] = bflo(raw.w); v[7] = bfhi(raw.w);
#pragma unroll
            for (int e2 = 0; e2 < 4; ++e2) { const f32x4 mr = sp[e2]; v[2 * e2] = (v[2 * e2] - mr[0]) * mr[1] * gg + gb; v[2 * e2 + 1] = (v[2 * e2 + 1] - mr[2]) * mr[3] * gg + gb; }
            if (!prompt) { float* op = out + O_SGV + (size_t)(m0 - MP + ks * 32 + fq * 8) * TOK + ch;
#pragma unroll
                for (int e = 0; e < 8; ++e) op[(size_t)e * TOK] = v[e]; }
            u32x4 pw; pw.x = pk2(v[0], v[1]); pw.y = pk2(v[2], v[3]); pw.z = pk2(v[4], v[5]); pw.w = pk2(v[6], v[7]);
            af[ks] = __builtin_bit_cast(bf16x8, pw);
        } else af[ks] = (bf16x8){0, 0, 0, 0, 0, 0, 0, 0};
#pragma unroll
        for (int rg = 0; rg < 8; ++rg) if (rg < nrg) {
            f32x4 acc = (f32x4){0.f, 0.f, 0.f, 0.f};
#pragma unroll
            for (int ks = 0; ks < 4; ++ks) if (ks <= (rg >> 1)) acc = __builtin_amdgcn_mfma_f32_16x16x32_bf16(af[ks], wf[rg][ks], acc, 0, 0, 0);
            const size_t t = (size_t)(m0 + rg * 16 + fr);
            const u32x2 uu = *(const u32x2*)(U + t * TOK + ch0 + 4 * fq);
            *(unsigned*)(CAT + t * D + ch0 + 4 * fq) = pk4_fp8(CAT_SCALE * bflo(uu.x) * (acc[0] + bs[rg]), CAT_SCALE * bfhi(uu.x) * (acc[1] + bs[rg]), CAT_SCALE * bflo(uu.y) * (acc[2] + bs[rg]), CAT_SCALE * bfhi(uu.y) * (acc[3] + bs[rg]));
        }
    }
    LDS_WAIT(); asm volatile("" ::: "memory");
}

DI void ln1_row(const bf16* z, const float* g, const float* b, bf16* xb, unsigned char* x8, int lane) {
    f32x4 v[16]; float s = 0.f;
#pragma unroll
    for (int j = 0; j < 8; ++j) { const u32x4 r = ((const u32x4*)z)[j * 64 + lane];
        v[2 * j] = (f32x4){bflo(r.x), bfhi(r.x), bflo(r.y), bfhi(r.y)}; v[2 * j + 1] = (f32x4){bflo(r.z), bfhi(r.z), bflo(r.w), bfhi(r.w)};
        s += ((v[2 * j][0] + v[2 * j][1]) + (v[2 * j][2] + v[2 * j][3])) + ((v[2 * j + 1][0] + v[2 * j + 1][1]) + (v[2 * j + 1][2] + v[2 * j + 1][3])); }
    const float mean = wave_sum(s) * (1.0f / D); float q = 0.f;
#pragma unroll
    for (int j = 0; j < 16; ++j) { v[j] = v[j] - mean; q += (v[j][0] * v[j][0] + v[j][1] * v[j][1]) + (v[j][2] * v[j][2] + v[j][3] * v[j][3]); }
    const float rstd = __builtin_amdgcn_rsqf(wave_sum(q) * (1.0f / D) + LN_EPS);
#pragma unroll
    for (int j = 0; j < 8; ++j) { const int ci = (j * 64 + lane) * 2;
        const f32x4 y0 = v[2 * j] * rstd * ((const f32x4*)g)[ci] + ((const f32x4*)b)[ci], y1 = v[2 * j + 1] * rstd * ((const f32x4*)g)[ci + 1] + ((const f32x4*)b)[ci + 1];
        st_bf16x8(xb + (size_t)(j * 64 + lane) * 8, y0, y1);
        u32x2 w8; w8.x = pk4_fp8(y0[0] * XB_SCALE, y0[1] * XB_SCALE, y0[2] * XB_SCALE, y0[3] * XB_SCALE); w8.y = pk4_fp8(y1[0] * XB_SCALE, y1[1] * XB_SCALE, y1[2] * XB_SCALE, y1[3] * XB_SCALE); ((u32x2*)x8)[j * 64 + lane] = w8; }
}

DI unsigned fkey(float f) { const unsigned u = __float_as_uint(f); return u ^ ((u >> 31) ? 0xffffffffu : 0x80000000u); }
DI float fkey_inv(unsigned k) { return __uint_as_float(k ^ ((k >> 31) ? 0x80000000u : 0xffffffffu)); }
DI unsigned radix_thr16_2(unsigned u0, unsigned u1) {
    unsigned T, bm, c, n0, n1; unsigned long long m0, m1;
    asm volatile("s_mov_b32 %[T], 0\n\ts_brev_b32 %[bm], 1\n"
                 "1:\n\ts_or_b32 %[c], %[T], %[bm]\n\t"
                 "v_cmp_ge_u32_e64 %[m0], %[u0], %[c]\n\tv_cmp_ge_u32_e64 %[m1], %[u1], %[c]\n\t"
                 "s_bcnt1_i32_b64 %[n0], %[m0]\n\ts_bcnt1_i32_b64 %[n1], %[m1]\n\ts_add_i32 %[n0], %[n0], %[n1]\n\t"
                 "s_cmp_ge_u32 %[n0], 16\n\ts_cselect_b32 %[T], %[c], %[T]\n\ts_cmp_eq_u32 %[n0], 16\n\ts_cbranch_scc1 2f\n\t"
                 "s_lshr_b32 %[bm], %[bm], 1\n\ts_cmp_lg_u32 %[bm], 0\n\ts_cbranch_scc1 1b\n"
                 "2:\n"
                 : [T] "=&s"(T), [bm] "=&s"(bm), [c] "=&s"(c), [n0] "=&s"(n0), [n1] "=&s"(n1), [m0] "=&s"(m0), [m1] "=&s"(m1)
                 : [u0] "v"(u0), [u1] "v"(u1) : "scc");
    return T;
}
DI unsigned radix_thr16_4(unsigned u0, unsigned u1, unsigned u2, unsigned u3) {
    unsigned T, bm, c, n0, n1; unsigned long long m0, m1, m2, m3;
    asm volatile("s_mov_b32 %[T], 0\n\ts_brev_b32 %[bm], 1\n"
                 "1:\n\ts_or_b32 %[c], %[T], %[bm]\n\t"
                 "v_cmp_ge_u32_e64 %[m0], %[u0], %[c]\n\tv_cmp_ge_u32_e64 %[m1], %[u1], %[c]\n\tv_cmp_ge_u32_e64 %[m2], %[u2], %[c]\n\tv_cmp_ge_u32_e64 %[m3], %[u3], %[c]\n\t"
                 "s_bcnt1_i32_b64 %[n0], %[m0]\n\ts_bcnt1_i32_b64 %[n1], %[m1]\n\ts_add_i32 %[n0], %[n0], %[n1]\n\t"
                 "s_bcnt1_i32_b64 %[n1], %[m2]\n\ts_add_i32 %[n0], %[n0], %[n1]\n\ts_bcnt1_i32_b64 %[n1], %[m3]\n\ts_add_i32 %[n0], %[n0], %[n1]\n\t"
                 "s_cmp_ge_u32 %[n0], 16\n\ts_cselect_b32 %[T], %[c], %[T]\n\ts_cmp_eq_u32 %[n0], 16\n\ts_cbranch_scc1 2f\n\t"
                 "s_lshr_b32 %[bm], %[bm], 1\n\ts_cmp_lg_u32 %[bm], 0\n\ts_cbranch_scc1 1b\n"
                 "2:\n"
                 : [T] "=&s"(T), [bm] "=&s"(bm), [c] "=&s"(c), [n0] "=&s"(n0), [n1] "=&s"(n1), [m0] "=&s"(m0), [m1] "=&s"(m1), [m2] "=&s"(m2), [m3] "=&s"(m3)
                 : [u0] "v"(u0), [u1] "v"(u1), [u2] "v"(u2), [u3] "v"(u3) : "scc");
    return T;
}
DI void radix_thr16_4x2(unsigned u00, unsigned u01, unsigned u10, unsigned u11, unsigned u20, unsigned u21, unsigned u30, unsigned u31, unsigned& o0, unsigned& o1, unsigned& o2, unsigned& o3) {
    unsigned T0, T1, T2, T3, cc0, cc1, cc2, cc3, bm, dd, n0, n1; unsigned long long m00, m01, m10, m11, m20, m21, m30, m31;
    asm volatile("s_mov_b32 %[T0], 0\n\ts_mov_b32 %[T1], 0\n\ts_mov_b32 %[T2], 0\n\ts_mov_b32 %[T3], 0\n\ts_brev_b32 %[bm], 1\n\ts_mov_b32 %[d], 0\n1:\n\ts_or_b32 %[c0], %[T0], %[bm]\n\ts_or_b32 %[c1], %[T1], %[bm]\n\ts_or_b32 %[c2], %[T2], %[bm]\n\ts_or_b32 %[c3], %[T3], %[bm]\n\tv_cmp_ge_u32_e64 %[m00], %[u00], %[c0]\n\tv_cmp_ge_u32_e64 %[m01], %[u01], %[c0]\n\tv_cmp_ge_u32_e64 %[m10], %[u10], %[c1]\n\tv_cmp_ge_u32_e64 %[m11], %[u11], %[c1]\n\tv_cmp_ge_u32_e64 %[m20], %[u20], %[c2]\n\tv_cmp_ge_u32_e64 %[m21], %[u21], %[c2]\n\tv_cmp_ge_u32_e64 %[m30], %[u30], %[c3]\n\tv_cmp_ge_u32_e64 %[m31], %[u31], %[c3]\n\ts_bcnt1_i32_b64 %[n0], %[m00]\n\ts_bcnt1_i32_b64 %[n1], %[m01]\n\ts_add_i32 %[n0], %[n0], %[n1]\n\ts_cmp_ge_u32 %[n0], 16\n\ts_cselect_b32 %[T0], %[c0], %[T0]\n\ts_cmp_eq_u32 %[n0], 16\n\ts_cselect_b32 %[n1], 1, 0\n\ts_or_b32 %[d], %[d], %[n1]\n\ts_bcnt1_i32_b64 %[n0], %[m10]\n\ts_bcnt1_i32_b64 %[n1], %[m11]\n\ts_add_i32 %[n0], %[n0], %[n1]\n\ts_cmp_ge_u32 %[n0], 16\n\ts_cselect_b32 %[T1], %[c1], %[T1]\n\ts_cmp_eq_u32 %[n0], 16\n\ts_cselect_b32 %[n1], 2, 0\n\ts_or_b32 %[d], %[d], %[n1]\n\ts_bcnt1_i32_b64 %[n0], %[m20]\n\ts_bcnt1_i32_b64 %[n1], %[m21]\n\ts_add_i32 %[n0], %[n0], %[n1]\n\ts_cmp_ge_u32 %[n0], 16\n\ts_cselect_b32 %[T2], %[c2], %[T2]\n\ts_cmp_eq_u32 %[n0], 16\n\ts_cselect_b32 %[n1], 4, 0\n\ts_or_b32 %[d], %[d], %[n1]\n\ts_bcnt1_i32_b64 %[n0], %[m30]\n\ts_bcnt1_i32_b64 %[n1], %[m31]\n\ts_add_i32 %[n0], %[n0], %[n1]\n\ts_cmp_ge_u32 %[n0], 16\n\ts_cselect_b32 %[T3], %[c3], %[T3]\n\ts_cmp_eq_u32 %[n0], 16\n\ts_cselect_b32 %[n1], 8, 0\n\ts_or_b32 %[d], %[d], %[n1]\n\ts_cmp_eq_u32 %[d], 15\n\ts_cbranch_scc1 2f\n\ts_lshr_b32 %[bm], %[bm], 1\n\ts_cmp_lg_u32 %[bm], 0\n\ts_cbranch_scc1 1b\n2:\n"
                 : [T0] "=&s"(T0), [T1] "=&s"(T1), [T2] "=&s"(T2), [T3] "=&s"(T3), [c0] "=&s"(cc0), [c1] "=&s"(cc1), [c2] "=&s"(cc2), [c3] "=&s"(cc3), [bm] "=&s"(bm), [d] "=&s"(dd), [n0] "=&s"(n0), [n1] "=&s"(n1), [m00] "=&s"(m00), [m01] "=&s"(m01), [m10] "=&s"(m10), [m11] "=&s"(m11), [m20] "=&s"(m20), [m21] "=&s"(m21), [m30] "=&s"(m30), [m31] "=&s"(m31)
                 : [u00] "v"(u00), [u01] "v"(u01), [u10] "v"(u10), [u11] "v"(u11), [u20] "v"(u20), [u21] "v"(u21), [u30] "v"(u30), [u31] "v"(u31) : "scc");
    o0 = T0; o1 = T1; o2 = T2; o3 = T3;
}
DI void radix_thr16_2x4(unsigned u00, unsigned u01, unsigned u02, unsigned u03, unsigned u10, unsigned u11, unsigned u12, unsigned u13, unsigned& o0, unsigned& o1) {
    unsigned T0, T1, cc0, cc1, bm, dd, n0, n1; unsigned long long m00, m01, m02, m03, m10, m11, m12, m13;
    asm volatile("s_mov_b32 %[T0], 0\n\ts_mov_b32 %[T1], 0\n\ts_brev_b32 %[bm], 1\n\ts_mov_b32 %[d], 0\n1:\n\ts_or_b32 %[c0], %[T0], %[bm]\n\ts_or_b32 %[c1], %[T1], %[bm]\n\tv_cmp_ge_u32_e64 %[m00], %[u00], %[c0]\n\tv_cmp_ge_u32_e64 %[m01], %[u01], %[c0]\n\tv_cmp_ge_u32_e64 %[m02], %[u02], %[c0]\n\tv_cmp_ge_u32_e64 %[m03], %[u03], %[c0]\n\tv_cmp_ge_u32_e64 %[m10], %[u10], %[c1]\n\tv_cmp_ge_u32_e64 %[m11], %[u11], %[c1]\n\tv_cmp_ge_u32_e64 %[m12], %[u12], %[c1]\n\tv_cmp_ge_u32_e64 %[m13], %[u13], %[c1]\n\ts_bcnt1_i32_b64 %[n0], %[m00]\n\ts_bcnt1_i32_b64 %[n1], %[m01]\n\ts_add_i32 %[n0], %[n0], %[n1]\n\ts_bcnt1_i32_b64 %[n1], %[m02]\n\ts_add_i32 %[n0], %[n0], %[n1]\n\ts_bcnt1_i32_b64 %[n1], %[m03]\n\ts_add_i32 %[n0], %[n0], %[n1]\n\ts_cmp_ge_u32 %[n0], 16\n\ts_cselect_b32 %[T0], %[c0], %[T0]\n\ts_cmp_eq_u32 %[n0], 16\n\ts_cselect_b32 %[n1], 1, 0\n\ts_or_b32 %[d], %[d], %[n1]\n\ts_bcnt1_i32_b64 %[n0], %[m10]\n\ts_bcnt1_i32_b64 %[n1], %[m11]\n\ts_add_i32 %[n0], %[n0], %[n1]\n\ts_bcnt1_i32_b64 %[n1], %[m12]\n\ts_add_i32 %[n0], %[n0], %[n1]\n\ts_bcnt1_i32_b64 %[n1], %[m13]\n\ts_add_i32 %[n0], %[n0], %[n1]\n\ts_cmp_ge_u32 %[n0], 16\n\ts_cselect_b32 %[T1], %[c1], %[T1]\n\ts_cmp_eq_u32 %[n0], 16\n\ts_cselect_b32 %[n1], 2, 0\n\ts_or_b32 %[d], %[d], %[n1]\n\ts_cmp_eq_u32 %[d], 3\n\ts_cbranch_scc1 2f\n\ts_lshr_b32 %[bm], %[bm], 1\n\ts_cmp_lg_u32 %[bm], 0\n\ts_cbranch_scc1 1b\n2:\n"
                 : [T0] "=&s"(T0), [T1] "=&s"(T1), [c0] "=&s"(cc0), [c1] "=&s"(cc1), [bm] "=&s"(bm), [d] "=&s"(dd), [n0] "=&s"(n0), [n1] "=&s"(n1), [m00] "=&s"(m00), [m01] "=&s"(m01), [m02] "=&s"(m02), [m03] "=&s"(m03), [m10] "=&s"(m10), [m11] "=&s"(m11), [m12] "=&s"(m12), [m13] "=&s"(m13)
                 : [u00] "v"(u00), [u01] "v"(u01), [u02] "v"(u02), [u03] "v"(u03), [u10] "v"(u10), [u11] "v"(u11), [u12] "v"(u12), [u13] "v"(u13) : "scc");
    o0 = T0; o1 = T1;
}
template <int NV> DI void compact16(const unsigned (&u)[NV], unsigned T, int lane, LAS float* dstv, LAS int* dsti) {
    int base = 0;
#pragma unroll
    for (int r = 0; r < NV; ++r) { const bool sel = u[r] >= T; const unsigned long long m = __ballot(sel);
        const int rank = base + (int)__builtin_amdgcn_mbcnt_hi((unsigned)(m >> 32), __builtin_amdgcn_mbcnt_lo((unsigned)m, 0u));
        if (sel && rank < 16) { dstv[rank] = fkey_inv(u[r]); dsti[rank] = lane + 64 * r; }
        base += __builtin_popcountll(m); }
}
DI float row16_max(float x) {
    x = fmaxf(x, __builtin_bit_cast(float, __builtin_amdgcn_update_dpp(0, __builtin_bit_cast(int, x), 0x128, 0xf, 0xf, false)));
    x = fmaxf(x, __builtin_bit_cast(float, __builtin_amdgcn_update_dpp(0, __builtin_bit_cast(int, x), 0x124, 0xf, 0xf, false)));
    x = fmaxf(x, __builtin_bit_cast(float, __builtin_amdgcn_update_dpp(0, __builtin_bit_cast(int, x), 0x122, 0xf, 0xf, false)));
    x = fmaxf(x, __builtin_bit_cast(float, __builtin_amdgcn_update_dpp(0, __builtin_bit_cast(int, x), 0x121, 0xf, 0xf, false)));
    return x;
}
DI void topk_item(int item, const bf16* PQ, const bf16* KEYB, int* IDX, float* GATE, LAS float* S, LAS float* wscr, int wave, int lane) {
    const int fr = lane & 15, fq = lane >> 4, tt = item >> 3, h = item & 7, p = wave >> 2, r0 = (wave & 3) * 16, t0 = tt * 64;
    bf16x8 af[4];
#pragma unroll
    for (int ks = 0; ks < 4; ++ks) af[ks] = *(const bf16x8*)(PQ + (size_t)(t0 + r0 + fr) * 2048 + h * 256 + p * 128 + ks * 32 + fq * 8);
    const bf16* kb = KEYB + ((size_t)(h * 2 + p) * 128) * 128;
#pragma unroll
    for (int nb = 0; nb < 8; ++nb) { f32x4 acc = (f32x4){0.f, 0.f, 0.f, 0.f};
#pragma unroll
        for (int ks = 0; ks < 4; ++ks) { const bf16x8 bfr = *(const bf16x8*)(kb + (size_t)(nb * 16 + fr) * 128 + ks * 32 + fq * 8); acc = __builtin_amdgcn_mfma_f32_16x16x32_bf16(af[ks], bfr, acc, 0, 0, 0); }
#pragma unroll
        for (int j = 0; j < 4; ++j) S[(r0 + 4 * fq + j) * 256 + p * 128 + nb * 16 + fr] = acc[j]; }
    __syncthreads();
    LAS float* v0s = wscr; LAS int* i0s = (LAS int*)(wscr + 16); LAS float* v1s = wscr + 32; LAS int* i1s = (LAS int*)(wscr + 48); LAS float* vfs = wscr + 64; LAS int* ifs = (LAS int*)(wscr + 80);
    for (int q = 0; q < 8; q += 2) { const int tl = wave * 8 + q; const LAS float* sr = S + tl * 256;
        const unsigned ua[2] = {fkey(sr[lane]), fkey(sr[lane + 64])}, ub[2] = {fkey(sr[128 + lane]), fkey(sr[192 + lane])};
        const unsigned uc[2] = {fkey(sr[256 + lane]), fkey(sr[256 + lane + 64])}, ud[2] = {fkey(sr[256 + 128 + lane]), fkey(sr[256 + 192 + lane])};
        unsigned Ta, Tb, Tc, Td; radix_thr16_4x2(ua[0], ua[1], ub[0], ub[1], uc[0], uc[1], ud[0], ud[1], Ta, Tb, Tc, Td);
        compact16<2>(ua, Ta, lane, v0s, i0s); compact16<2>(ub, Tb, lane, v1s, i1s); compact16<2>(uc, Tc, lane, v0s + 96, i0s + 96); compact16<2>(ud, Td, lane, v1s + 96, i1s + 96);
        unsigned c0[4], c1[4]; const float s1a = v1s[lane & 15], s1b = v1s[96 + (lane & 15)];
#pragma unroll
        for (int r = 0; r < 4; ++r) { c0[r] = fkey(v0s[(lane >> 4) + 4 * r] + s1a); c1[r] = fkey(v0s[96 + (lane >> 4) + 4 * r] + s1b); }
        unsigned Tf0, Tf1; radix_thr16_2x4(c0[0], c0[1], c0[2], c0[3], c1[0], c1[1], c1[2], c1[3], Tf0, Tf1);
        compact16<4>(c0, Tf0, lane, vfs, ifs); compact16<4>(c1, Tf1, lane, vfs + 96, ifs + 96);
#pragma unroll
        for (int tk = 0; tk < 2; ++tk) {
            const float bs = vfs[96 * tk + (lane & 15)]; const int pos = ifs[96 * tk + (lane & 15)];
            const int e = i0s[96 * tk + ((pos >> 4) & 15)] * 128 + i1s[96 * tk + (pos & 15)];
            const float ex = __expf(bs - row16_max(bs)), sum = row16_sum(ex);
            if (lane < 16) { const size_t o = (size_t)(t0 + tl + tk) * 128 + h * 16 + lane; IDX[o] = e; GATE[o] = ex / sum; } }
    }
    __syncthreads();
}


#define TK_CHAIN(Lst, k) do { _Pragma("unroll") for (int _s = 0; _s < 16; ++_s) { const unsigned _t = Lst[_s] > (k) ? Lst[_s] : (k); (k) = Lst[_s] > (k) ? (k) : Lst[_s]; Lst[_s] = _t; } } while (0)
DI void topk_item2(int item, const bf16* PQ, const bf16* KEYB, int* IDX, float* GATE, LAS unsigned* S, LAS unsigned* T, int tid, int wave, int lane) {
    const int fr = lane & 15, fq = lane >> 4, tile = item >> 1, hg = item & 1, t0 = tile * 32, hl = wave >> 1, p = wave & 1, h = hg * 4 + hl;
    {
        bf16x8 af[2][4];
#pragma unroll
        for (int rb = 0; rb < 2; ++rb)
#pragma unroll
            for (int ks = 0; ks < 4; ++ks) af[rb][ks] = *(const bf16x8*)(PQ + (size_t)(t0 + rb * 16 + fr) * 2048 + h * 256 + p * 128 + ks * 32 + fq * 8);
        const bf16* kb = KEYB + ((size_t)(h * 2 + p) * 128) * 128;
#pragma unroll
        for (int nb = 0; nb < 8; ++nb) { bf16x8 bfr[4];
#pragma unroll
            for (int ks = 0; ks < 4; ++ks) bfr[ks] = *(const bf16x8*)(kb + (size_t)(nb * 16 + fr) * 128 + ks * 32 + fq * 8);
#pragma unroll
            for (int rb = 0; rb < 2; ++rb) { f32x4 acc = (f32x4){0.f, 0.f, 0.f, 0.f};
#pragma unroll
                for (int ks = 0; ks < 4; ++ks) acc = __builtin_amdgcn_mfma_f32_16x16x32_bf16(af[rb][ks], bfr[ks], acc, 0, 0, 0);
#pragma unroll
                for (int j = 0; j < 4; ++j) { const int set = (hl * 2 + p) * 32 + rb * 16 + 4 * fq + j, n = nb * 16 + fr;
                    S[set * 128 + (n ^ (set & 31))] = (fkey(acc[j]) & 0xFFFFFF80u) | (unsigned)(127 - n); } } }
    }
    __syncthreads();
    {
        const int set = tid >> 1, c2 = tid & 1; const LAS unsigned* sp = S + set * 128; const int sw = set & 31;
        unsigned Lst[16];
#pragma unroll
        for (int i = 0; i < 16; ++i) Lst[i] = 0u;
#pragma unroll 2
        for (int i = 0; i < 64; ++i) { unsigned k = sp[(c2 * 64 + i) ^ sw]; TK_CHAIN(Lst, k); }
        unsigned C[16];
#pragma unroll
        for (int i = 0; i < 16; ++i) { const unsigned pr = (unsigned)__builtin_amdgcn_update_dpp(0, (int)Lst[15 - i], 0xB1, 0xf, 0xf, false); C[i] = Lst[i] > pr ? Lst[i] : pr; }
#pragma unroll
        for (int st = 8; st >= 1; st >>= 1)
#pragma unroll
            for (int i = 0; i < 16; ++i) if ((i & st) == 0) { const unsigned a = C[i] > C[i + st] ? C[i] : C[i + st], b = C[i] > C[i + st] ? C[i + st] : C[i]; C[i] = a; C[i + st] = b; }
        if (c2 == 0) {
#pragma unroll
            for (int i = 0; i < 4; ++i) { u32x4 w; w.x = C[4 * i]; w.y = C[4 * i + 1]; w.z = C[4 * i + 2]; w.w = C[4 * i + 3]; *(LAS u32x4*)(T + set * 16 + 4 * i) = w; } }
    }
    __syncthreads();
    if (tid < 128) {
        const int tok = tid & 31, hl2 = tid >> 5, set0 = (hl2 * 2) * 32 + tok, set1 = set0 + 32;
        float s0[16], s1[16];
#pragma unroll
        for (int i = 0; i < 4; ++i) { const u32x4 a = *(const LAS u32x4*)(T + set0 * 16 + 4 * i), b = *(const LAS u32x4*)(T + set1 * 16 + 4 * i);
            s0[4 * i] = fkey_inv(a.x & 0xFFFFFF80u); s0[4 * i + 1] = fkey_inv(a.y & 0xFFFFFF80u); s0[4 * i + 2] = fkey_inv(a.z & 0xFFFFFF80u); s0[4 * i + 3] = fkey_inv(a.w & 0xFFFFFF80u);
            s1[4 * i] = fkey_inv(b.x & 0xFFFFFF80u); s1[4 * i + 1] = fkey_inv(b.y & 0xFFFFFF80u); s1[4 * i + 2] = fkey_inv(b.z & 0xFFFFFF80u); s1[4 * i + 3] = fkey_inv(b.w & 0xFFFFFF80u); }
        unsigned L2[16];
#pragma unroll
        for (int i = 0; i < 16; ++i) L2[i] = 0u;
#define TK_INS2(i, j) do { unsigned _k = (fkey(s0[i] + s1[j]) & 0xFFFFFF00u) | (unsigned)((i) * 16 + (j)); TK_CHAIN(L2, _k); } while (0)
        TK_INS2(0, 0);
        TK_INS2(0, 1);
        TK_INS2(0, 2);
        TK_INS2(0, 3);
        TK_INS2(0, 4);
        TK_INS2(0, 5);
        TK_INS2(0, 6);
        TK_INS2(0, 7);
        TK_INS2(0, 8);
        TK_INS2(0, 9);
        TK_INS2(0, 10);
        TK_INS2(0, 11);
        TK_INS2(0, 12);
        TK_INS2(0, 13);
        TK_INS2(0, 14);
        TK_INS2(0, 15);
        TK_INS2(1, 0);
        TK_INS2(1, 1);
        TK_INS2(1, 2);
        TK_INS2(1, 3);
        TK_INS2(1, 4);
        TK_INS2(1, 5);
        TK_INS2(1, 6);
        TK_INS2(1, 7);
        TK_INS2(2, 0);
        TK_INS2(2, 1);
        TK_INS2(2, 2);
        TK_INS2(2, 3);
        TK_INS2(2, 4);
        TK_INS2(3, 0);
        TK_INS2(3, 1);
        TK_INS2(3, 2);
        TK_INS2(3, 3);
        TK_INS2(4, 0);
        TK_INS2(4, 1);
        TK_INS2(4, 2);
        TK_INS2(5, 0);
        TK_INS2(5, 1);
        TK_INS2(6, 0);
        TK_INS2(6, 1);
        TK_INS2(7, 0);
        TK_INS2(7, 1);
        TK_INS2(8, 0);
        TK_INS2(9, 0);
        TK_INS2(10, 0);
        TK_INS2(11, 0);
        TK_INS2(12, 0);
        TK_INS2(13, 0);
        TK_INS2(14, 0);
        TK_INS2(15, 0);
#undef TK_INS2
        float ex[16]; float tot = 0.f; const float mx = fkey_inv(L2[0] & 0xFFFFFF00u);
#pragma unroll
        for (int r = 0; r < 16; ++r) { ex[r] = __expf(fkey_inv(L2[r] & 0xFFFFFF00u) - mx); tot += ex[r]; }
        const float inv = 1.0f / tot; const size_t o = (size_t)(t0 + tok) * 128 + (hg * 4 + hl2) * 16;
#pragma unroll
        for (int r4 = 0; r4 < 4; ++r4) { int ev[4]; f32x4 gv;
#pragma unroll
            for (int q = 0; q < 4; ++q) { const unsigned code = L2[4 * r4 + q] & 0xFFu; const int i = code >> 4, j = code & 15;
                ev[q] = (127 - (int)(T[set0 * 16 + i] & 0x7Fu)) * 128 + (127 - (int)(T[set1 * 16 + j] & 0x7Fu)); gv[q] = ex[4 * r4 + q] * inv; }
            *(u32x4*)(IDX + o + 4 * r4) = (u32x4){(unsigned)ev[0], (unsigned)ev[1], (unsigned)ev[2], (unsigned)ev[3]}; *(f32x4*)(GATE + o + 4 * r4) = gv; }
    }
    __syncthreads();
}

DI f32x2 dot32_fp4(const u32x4 w, const f32x4 (&x)[8], f32x2 c) {
    const unsigned ww[4] = {w.x, w.y, w.z, w.w};
#pragma unroll
    for (int i = 0; i < 4; ++i) {
        c = __builtin_elementwise_fma(__builtin_amdgcn_cvt_scalef32_pk_f32_fp4(ww[i], 1.0f, 0), x[2 * i].lo, c); c = __builtin_elementwise_fma(__builtin_amdgcn_cvt_scalef32_pk_f32_fp4(ww[i], 1.0f, 1), x[2 * i].hi, c);
        c = __builtin_elementwise_fma(__builtin_amdgcn_cvt_scalef32_pk_f32_fp4(ww[i], 1.0f, 2), x[2 * i + 1].lo, c); c = __builtin_elementwise_fma(__builtin_amdgcn_cvt_scalef32_pk_f32_fp4(ww[i], 1.0f, 3), x[2 * i + 1].hi, c); }
    return c;
}
DI void axpy32_fp4(const u32x4 w, float a, f32x4 (&y)[8]) {
    const unsigned ww[4] = {w.x, w.y, w.z, w.w}; const f32x2 aa = {a, a};
#pragma unroll
    for (int i = 0; i < 4; ++i) {
        y[2 * i].lo = __builtin_elementwise_fma(aa, __builtin_amdgcn_cvt_scalef32_pk_f32_fp4(ww[i], 1.0f, 0), y[2 * i].lo); y[2 * i].hi = __builtin_elementwise_fma(aa, __builtin_amdgcn_cvt_scalef32_pk_f32_fp4(ww[i], 1.0f, 1), y[2 * i].hi);
        y[2 * i + 1].lo = __builtin_elementwise_fma(aa, __builtin_amdgcn_cvt_scalef32_pk_f32_fp4(ww[i], 1.0f, 2), y[2 * i + 1].lo); y[2 * i + 1].hi = __builtin_elementwise_fma(aa, __builtin_amdgcn_cvt_scalef32_pk_f32_fp4(ww[i], 1.0f, 3), y[2 * i + 1].hi); }
}
template <bool COOP> DI void peer_token(int t, const bf16* X1Bp, const int* IDX, const float* GATE, const unsigned char* PU4, const float* SCU_, const unsigned char* PV4, const float* SCV_,
                   const float* g2, const float* b2, float* outf, bf16* outb, unsigned char* outb8, float* dbg, int lane, int q4 = 0, LAS f32x4* part = nullptr) {
    const int kbeg = COOP ? 32 * q4 : 0, kend = COOP ? 32 * q4 + 32 : 128;
    const u32x4* xr = (const u32x4*)(X1Bp + (size_t)t * D);
    const int id0 = IDX[(size_t)t * 128 + lane], id1 = IDX[(size_t)t * 128 + 64 + lane];
    const float gt0 = GATE[(size_t)t * 128 + lane], gt1 = GATE[(size_t)t * 128 + 64 + lane];
    float a0 = 0.f, a1 = 0.f;
    {
        f32x4 x[2][8];
#pragma unroll
        for (int p = 0; p < 2; ++p)
#pragma unroll
            for (int i = 0; i < 4; ++i) { const u32x4 r = xr[(p * 64 + lane) * 4 + i]; x[p][2 * i] = (f32x4){bflo(r.x), bfhi(r.x), bflo(r.y), bfhi(r.y)}; x[p][2 * i + 1] = (f32x4){bflo(r.z), bfhi(r.z), bflo(r.w), bfhi(r.w)}; }
#pragma unroll 1
        for (int k0 = kbeg; k0 < kend; k0 += 8) {
            u32x4 w[8][2]; float su[8];
#pragma unroll
            for (int q = 0; q < 8; ++q) { const int k = k0 + q; const int e = __builtin_amdgcn_readlane(k0 < 64 ? id0 : id1, k & 63); su[q] = SCU_[e];
                const u32x4* row = (const u32x4*)(PU4 + (size_t)e * (D / 2));
                w[q][0] = row[lane]; w[q][1] = row[64 + lane]; }
#pragma unroll
            for (int q = 0; q < 8; ++q) { const int k = k0 + q; f32x2 d2 = {0.f, 0.f};
                d2 = dot32_fp4(w[q][0], x[0], d2); d2 = dot32_fp4(w[q][1], x[1], d2);
                const float d = wave_sum(d2.x + d2.y) * su[q];
                const float gate = __uint_as_float(__builtin_amdgcn_readlane(__float_as_uint(k0 < 64 ? gt0 : gt1), k & 63));
                const float a = gate * gelu_tanh(d);
                if (k0 < 64) { if (lane == (k & 63)) a0 = a; } else { if (lane == (k & 63)) a1 = a; } }
        }
    }
    if (dbg) { dbg[(size_t)t * 128 + lane] = a0; dbg[(size_t)t * 128 + 64 + lane] = a1; }
    f32x4 y[2][8];
#pragma unroll
    for (int p = 0; p < 2; ++p)
#pragma unroll
        for (int i = 0; i < 8; ++i) y[p][i] = (f32x4){0.f, 0.f, 0.f, 0.f};
#pragma unroll 1
    for (int k0 = kbeg; k0 < kend; k0 += 8) {
        u32x4 w[8][2]; float a[8];
#pragma unroll
        for (int q = 0; q < 8; ++q) { const int k = k0 + q; const int e = __builtin_amdgcn_readlane(k0 < 64 ? id0 : id1, k & 63);
            a[q] = __uint_as_float(__builtin_amdgcn_readlane(__float_as_uint(k0 < 64 ? a0 : a1), k & 63)) * SCV_[e];
            const u32x4* row = (const u32x4*)(PV4 + (size_t)e * (D / 2));
            w[q][0] = row[lane]; w[q][1] = row[64 + lane]; }
#pragma unroll
        for (int q = 0; q < 8; ++q) { axpy32_fp4(w[q][0], a[q], y[0]); axpy32_fp4(w[q][1], a[q], y[1]); }
    }
    asm volatile("" : "+v"(lane));
    if (COOP) {
        if (q4 != 0) {
#pragma unroll
            for (int p = 0; p < 2; ++p)
#pragma unroll
                for (int i = 0; i < 8; ++i) part[(q4 * 16 + p * 8 + i) * 64 + lane] = y[p][i]; }
        __syncthreads();
        if (q4 == 0) {
#pragma unroll
            for (int qq = 1; qq < 4; ++qq)
#pragma unroll
                for (int p = 0; p < 2; ++p)
#pragma unroll
                    for (int i = 0; i < 8; ++i) y[p][i] = y[p][i] + part[(qq * 16 + p * 8 + i) * 64 + lane]; }
        __syncthreads();
        if (q4 != 0) return;
    }
    float s = 0.f;
#pragma unroll
    for (int p = 0; p < 2; ++p)
#pragma unroll
        for (int i = 0; i < 4; ++i) { const u32x4 r = xr[(p * 64 + lane) * 4 + i]; const f32x4 xa = (f32x4){bflo(r.x), bfhi(r.x), bflo(r.y), bfhi(r.y)}, xb2 = (f32x4){bflo(r.z), bfhi(r.z), bflo(r.w), bfhi(r.w)};
            y[p][2 * i] = xa * ALPHA + y[p][2 * i]; y[p][2 * i + 1] = xb2 * ALPHA + y[p][2 * i + 1];
            s += ((y[p][2 * i][0] + y[p][2 * i][1]) + (y[p][2 * i][2] + y[p][2 * i][3])) + ((y[p][2 * i + 1][0] + y[p][2 * i + 1][1]) + (y[p][2 * i + 1][2] + y[p][2 * i + 1][3])); }
    const float mean = wave_sum(s) * (1.0f / D); float q = 0.f;
#pragma unroll
    for (int p = 0; p < 2; ++p)
#pragma unroll
        for (int i = 0; i < 8; ++i) { y[p][i] = y[p][i] - mean; q += (y[p][i][0] * y[p][i][0] + y[p][i][1] * y[p][i][1]) + (y[p][i][2] * y[p][i][2] + y[p][i][3] * y[p][i][3]); }
    const float rstd = __builtin_amdgcn_rsqf(wave_sum(q) * (1.0f / D) + LN_EPS);
#pragma unroll
    for (int p = 0; p < 2; ++p)
#pragma unroll
        for (int i2 = 0; i2 < 4; ++i2) { f32x4 o[2];
#pragma unroll
            for (int hh = 0; hh < 2; ++hh) { const int ci = (p * 64 + lane) * 8 + 2 * i2 + hh; o[hh] = y[p][2 * i2 + hh] * rstd * ((const f32x4*)g2)[ci] + ((const f32x4*)b2)[ci]; if (outf) ((f32x4*)outf)[ci] = o[hh]; }
            if (outb) { u32x4 w0; w0.x = pk2(o[0][0], o[0][1]); w0.y = pk2(o[0][2], o[0][3]); w0.z = pk2(o[1][0], o[1][1]); w0.w = pk2(o[1][2], o[1][3]); ((u32x4*)outb)[(p * 64 + lane) * 4 + i2] = w0;
                u32x2 w8; w8.x = pk4_fp8(o[0][0] * XB_SCALE, o[0][1] * XB_SCALE, o[0][2] * XB_SCALE, o[0][3] * XB_SCALE); w8.y = pk4_fp8(o[1][0] * XB_SCALE, o[1][1] * XB_SCALE, o[1][2] * XB_SCALE, o[1][3] * XB_SCALE); ((u32x2*)outb8)[(p * 64 + lane) * 4 + i2] = w8; } }
}

typedef _Float16 h2_t __attribute__((ext_vector_type(2)));
#define H2C(x) __builtin_bit_cast(h2_t, (x))
DI h2_t dot32_fp4_h(const u32x4 w, const h2_t (&x)[16], h2_t c) {
    unsigned ww[4] = {w.x, w.y, w.z, w.w};
#pragma unroll
    for (int i = 0; i < 4; ++i) {
        c = __builtin_elementwise_fma(H2C(__builtin_amdgcn_cvt_scalef32_pk_f16_fp4(ww[i], 1.0f, 0)), x[4 * i], c); c = __builtin_elementwise_fma(H2C(__builtin_amdgcn_cvt_scalef32_pk_f16_fp4(ww[i], 1.0f, 1)), x[4 * i + 1], c);
        c = __builtin_elementwise_fma(H2C(__builtin_amdgcn_cvt_scalef32_pk_f16_fp4(ww[i], 1.0f, 2)), x[4 * i + 2], c); c = __builtin_elementwise_fma(H2C(__builtin_amdgcn_cvt_scalef32_pk_f16_fp4(ww[i], 1.0f, 3)), x[4 * i + 3], c); }
    return c;
}
DI void axpy32_fp4_h(const u32x4 w, h2_t aa, h2_t (&y)[16]) {
    unsigned ww[4] = {w.x, w.y, w.z, w.w};
#pragma unroll
    for (int i = 0; i < 4; ++i) {
        y[4 * i] = __builtin_elementwise_fma(aa, H2C(__builtin_amdgcn_cvt_scalef32_pk_f16_fp4(ww[i], 1.0f, 0)), y[4 * i]); y[4 * i + 1] = __builtin_elementwise_fma(aa, H2C(__builtin_amdgcn_cvt_scalef32_pk_f16_fp4(ww[i], 1.0f, 1)), y[4 * i + 1]);
        y[4 * i + 2] = __builtin_elementwise_fma(aa, H2C(__builtin_amdgcn_cvt_scalef32_pk_f16_fp4(ww[i], 1.0f, 2)), y[4 * i + 2]); y[4 * i + 3] = __builtin_elementwise_fma(aa, H2C(__builtin_amdgcn_cvt_scalef32_pk_f16_fp4(ww[i], 1.0f, 3)), y[4 * i + 3]); }
}
constexpr int NSUB = 16;
constexpr size_t SUB_BYTES = (size_t)NEXP * 128;
DI float oct_sum(float x) {
    x += __builtin_bit_cast(float, __builtin_amdgcn_update_dpp(0, __builtin_bit_cast(int, x), 0xB1, 0xf, 0xf, false));
    x += __builtin_bit_cast(float, __builtin_amdgcn_update_dpp(0, __builtin_bit_cast(int, x), 0x4E, 0xf, 0xf, false));
    x += __builtin_bit_cast(float, __builtin_amdgcn_update_dpp(0, __builtin_bit_cast(int, x), 0x141, 0xf, 0xf, false));
    return x;
}
DI void peer_u_slice(int t, int sub, const bf16* X1Bp, const int* IDX, const unsigned char* PU4s, float* PACTs, int lane) {
    asm volatile("" : "+v"(lane));
    const int c8 = lane & 7, r8 = lane >> 3;
    const u32x4* xr = (const u32x4*)(X1Bp + (size_t)t * D + sub * 256 + c8 * 32);
    const pg8::v4i* ip = (const pg8::v4i*)(IDX + (size_t)t * 128 + r8 * 16);
    pg8::v4i e4[4];
#pragma unroll
    for (int i = 0; i < 4; ++i) e4[i] = ip[i];
    f32x4 x[8];
#pragma unroll
    for (int i = 0; i < 4; ++i) { const u32x4 r = xr[i]; x[2 * i] = (f32x4){bflo(r.x), bfhi(r.x), bflo(r.y), bfhi(r.y)}; x[2 * i + 1] = (f32x4){bflo(r.z), bfhi(r.z), bflo(r.w), bfhi(r.w)}; }
    u32x4 w[16];
#pragma unroll
    for (int j = 0; j < 16; ++j) w[j] = *(const u32x4*)(PU4s + ((unsigned)e4[j >> 2][j & 3] * 128u + (unsigned)c8 * 16u));
    float res[16];
#pragma unroll
    for (int j = 0; j < 16; ++j) { const f32x2 d2 = dot32_fp4(w[j], x, (f32x2){0.f, 0.f}); res[j] = oct_sum(d2.x + d2.y); }
    if (c8 == 0) { f32x4* o = (f32x4*)(PACTs + (size_t)t * 128 + r8 * 16);
#pragma unroll
        for (int i = 0; i < 4; ++i) o[i] = (f32x4){res[4 * i], res[4 * i + 1], res[4 * i + 2], res[4 * i + 3]}; }
}
DI void peer_a_token(int t, const int* IDX, const float* GATE, const float* PACT, const float* SCU_, const float* SCV_, float* AV, int lane) {
    asm volatile("" : "+v"(lane));
#pragma unroll
    for (int h = 0; h < 2; ++h) { const int k = h * 64 + lane; const int e = IDX[(size_t)t * 128 + k]; float sum = 0.f;
#pragma unroll
        for (int sub = 0; sub < NSUB; ++sub) sum += PACT[((size_t)sub * M + t) * 128 + k];
        AV[(size_t)t * 128 + k] = GATE[(size_t)t * 128 + k] * gelu_tanh(sum * SCU_[e] * (1.0f / XB_SCALE)) * SCV_[e]; }
}
DI void peer_v_slice(int t, int sub, const bf16* X1Bp, const int* IDX, const float* AV, const unsigned char* PV4s, bf16* ZBp, float* STATs, LAS f32x4* red, int lane) {
    asm volatile("" : "+v"(lane));
    const int c8 = lane & 7, r8 = lane >> 3;
    const pg8::v4i* ip = (const pg8::v4i*)(IDX + (size_t)t * 128 + r8 * 16);
    const f32x4* ap = (const f32x4*)(AV + (size_t)t * 128 + r8 * 16);
    const int col = sub * 256 + 32 * (lane & 7) + 4 * (lane >> 3);
    const u32x2 xv = *(const u32x2*)(X1Bp + (size_t)t * D + col);
    f32x4 y[8];
#pragma unroll
    for (int i = 0; i < 8; ++i) y[i] = (f32x4){0.f, 0.f, 0.f, 0.f};
#pragma unroll 1
    for (int b = 0; b < 2; ++b) {
        pg8::v4i e4[2]; f32x4 a4[2];
#pragma unroll
        for (int i = 0; i < 2; ++i) { e4[i] = ip[2 * b + i]; a4[i] = ap[2 * b + i]; }
        u32x4 w[8];
#pragma unroll
        for (int j = 0; j < 8; ++j) w[j] = *(const u32x4*)(PV4s + ((unsigned)e4[j >> 2][j & 3] * 128u + (unsigned)c8 * 16u));
#pragma unroll
        for (int j = 0; j < 8; ++j) axpy32_fp4(w[j], a4[j >> 2][j & 3], y);
    }
#pragma unroll
    for (int q = 0; q < 8; ++q) red[r8 * 72 + q * 8 + c8] = y[q];
    asm volatile("s_waitcnt lgkmcnt(0)" ::: "memory");
    f32x4 z = red[lane];
#pragma unroll
    for (int r = 1; r < 8; ++r) z = z + red[r * 72 + lane];
    asm volatile("s_waitcnt lgkmcnt(0)" ::: "memory");
    z = (f32x4){bflo(xv.x), bfhi(xv.x), bflo(xv.y), bfhi(xv.y)} * ALPHA + z;
    const float s1 = wave_sum((z[0] + z[1]) + (z[2] + z[3])), s2 = wave_sum((z[0] * z[0] + z[1] * z[1]) + (z[2] * z[2] + z[3] * z[3]));
    u32x2 o; o.x = pk2(z[0], z[1]); o.y = pk2(z[2], z[3]); *(u32x2*)(ZBp + (size_t)t * D + col) = o;
    if (lane == 0) *(f32x2*)(STATs + (size_t)t * 2) = (f32x2){s1, s2};
}
#define PEER_HCL(h) ((h) < nh ? (h) : nh - 1)
#define PEER_HOFF(h) ((size_t)(wx + (PEER_HCL(h) >> 1) * nwx) * 128 + (PEER_HCL(h) & 1) * 8)
#define PEER_MEMFENCE() asm volatile("" ::: "memory")
DI void peer_u_pass(int sub, int wx, int nwx, const bf16* X1Bp, const int* IDX, const unsigned char* PU4s, float* PACTs, int lane, int emask = 0x3fff) {
    asm volatile("" : "+v"(lane));
    if (wx >= M) return;
    const int c8 = lane & 7, r8 = lane >> 3; const unsigned lo = (unsigned)c8 * 16u;
    const int* ibase = IDX + r8 * 16; const bf16* xbase = X1Bp + sub * 256 + c8 * 32;
    pg8::v4i eA[2], eB[2]; u32x4 xraw[4], wA[8], wB[8]; h2_t x[16];
    { const pg8::v4i* ip = (const pg8::v4i*)(ibase + (size_t)wx * 128); eA[0] = ip[0]; eA[1] = ip[1]; eB[0] = ip[2]; eB[1] = ip[3];
#pragma unroll
      for (int i = 0; i < 4; ++i) xraw[i] = ((const u32x4*)(xbase + (size_t)wx * D))[i];
#pragma unroll
      for (int j = 0; j < 8; ++j) wA[j] = *(const u32x4*)(PU4s + ((unsigned)(eA[j >> 2][j & 3] & emask) * 128u + lo)); }
#pragma unroll 1
    for (int t = wx; t < M; t += nwx) {
        const int tn = (t + nwx < M) ? t + nwx : t;
#pragma unroll
        for (int j = 0; j < 8; ++j) wB[j] = *(const u32x4*)(PU4s + ((unsigned)(eB[j >> 2][j & 3] & emask) * 128u + lo));
#pragma unroll
        for (int i = 0; i < 4; ++i) { const u32x4 r = xraw[i]; x[4 * i] = H2C(__builtin_amdgcn_cvt_pkrtz(bflo(r.x), bfhi(r.x))); x[4 * i + 1] = H2C(__builtin_amdgcn_cvt_pkrtz(bflo(r.y), bfhi(r.y))); x[4 * i + 2] = H2C(__builtin_amdgcn_cvt_pkrtz(bflo(r.z), bfhi(r.z))); x[4 * i + 3] = H2C(__builtin_amdgcn_cvt_pkrtz(bflo(r.w), bfhi(r.w))); }
        PEER_MEMFENCE();
        { const pg8::v4i* ip = (const pg8::v4i*)(ibase + (size_t)tn * 128); eA[0] = ip[0]; eA[1] = ip[1]; eB[0] = ip[2]; eB[1] = ip[3];
#pragma unroll
          for (int i = 0; i < 4; ++i) xraw[i] = ((const u32x4*)(xbase + (size_t)tn * D))[i]; }
        PEER_MEMFENCE();
        float res[16];
#pragma unroll
        for (int j = 0; j < 8; ++j) { const h2_t d2 = dot32_fp4_h(wA[j], x, (h2_t){(_Float16)0.f, (_Float16)0.f}); res[j] = oct_sum((float)d2.x + (float)d2.y); }
        PEER_MEMFENCE();
#pragma unroll
        for (int j = 0; j < 8; ++j) wA[j] = *(const u32x4*)(PU4s + ((unsigned)(eA[j >> 2][j & 3] & emask) * 128u + lo));
        PEER_MEMFENCE();
#pragma unroll
        for (int j = 0; j < 8; ++j) { const h2_t d2 = dot32_fp4_h(wB[j], x, (h2_t){(_Float16)0.f, (_Float16)0.f}); res[8 + j] = oct_sum((float)d2.x + (float)d2.y); }
        if (c8 == 0) { f32x4* o = (f32x4*)(PACTs + (size_t)t * 128 + r8 * 16);
#pragma unroll
            for (int i = 0; i < 4; ++i) o[i] = (f32x4){res[4 * i], res[4 * i + 1], res[4 * i + 2], res[4 * i + 3]}; }
    }
}
#define PEER_HOFF4(h) ((size_t)(wx + (PEER_HCL(h) >> 1) * nwx) * 128 + (PEER_HCL(h) & 1) * 4)
DI void peer_u_pass_mfma(int sub, int wx, int nwx, const unsigned char* X18p, const int* IDX, const unsigned char* PU4s, float* PACTs, LAS unsigned char* buf, int lane, int emask = 0x3fff) {
    asm volatile("" : "+v"(lane));
    if (wx >= M) return;
    const int i16 = lane & 15, kg = lane >> 4, r8 = lane >> 3, c8 = lane & 7;
    const int* ibase = IDX + r8 * 8; const unsigned char* xbase = X18p + sub * 256 + kg * 16;
    const unsigned rdoff = (unsigned)((i16 & 7) * 1024 + (i16 >> 3) * 128);
    pg8::v4i eA[2], eB[2]; u32x4 braw[4], bc[4];
#define PEER_DMA_HALF(E, BUF) do { _Pragma("unroll") for (int q = 0; q < 8; ++q) \
        AttnWG<128>::dma16(PU4s + ((unsigned)(E[q >> 2][q & 3] & emask) * 128u + (unsigned)((c8 ^ q) * 16)), (BUF) + q * 1024); } while (0)
#define PEER_MFMA_HALF(BUF, HALF) do { f32x4 acc[4]; \
        _Pragma("unroll") for (int g = 0; g < 4; ++g) { acc[g] = (f32x4){0.f, 0.f, 0.f, 0.f}; \
            _Pragma("unroll") for (int ks = 0; ks < 2; ++ks) { const u32x4 av = *(const LAS u32x4*)((BUF) + rdoff + g * 256 + (((4 * ks + kg) ^ (i16 & 7)) * 16)); const pg8::v8i a8 = {(int)av.x, (int)av.y, (int)av.z, (int)av.w, 0, 0, 0, 0}; \
                const u32x4 b0 = bc[2 * ks], b1 = bc[2 * ks + 1]; const pg8::v8i b8 = {(int)b0.x, (int)b0.y, (int)b0.z, (int)b0.w, (int)b1.x, (int)b1.y, (int)b1.z, (int)b1.w}; \
                acc[g] = __builtin_amdgcn_mfma_scale_f32_16x16x128_f8f6f4(a8, b8, acc[g], 4, 0, 0, 0x7F7F7F7F, 0, 0x7F7F7F7F); } } \
        if (i16 == 0) { _Pragma("unroll") for (int g = 0; g < 4; ++g) *(f32x4*)(PACTs + (size_t)t * 128 + (HALF) * 64 + g * 16 + 4 * kg) = acc[g]; } } while (0)
    LAS unsigned char* bufA = buf; LAS unsigned char* bufB = buf + 8192;
    { const pg8::v4i* ip = (const pg8::v4i*)(ibase + (size_t)wx * 128); eA[0] = ip[0]; eA[1] = ip[1]; const pg8::v4i* iq = (const pg8::v4i*)(ibase + (size_t)wx * 128 + 64); eB[0] = iq[0]; eB[1] = iq[1];
#pragma unroll
      for (int ks = 0; ks < 2; ++ks) { braw[2 * ks] = *(const u32x4*)(xbase + (size_t)wx * D + ks * 128); braw[2 * ks + 1] = *(const u32x4*)(xbase + (size_t)wx * D + ks * 128 + 64); }
      PEER_DMA_HALF(eA, bufA);
      asm volatile("s_waitcnt vmcnt(0)" ::: "memory"); }
#pragma unroll 1
    for (int t = wx; t < M; t += nwx) {
        const int tn = (t + nwx < M) ? t + nwx : t;
        PEER_DMA_HALF(eB, bufB);
#pragma unroll
        for (int i = 0; i < 4; ++i) bc[i] = braw[i];
        PEER_MEMFENCE();
        { const pg8::v4i* ip = (const pg8::v4i*)(ibase + (size_t)tn * 128); eA[0] = ip[0]; eA[1] = ip[1]; const pg8::v4i* iq = (const pg8::v4i*)(ibase + (size_t)tn * 128 + 64); eB[0] = iq[0]; eB[1] = iq[1];
#pragma unroll
          for (int ks = 0; ks < 2; ++ks) { braw[2 * ks] = *(const u32x4*)(xbase + (size_t)tn * D + ks * 128); braw[2 * ks + 1] = *(const u32x4*)(xbase + (size_t)tn * D + ks * 128 + 64); } }
        asm volatile("s_waitcnt vmcnt(16)" ::: "memory");
        PEER_MFMA_HALF(bufA, 0);
        PEER_MEMFENCE();
        PEER_DMA_HALF(eA, bufA);
        asm volatile("s_waitcnt vmcnt(12)" ::: "memory");
        PEER_MFMA_HALF(bufB, 1);
        PEER_MEMFENCE();
    }
    asm volatile("s_waitcnt vmcnt(0)" ::: "memory");
}
DI void peer_v_pass(int sub, int wx, int nwx, const bf16* X1Bp, const int* IDX, const float* AV, const unsigned char* PV4s, bf16* ZBp, float* STATs, LAS f32x4* red, int lane, int emask = 0x3fff) {
    asm volatile("" : "+v"(lane));
    if (wx >= M) return;
    const int c8 = lane & 7, r8 = lane >> 3; const unsigned lo = (unsigned)c8 * 16u;
    const int* ibase = IDX + r8 * 16; const float* abase = AV + r8 * 16;
    const int col = sub * 256 + 32 * (lane & 7) + 4 * (lane >> 3);
    pg8::v4i eA[2], eB[2]; f32x4 aA[2], aB[2]; u32x4 wA[8], wB[8]; h2_t yh[16];
    { const pg8::v4i* ip = (const pg8::v4i*)(ibase + (size_t)wx * 128); eA[0] = ip[0]; eA[1] = ip[1]; eB[0] = ip[2]; eB[1] = ip[3];
      const f32x4* ap = (const f32x4*)(abase + (size_t)wx * 128); aA[0] = ap[0]; aA[1] = ap[1]; aB[0] = ap[2]; aB[1] = ap[3];
#pragma unroll
      for (int j = 0; j < 8; ++j) wA[j] = *(const u32x4*)(PV4s + ((unsigned)(eA[j >> 2][j & 3] & emask) * 128u + lo)); }
#pragma unroll 1
    for (int t = wx; t < M; t += nwx) {
        const int tn = (t + nwx < M) ? t + nwx : t;
#pragma unroll
        for (int j = 0; j < 8; ++j) wB[j] = *(const u32x4*)(PV4s + ((unsigned)(eB[j >> 2][j & 3] & emask) * 128u + lo));
        PEER_MEMFENCE();
        { const pg8::v4i* ip = (const pg8::v4i*)(ibase + (size_t)tn * 128); eA[0] = ip[0]; eA[1] = ip[1]; eB[0] = ip[2]; eB[1] = ip[3]; }
        const u32x2 xv = *(const u32x2*)(X1Bp + (size_t)t * D + col);
        PEER_MEMFENCE();
#pragma unroll
        for (int i = 0; i < 16; ++i) yh[i] = (h2_t){(_Float16)0.f, (_Float16)0.f};
#pragma unroll
        for (int j = 0; j < 8; ++j) { const float aj = aA[j >> 2][j & 3]; axpy32_fp4_h(wA[j], H2C(__builtin_amdgcn_cvt_pkrtz(aj, aj)), yh); }
        PEER_MEMFENCE();
        { const f32x4* ap = (const f32x4*)(abase + (size_t)tn * 128); aA[0] = ap[0]; aA[1] = ap[1]; }
#pragma unroll
        for (int j = 0; j < 8; ++j) wA[j] = *(const u32x4*)(PV4s + ((unsigned)(eA[j >> 2][j & 3] & emask) * 128u + lo));
        PEER_MEMFENCE();
#pragma unroll
        for (int j = 0; j < 8; ++j) { const float aj = aB[j >> 2][j & 3]; axpy32_fp4_h(wB[j], H2C(__builtin_amdgcn_cvt_pkrtz(aj, aj)), yh); }
        PEER_MEMFENCE();
        { const f32x4* ap = (const f32x4*)(abase + (size_t)tn * 128); aB[0] = ap[2]; aB[1] = ap[3]; }
#pragma unroll
        for (int q = 0; q < 8; ++q) red[r8 * 72 + q * 8 + c8] = (f32x4){(float)yh[2 * q].x, (float)yh[2 * q].y, (float)yh[2 * q + 1].x, (float)yh[2 * q + 1].y};
        asm volatile("s_waitcnt lgkmcnt(0)" ::: "memory");
        f32x4 z = red[lane];
#pragma unroll
        for (int r = 1; r < 8; ++r) z = z + red[r * 72 + lane];
        asm volatile("s_waitcnt lgkmcnt(0)" ::: "memory");
        z = (f32x4){bflo(xv.x), bfhi(xv.x), bflo(xv.y), bfhi(xv.y)} * ALPHA + z;
        const float s1 = wave_sum((z[0] + z[1]) + (z[2] + z[3])), s2 = wave_sum((z[0] * z[0] + z[1] * z[1]) + (z[2] * z[2] + z[3] * z[3]));
        u32x2 o; o.x = pk2(z[0], z[1]); o.y = pk2(z[2], z[3]); *(u32x2*)(ZBp + (size_t)t * D + col) = o;
        if (lane == 0) *(f32x2*)(STATs + (size_t)t * 2) = (f32x2){s1, s2};
    }
}
DI void ln2_row(int t, const bf16* ZBp, const float* STAT, const float* g2, const float* b2, float* outf, bf16* outb, unsigned char* outb8, int lane) {
    asm volatile("" : "+v"(lane));
    float s1 = 0.f, s2 = 0.f;
    if (lane < NSUB) { const f32x2 v = *(const f32x2*)(STAT + ((size_t)lane * M + t) * 2); s1 = v.x; s2 = v.y; }
    const u32x2* zr = (const u32x2*)(ZBp + (size_t)t * D);
    u32x2 zq[16];
#pragma unroll
    for (int j = 0; j < 16; ++j) zq[j] = zr[j * 64 + lane];
    s1 = wave_sum(s1); s2 = wave_sum(s2);
    const float mean = s1 * (1.0f / D), rstd = __builtin_amdgcn_rsqf(fmaxf(s2 * (1.0f / D) - mean * mean, 0.f) + LN_EPS);
#pragma unroll
    for (int j = 0; j < 16; ++j) { const int ci = j * 64 + lane; const u32x2 r = zq[j];
        const f32x4 o = ((f32x4){bflo(r.x), bfhi(r.x), bflo(r.y), bfhi(r.y)} - mean) * rstd * ((const f32x4*)g2)[ci] + ((const f32x4*)b2)[ci];
        if (outf) ((f32x4*)outf)[ci] = o;
        if (outb) { u32x2 w0; w0.x = pk2(o[0], o[1]); w0.y = pk2(o[2], o[3]); ((u32x2*)outb)[ci] = w0; ((unsigned*)outb8)[ci] = pk4_fp8(o[0] * XB_SCALE, o[1] * XB_SCALE, o[2] * XB_SCALE, o[3] * XB_SCALE); } }
}

DI const float* inp_ptr(const LAS unsigned long long* tab, int k) { const unsigned long long v = tab[k];
    const unsigned lo = __builtin_amdgcn_readfirstlane((unsigned)v), hi = __builtin_amdgcn_readfirstlane((unsigned)(v >> 32)); return (const float*)(((unsigned long long)hi << 32) | lo); }
__global__ void __launch_bounds__(NWAVES * 64, 2) mk_fwd(Args args) {
    extern __shared__ __attribute__((aligned(16))) unsigned char lds[];
    LAS unsigned char* L = (LAS unsigned char*)lds;
    volatile LAS unsigned* MISC = (volatile LAS unsigned*)(L + MISC_OFF);
    const int tid = threadIdx.x, lane = tid & 63, wave = __builtin_amdgcn_readfirstlane(tid >> 6);
    const int G = gridDim.x; const int bx = blockIdx.x; const int vcu = (G % 8 == 0) ? (bx % 8) * (G / 8) + bx / 8 : bx;
    const int gw = vcu * NWAVES + wave, NGW = G * NWAVES;
    unsigned char* ws = args.ws; float* out = args.out;
    unsigned* ctl = (unsigned*)(ws + WS_CTL);
    for (int u = tid; u < (LDS_BYTES - LDSCTL_OFF) / 4; u += NWAVES * 64) ((LAS unsigned*)(L + LDSCTL_OFF))[u] = 0u;
    __syncthreads();
    LAS unsigned long long* ptab = (LAS unsigned long long*)(L + LDSCTL_OFF);
    if (tid == 0) {
#pragma unroll
        for (int k = 0; k < 24; ++k) ptab[k] = (unsigned long long)args.in[k]; }
    __syncthreads();
#define INP(k) inp_ptr(ptab, (k))
    XcdBarrier bar; bar.bar = ctl + CW_BAR; bar.x = 0; bar.st = nullptr;
    if (N_LAUNCHES == 1) bar = xcd_barrier_post(ctl + CW_BAR, MISC + 8);
    const int lo = args.ph_lo, hi = args.ph_hi;
#ifndef PH_MASK
#define PH_MASK 0x7fff
#endif
#define IN(k) ((((PH_MASK) >> (k)) & 1) && lo <= (k) && (k) < hi)
#define REP(k) for (int _r = 0, _n = ((args.dup >> (k)) & 1) + 1; _r < _n; ++_r, __syncthreads())
#define TAIL(total) const int first_idle = (total) - (((total) + G - 1) / G - 1) * G; const bool in_tail = bx >= first_idle && first_idle < G; const int gtw = (bx - first_idle) * NWAVES + wave, ngtw = (G - first_idle) * NWAVES; \
    LAS float* scr = (LAS float*)(L + wave * 16640); const size_t gtt = (size_t)gtw * 64 + ln, ntt = (size_t)ngtw * 64; (void)scr; (void)gtt; (void)ntt
#define SEAM(k) do { if (IN(k) && IN((k) + 1)) xcd_barrier(bar); } while (0)

#define Wa ((bf16*)(ws + WS_WA))
#define Wb ((bf16*)(ws + WS_WB))
#define Wmkv ((bf16*)(ws + WS_WMKV))
#define Wout8 ((unsigned char*)(ws + WS_WOUT))
#define Wq ((bf16*)(ws + WS_WQ))
#define KEYB ((bf16*)(ws + WS_KEYB))
#define SWB ((bf16*)(ws + WS_SWB))
#define PU8 ((unsigned char*)(ws + WS_PU))
#define PV8 ((unsigned char*)(ws + WS_PV))
#define SCU ((float*)(ws + WS_SCU))
#define SCV ((float*)(ws + WS_SCV))
#define XB ((bf16*)(ws + WS_XB))
#define XF ((float*)(ws + WS_XF))
#define MEMB ((bf16*)(ws + WS_MEMB))
#define MKB ((bf16*)(ws + WS_MKB))
#define MVT ((bf16*)(ws + WS_MVT))
#define CMK ((bf16*)(ws + WS_CMK))
#define CMVT ((bf16*)(ws + WS_CMVT))
#define CK ((bf16*)(ws + WS_CK))
#define CVT ((bf16*)(ws + WS_CVT))
#define BUFA ((bf16*)(ws + WS_BUFA))
#define BUFB ((bf16*)(ws + WS_BUFB))
#define BUFC ((bf16*)(ws + WS_BUFC))
#define QM ((bf16*)(ws + WS_QM))
#define CAT ((unsigned char*)(ws + WS_CAT))
#define Z ((bf16*)(ws + WS_Z))
#define X1F ((float*)(ws + WS_X1F))
#define X1B ((bf16*)(ws + WS_X1B))
#define X18 ((unsigned char*)(ws + WS_XF + 80 * MiB))
#define PQ ((bf16*)(ws + WS_PQ))
#define IDX ((int*)(ws + WS_IDX))
#define GATE ((float*)(ws + WS_GATE))
#define VST ((float*)(ws + WS_VST))
#define XB8 ((unsigned char*)(ws + WS_XB8))
#define Wa8 ((unsigned char*)(ws + WS_WA8))
#define Wb8 ((unsigned char*)(ws + WS_WB8))

    if (IN(0)) REP(0) { int ln = lane; asm volatile("" : "+v"(ln)); int tq = tid; asm volatile("" : "+v"(tq));
        LAS float* scr = (LAS float*)(L + wave * 16640);
        tr_job_both(INP(I_WINA) + 3072, Wa + (size_t)3072 * KDIM, Wa8 + (size_t)4096 * KDIM, 4096, 3072, 7168, WIN_SCALE, scr, gw, NGW, ln);
        tr_job8(INP(I_WINA), Wa8, 4096, 3072, 7168, WIN_SCALE, scr, gw, NGW, ln);
        tr_job8(INP(I_WINA) + 6144, Wa8 + (size_t)3072 * KDIM, 4096, 1024, 7168, WIN_SCALE, scr, gw, NGW, ln);
        tr_job(INP(I_WMKV), Wmkv, 4096, 2048, 2, (size_t)4096 * 2048, (size_t)4096 * 2048, scr, gw, NGW, ln);
        tr_job8(INP(I_WOUT), Wout8, 4096, 4096, 4096, WOUT_SCALE, scr, gw, NGW, ln);
        tr_job(INP(I_PWQ), Wq, 4096, 2048, 1, 0, 0, scr, gw, NGW, ln);
        tr_job(INP(I_CMV), CMVT, 256, 1024, 32, (size_t)256 * 1024, (size_t)256 * 1024, scr, gw, NGW, ln);
        const size_t gt = (size_t)gw * 64 + ln, nth = (size_t)NGW * 64;
        cvt_job(INP(I_XP), XB, (size_t)MP * D, gt, nth, XB8, XB_SCALE);
        cvt_job(INP(I_XS), XB + (size_t)MP * D, (size_t)MS * D, gt, nth, XB8 + (size_t)MP * D, XB_SCALE);
        cvt_job(INP(I_MEMP), MEMB, (size_t)512 * D, gt, nth);
        cvt_job(INP(I_PKEYS), KEYB, (size_t)2 * 8 * 2 * 128 * 128, gt, nth);
        cvt_job(INP(I_CMK), CMK, (size_t)2 * 16 * 256 * 1024, gt, nth);
        for (size_t i = gt; i < (size_t)8 * 128 * 128; i += nth) { const int s = (int)(i & 127), t = (int)((i >> 7) & 127); const float v = (s <= t) ? INP(I_SGUW)[i] : 0.f; SWB[i] = (bf16)(pk2(v, 0.f) & 0xffffu); }
    }
    SEAM(0);
    if (IN(1)) REP(1) { int ln = lane; asm volatile("" : "+v"(ln)); int tq = tid; asm volatile("" : "+v"(tq));
        EpiA E{BUFA, QM, BUFB, VST, out, MKB, MVT};
        { pg8::MultiOrder<JobsA> S; S.G = G; S.c = bx; S.jt = JobsA{XB, Wa, MEMB, Wmkv};
          pg8::gemm_phase<EpiA, pg8::MultiOrder<JobsA>>(L, S, E, tq); }
        { constexpr int off = 72;
          pg8::MultiOrder<JobsA8, pg8::TSTEP / 2> S; S.G = G; S.c = (G == 256) ? ((bx + 256 - off) & 255) : bx; S.jt = JobsA8{XB8, Wa8};
          int tq2 = tid; asm volatile("" : "+v"(tq2));
          pg8::gemm_phase<EpiA, pg8::MultiOrder<JobsA8, pg8::TSTEP / 2>, true>(L, S, E, tq2); }
    }
    SEAM(1);
    if (IN(2)) REP(2) { int ln = lane; asm volatile("" : "+v"(ln)); int tq = tid; asm volatile("" : "+v"(tq));
        { const int sh = (320 > G) ? (320 - G) : 0;
          for (int t = ((vcu + sh) % G); t < 320; t += G) mem_wg(t, 0, QM, MKB, MVT, CMK, CMVT, CAT, L, tq, wave, ln); }
        AW_BAR();
        LAS float* stl = (LAS float*)(L + wave * 2048);
        constexpr int NSGU = 80 * 8 * 3;
        for (int t = gw; t < NSGU; t += NGW) sgu_task(t, BUFA, BUFB, VST, SWB, INP(I_SLNG), INP(I_SLNB), INP(I_SGUB), CAT, out, stl, ln);
    }
    SEAM(2);
    if (IN(3)) REP(3) { int ln = lane; asm volatile("" : "+v"(ln)); int tq = tid; asm volatile("" : "+v"(tq));
        pg8::MultiOrder<Jobs1, pg8::TSTEP / 2> S; S.G = G; S.c = bx; S.jt = Jobs1{(const bf16*)CAT, (const bf16*)Wout8, 16, K_OUT};
        EpiOut<true> E{XB, XB + (size_t)MP * D, Z};
        pg8::gemm_phase<EpiOut<true>, pg8::MultiOrder<Jobs1, pg8::TSTEP / 2>, true>(L, S, E, tq);
        TAIL(544);
        if (in_tail) { fp4_rows_job(INP(I_PU), (unsigned*)PU8, SCU, 0, NEXP, gtw, ngtw, ln); fp4_rows_job(INP(I_PV), (unsigned*)PV8, SCV, 0, V0_A, gtw, ngtw, ln); }
    }
    SEAM(3);
    if (IN(4)) REP(4) { int ln = lane; asm volatile("" : "+v"(ln)); int tq = tid; asm volatile("" : "+v"(tq)); for (int m = gw; m < M; m += NGW) ln1_row(Z + (size_t)m * D, INP(I_LN1G), INP(I_LN1B), X1B + (size_t)m * D, X18 + (size_t)m * D, ln); }
    SEAM(4);
    if (IN(5)) REP(5) { int ln = lane; asm volatile("" : "+v"(ln)); int tq = tid; asm volatile("" : "+v"(tq));
        pg8::MultiOrder<Jobs1> S; S.G = G; S.c = bx; S.jt = Jobs1{X1B, Wq, 8, K_WQ};
        EpiWq E{PQ};
        pg8::gemm_phase<EpiWq, pg8::MultiOrder<Jobs1>>(L, S, E, tq);
        TAIL(272);
        if (in_tail) {
            tr_job_both(INP(I_WINB) + 3072, Wb + (size_t)3072 * KDIM, Wb8 + (size_t)4096 * KDIM, 4096, 6144, 10240, WIN_SCALE, scr, gtw, ngtw, ln);
            tr_job8(INP(I_WINB), Wb8, 4096, 3072, 10240, WIN_SCALE, scr, gtw, ngtw, ln);
            tr_job8(INP(I_WINB) + 9216, Wb8 + (size_t)3072 * KDIM, 4096, 1024, 10240, WIN_SCALE, scr, gtw, ngtw, ln);
            fp4_rows_job(INP(I_PV), (unsigned*)PV8, SCV, V0_A, V0_B, gtw, ngtw, ln);
        }
    }
    SEAM(5);
    if (IN(6)) REP(6) { int ln = lane; asm volatile("" : "+v"(ln)); int tq = tid; asm volatile("" : "+v"(tq)); for (int it = vcu; it < (M / 32) * 2; it += G) topk_item2(it, PQ, KEYB, IDX, GATE, (LAS unsigned*)L, (LAS unsigned*)(L + 131072), tq, wave, ln);
        { constexpr int items = (M / 32) * 2, busy = items - (items / 256) * 256;
          if (G == 256 ? vcu >= busy : true) { const int gtw = (G == 256 ? vcu - busy : vcu) * NWAVES + wave, ngtw = (G == 256 ? 256 - busy : G) * NWAVES;
            fp4_rows_job(INP(I_PV), (unsigned*)PV8, SCV, V0_B, NEXP, gtw, ngtw, ln); } } }
    SEAM(6);
#define PACT ((float*)(ws + WS_X1F))
#define ZB ((bf16*)(ws + WS_XF))
#define AV ((float*)(ws + WS_XF + 70 * MiB))
#define STAT ((float*)(ws + WS_XF + 76 * MiB))
#define PEER_SLICED(li, OUTF, OUTB, OUTB8) do { \
        int xg = (G % 8 == 0) ? 8 : 1, xk = bx % xg, wx = (bx / xg) * NWAVES + wave, nwx = (G / xg) * NWAVES; \
        if (N_LAUNCHES == 1) {     \
            if (tid == 0) { unsigned cnt = 0u, xi = 0u, mine = 0u; for (unsigned j = 0; j < 16u; ++j) { const unsigned c = xb_ld(&bar.bar[XB_XCNT(j)]); if (c) { ++cnt; if (j < bar.x) ++xi; } if (j == bar.x) mine = c; } MISC[11] = xi; MISC[12] = cnt; MISC[13] = mine; } \
            __syncthreads(); \
            xk = (int)MISC[11]; xg = (int)MISC[12]; wx = (int)MISC[10] * NWAVES + wave; nwx = (int)MISC[13] * NWAVES; __syncthreads(); } \
        const unsigned char* pu = PU8 + (size_t)(li) * NEXP * (D / 2); const unsigned char* pv = PV8 + (size_t)(li) * NEXP * (D / 2); \
        _Pragma("unroll 1") for (int step8 = 0; step8 < 8; ++step8) { const int step = step8 >> 1; const bool sdup = (MK_STEP_DUP >> step) & 1; if ((step8 & 1) && !sdup) continue; const int emk = (sdup && !(step8 & 1)) ? 127 : 0x3fff;                                         \
            if (step == 0) { for (int sub = xk; sub < NSUB; sub += xg) peer_u_pass_mfma(sub, wx, nwx, X18, IDX, pu + (size_t)sub * SUB_BYTES, PACT + (size_t)sub * M * 128, L + wave * 16384, ln, emk); } \
            else if (step == 1) { for (int t = gw; t < M; t += NGW) peer_a_token(t, IDX, GATE, PACT, SCU + (li) * NEXP, SCV + (li) * NEXP, AV, ln); } \
            else if (step == 2) { for (int sub = xk; sub < NSUB; sub += xg) peer_v_pass(sub, wx, nwx, X1B, IDX, AV, pv + (size_t)sub * SUB_BYTES, ZB, STAT + (size_t)sub * M * 2, (LAS f32x4*)(L + wave * 9216), ln, emk); } \
            else { for (int t = gw; t < M; t += NGW) ln2_row(t, ZB, STAT, INP(I_LN2G) + (li) * D, INP(I_LN2B) + (li) * D, OUTF, OUTB, OUTB8, ln); } \
            if (step8 < 7 && N_LAUNCHES == 1) xcd_barrier(bar); } \
    } while (0)
    if (IN(7)) REP(7) { int ln = lane; asm volatile("" : "+v"(ln)); int tq = tid; asm volatile("" : "+v"(tq)); (void)tq;
        PEER_SLICED(0, (float*)nullptr, XB + (size_t)t * D, XB8 + (size_t)t * D); }
    SEAM(7);
    if (IN(8)) REP(8) { int ln = lane; asm volatile("" : "+v"(ln)); int tq = tid; asm volatile("" : "+v"(tq));
        EpiB<false> E{BUFA, BUFC, QM, BUFB, out}; EpiB<true> E8{BUFA, BUFC, QM, BUFB, out};
        { pg8::MultiOrder<JobsB> S; S.G = G; S.c = bx; S.jt = JobsB{XB, Wb};
          pg8::gemm_phase<EpiB<false>, pg8::MultiOrder<JobsB>>(L, S, E, tq); }
        { constexpr int off = 64;
          pg8::MultiOrder<JobsB8, pg8::TSTEP / 2> S; S.G = G; S.c = (G == 256) ? ((bx + 256 - off) & 255) : bx; S.jt = JobsB8{XB8, Wb8};
          int tq2 = tid; asm volatile("" : "+v"(tq2));
          pg8::gemm_phase<EpiB<true>, pg8::MultiOrder<JobsB8, pg8::TSTEP / 2>, true>(L, S, E8, tq2); }
        const bool in_tail = bx >= 144 || G != 256; const int gtw = (G == 256 ? bx - 144 : bx) * NWAVES + wave, ngtw = (G == 256 ? 112 : G) * NWAVES;
        if (in_tail) { LAS float* scr = (LAS float*)(L + wave * 16640); const size_t gtt = (size_t)gtw * 64 + ln, ntt = (size_t)ngtw * 64;
            __syncthreads();
            tr_job(INP(I_CBV), CVT, 512, 3072, 16, (size_t)512 * 3072, (size_t)512 * 3072, scr, gtw, ngtw, ln);
            cvt_job(INP(I_CBK), CK, (size_t)16 * 512 * 3072, gtt, ntt);
            tr_job8(INP(I_WOUT) + (size_t)4096 * 4096, Wout8 + (size_t)4096 * 4096, 4096, 4096, 4096, WOUT_SCALE, scr, gtw, ngtw, ln); }
    }
    SEAM(8);
    if (IN(9)) REP(9) { int ln = lane; asm volatile("" : "+v"(ln)); int tq = tid; asm volatile("" : "+v"(tq));
        const int sub = (_r == 0) ? 7 : MK_P9_SUB;
        for (int t = vcu; t < 768 + 384; t += G) { if (t < 768) { if (sub & 1) band_wg2(t, BUFA, BUFC, BUFB, INP(I_RELB), CAT, L, tq, wave, ln, sub); } else if (sub & 2) band_wg(1536 + (t - 768), BUFA, BUFC, BUFB, CK, CVT, INP(I_RELB), CAT, L, tq, wave, ln); }
        AW_BAR();
        if (sub & 4) { const int sh = (1152 % G == 0) ? 0 : G - 1152 % G;
          for (int t = ((vcu + sh) % G); t < 320; t += G) mem_wg(t, 1, QM, MKB, MVT, CMK, CMVT, CAT, L, tq, wave, ln); }
    }
    SEAM(9);
    if (IN(10)) REP(10) { int ln = lane; asm volatile("" : "+v"(ln)); int tq = tid; asm volatile("" : "+v"(tq));
        pg8::MultiOrder<Jobs1, pg8::TSTEP / 2> S; S.G = G; S.c = bx; S.jt = Jobs1{(const bf16*)CAT, (const bf16*)(Wout8 + (size_t)4096 * 4096), 16, K_OUT};
        EpiOut<true> E{XB, XB + (size_t)MP * D, Z};
        pg8::gemm_phase<EpiOut<true>, pg8::MultiOrder<Jobs1, pg8::TSTEP / 2>, true>(L, S, E, tq);
        TAIL(544);
        if (in_tail) { __syncthreads();
            tr_job(INP(I_PWQ) + (size_t)4096 * 2048, Wq + (size_t)4096 * 2048, 4096, 2048, 1, 0, 0, scr, gtw, ngtw, ln);
            fp4_rows_job(INP(I_PU) + (size_t)NEXP * D, (unsigned*)(PU8 + (size_t)NEXP * (D / 2)), SCU + NEXP, 0, U1_A, gtw, ngtw, ln); }
    }
    SEAM(10);
    if (IN(11)) REP(11) { int ln = lane; asm volatile("" : "+v"(ln)); int tq = tid; asm volatile("" : "+v"(tq)); for (int m = gw; m < M; m += NGW) ln1_row(Z + (size_t)m * D, INP(I_LN1G) + D, INP(I_LN1B) + D, X1B + (size_t)m * D, X18 + (size_t)m * D, ln); }
    SEAM(11);
    if (IN(12)) REP(12) { int ln = lane; asm volatile("" : "+v"(ln)); int tq = tid; asm volatile("" : "+v"(tq));
        pg8::MultiOrder<Jobs1> S; S.G = G; S.c = bx; S.jt = Jobs1{X1B, Wq + (size_t)2048 * KDIM, 8, K_WQ};
        EpiWq E{PQ};
        pg8::gemm_phase<EpiWq, pg8::MultiOrder<Jobs1>>(L, S, E, tq);
        TAIL(272);
        if (in_tail) { fp4_rows_job(INP(I_PU) + (size_t)NEXP * D, (unsigned*)(PU8 + (size_t)NEXP * (D / 2)), SCU + NEXP, U1_A, NEXP, gtw, ngtw, ln);
            fp4_rows_job(INP(I_PV) + (size_t)NEXP * D, (unsigned*)(PV8 + (size_t)NEXP * (D / 2)), SCV + NEXP, 0, V1_A, gtw, ngtw, ln); }
    }
    SEAM(12);
    if (IN(13)) REP(13) { int ln = lane; asm volatile("" : "+v"(ln)); int tq = tid; asm volatile("" : "+v"(tq)); for (int it = vcu; it < (M / 32) * 2; it += G) topk_item2(it, PQ, KEYB + (size_t)8 * 2 * 128 * 128, IDX, GATE, (LAS unsigned*)L, (LAS unsigned*)(L + 131072), tq, wave, ln);
        { constexpr int items = (M / 32) * 2, busy = items - (items / 256) * 256;
          if (G == 256 ? vcu >= busy : true) { const int gtw = (G == 256 ? vcu - busy : vcu) * NWAVES + wave, ngtw = (G == 256 ? 256 - busy : G) * NWAVES;
            fp4_rows_job(INP(I_PV) + (size_t)NEXP * D, (unsigned*)(PV8 + (size_t)NEXP * (D / 2)), SCV + NEXP, V1_A, NEXP, gtw, ngtw, ln); } } }
    SEAM(13);
    if (IN(14)) REP(14) { int ln = lane; asm volatile("" : "+v"(ln)); int tq = tid; asm volatile("" : "+v"(tq)); (void)tq;
        PEER_SLICED(1, out + O_YP + (size_t)t * D, (bf16*)nullptr, (unsigned char*)nullptr); }
#undef IN
#undef SEAM
#undef INP
}


#if MK_CHECK
constexpr int CW_CHK = 2048;
__device__ inline unsigned hsh(unsigned x) { x ^= x >> 16; x *= 0x7feb352du; x ^= x >> 15; x *= 0x846ca68bu; x ^= x >> 16; return x; }
__device__ inline float b2f(bf16 b) { return __uint_as_float(((unsigned)b) << 16); }
__device__ inline bf16 f2b(float f) { unsigned u = __float_as_uint(f); u += 0x7fffu + ((u >> 16) & 1u); return (bf16)(u >> 16); }
__device__ inline bool badv(float got, float ref, float rtol, float atol) { return !(fabsf(got - ref) <= rtol * fabsf(ref) + atol); }
__device__ inline float gelu_ref(float x) { return 0.5f * x * (1.0f + tanhf(0.7978845608f * (x + 0.044715f * x * x * x))); }
__device__ inline float dotbb(const bf16* a, const bf16* b, int n) { float s = 0.f; for (int k = 0; k < n; ++k) s += b2f(a[k]) * b2f(b[k]); return s; }
#define FLAG(id) atomicAdd(chk + (id), 1u)
__global__ void chk_tr(const float* src, const bf16* dst, int K, int N, int nmat, unsigned* chk, int id) {
    const unsigned i = blockIdx.x * blockDim.x + threadIdx.x; const unsigned r = hsh(i * 3u + 1u), r2 = hsh(i * 3u + 2u), r3 = hsh(i * 3u + 3u);
    const int mi = r % nmat, k = r2 % K, n = r3 % N; const size_t mo = (size_t)mi * K * N;
    if (dst[mo + (size_t)n * K + k] != f2b(src[mo + (size_t)k * N + n])) FLAG(id);
}
__global__ void chk_cvt(const float* src, const bf16* dst, size_t n, unsigned* chk, int id) {
    const unsigned i = blockIdx.x * blockDim.x + threadIdx.x; const size_t j = ((size_t)hsh(i) * 2654435761ull + hsh(i + 77u)) % n;
    if (dst[j] != f2b(src[j])) FLAG(id);
}
__global__ void chk_swb(const float* src, const bf16* dst, unsigned* chk, int id) {
    const unsigned i = blockIdx.x * blockDim.x + threadIdx.x; if (i >= 8 * 128 * 128) return; const int s_ = i & 127, t = (i >> 7) & 127;
    if (dst[i] != f2b(s_ <= t ? src[i] : 0.f)) FLAG(id);
}
__global__ void chk_gemm(const bf16* A, const bf16* B, int Mr, int Nr, const void* O, int ldo, int mode, int act, float scale, unsigned* chk, int id) {
    const unsigned i = blockIdx.x * blockDim.x + threadIdx.x; const int m = hsh(i * 2u + 11u) % Mr, n = hsh(i * 2u + 12u) % Nr;
    float d = dotbb(A + (size_t)m * KDIM, B + (size_t)n * KDIM, KDIM); if (act) d = gelu_ref(d); d *= scale;
    float got; if (mode == 0) got = b2f(((const bf16*)O)[(size_t)m * ldo + n]); else if (mode == 1) got = b2f(((const bf16*)O)[(size_t)n * ldo + m]); else got = ((const float*)O)[(size_t)m * ldo + n];
    if (badv(got, d, 0.012f, 0.004f)) FLAG(id);
}
__global__ void chk_bandout(const bf16* XBp, const bf16* Wrows, const float* out, unsigned* chk, int id) {
    const unsigned i = blockIdx.x * blockDim.x + threadIdx.x; const int r = hsh(i * 2u + 5u) % 1536, c = hsh(i * 2u + 6u) % TOK;
    int m; const float* o;
    if (r < 1024) { const int b = r >> 9, rr = r & 511; m = b * 4096 + 3584 + rr; o = out + (id & 1 ? O_BVP : O_BKP) + ((size_t)(b * 512 + rr)) * TOK + c; }
    else { m = MP + (r - 1024); o = out + (id & 1 ? O_BVS : O_BKS) + (size_t)(r - 1024) * TOK + c; }
    const float d = dotbb(XBp + (size_t)m * KDIM, Wrows + (size_t)c * KDIM, KDIM);
    if (badv(*o, d, 0.002f, 0.002f)) FLAG(id);
}
__global__ void chk_vst(const bf16* VT, const float* vst, unsigned* chk, int id) {
    const unsigned i = blockIdx.x * blockDim.x + threadIdx.x; const int t = hsh(i + 3u) % M; float s = 0.f, q = 0.f, s2 = 0.f, q2 = 0.f;
    for (int c = 0; c < TOK; ++c) { const float v = b2f(VT[(size_t)c * M + t]); s += v; q += v * v; }
    for (int sl = 0; sl < 24; ++sl) { s2 += vst[((size_t)sl * M + t) * 2]; q2 += vst[((size_t)sl * M + t) * 2 + 1]; }
    if (badv(s2, s, 0.01f, 0.5f) || badv(q2, q, 0.01f, 0.5f)) FLAG(id);
}
__device__ inline void ln_stats_tok(const bf16* VT, int t, float& mean, float& rstd) { float s = 0.f, q = 0.f; for (int c = 0; c < TOK; ++c) { const float v = b2f(VT[(size_t)c * M + t]); s += v; q += v * v; } mean = s / TOK; rstd = rsqrtf(q / TOK - mean * mean + LN_EPS); }
__global__ void chk_sgu(const bf16* U, const bf16* VT, const float* sguw, const float* sgub, const float* lng, const float* lnb, const bf16* CATp, const float* out, unsigned* chk, int id) {
    const unsigned i = blockIdx.x * blockDim.x + threadIdx.x; const int t = hsh(i * 2u + 1u) % M, col = hsh(i * 2u + 2u) % TOK, g = col / 384;
    int t0, tl; if (t < MP) { t0 = t & ~127; tl = t & 127; } else { t0 = MP + ((t - MP) & ~31); tl = (t - MP) & 31; }
    float acc = 0.f, vn_t = 0.f;
    for (int s_ = 0; s_ <= tl; ++s_) { float mean, rstd; ln_stats_tok(VT, t0 + s_, mean, rstd); const float vn = (b2f(VT[(size_t)col * M + t0 + s_]) - mean) * rstd * lng[col] + lnb[col];
        acc += sguw[((size_t)g * 128 + tl) * 128 + s_] * vn; if (s_ == tl) vn_t = vn; }
    const float ref = b2f(U[(size_t)t * TOK + col]) * (acc + sgub[g * 128 + tl]);
    if (badv(b2f(CATp[(size_t)t * D + col]), ref, 0.03f, 0.01f)) FLAG(id);
    if (t >= MP && badv(out[O_SGV + (size_t)(t - MP) * TOK + col], vn_t, 0.01f, 0.01f)) FLAG(id + 1);
}
__global__ void chk_memattn(int li, const bf16* QMp, const bf16* MKBp, const bf16* MVTp, const float* cmk, const float* cmv, const bf16* CATp, unsigned* chk, int id) {
    __shared__ float sc[256]; __shared__ float red[256];
    const unsigned i = blockIdx.x; const int t = hsh(i * 3u + 1u) % M, hm = hsh(i * 3u + 2u) & 3, d = hsh(i * 3u + 3u) & 255, m = threadIdx.x;
    float s = 0.f;
    for (int k = 0; k < 256; ++k) { const float q = b2f(QMp[(size_t)t * MEMW + hm * 256 + k]);
        const float kk = (t < MP) ? b2f(MKBp[((size_t)li * 512 + (t >> 12) * 256 + m) * 1024 + hm * 256 + k]) : cmk[(((size_t)(li * 16 + ((t - MP) >> 5)) * 256 + m) * 4 + hm) * 256 + k];
        s += q * kk; }
    sc[m] = s; __syncthreads();
    if (m == 0) { float mx = -1e30f, den = 0.f, num = 0.f; for (int j = 0; j < 256; ++j) mx = fmaxf(mx, sc[j]);
        for (int j = 0; j < 256; ++j) { const float p = expf(sc[j] - mx); den += p;
            const float v = (t < MP) ? b2f(MVTp[((size_t)li * 1024 + hm * 256 + d) * 512 + (t >> 12) * 256 + j]) : cmv[(((size_t)(li * 16 + ((t - MP) >> 5)) * 256 + j) * 4 + hm) * 256 + d];
            num += p * v; }
        if (badv(b2f(CATp[(size_t)t * D + TOK + hm * 256 + d]), num / den, 0.03f, 0.003f)) FLAG(id); }
    (void)red;
}
__global__ void chk_band(const bf16* Qb, const bf16* Kb, const bf16* VT, const float* cbk, const float* cbv, const float* relb, const bf16* CATp, unsigned* chk, int id) {
    const unsigned i = blockIdx.x * blockDim.x + threadIdx.x; const int t = hsh(i * 3u + 1u) % M, h = hsh(i * 3u + 2u) % 24, d = hsh(i * 3u + 3u) & 127;
    float mx = -1e30f, den = 0.f, num = 0.f;
    for (int pass = 0; pass < 2; ++pass) {
        const int nk = (t < MP) ? 576 : 544;
        for (int j = 0; j < nk; ++j) {
            int qpos, kpos; float kv[2]; const bf16* kr = nullptr; const float* krf = nullptr; float vv;
            if (t < MP) { const int b = t >> 12, tt = t & 4095, c = tt >> 6; qpos = tt; kpos = c * 64 - 512 + j; if (kpos < 0) continue;
                kr = Kb + ((size_t)(b * 4096 + kpos)) * TOK + h * 128; vv = b2f(VT[(size_t)(h * 128 + d) * M + b * 4096 + kpos]); }
            else { const int sb = (t - MP) >> 5, tt = (t - MP) & 31; qpos = 1024 + tt; kpos = 512 + j;
                if (j < 512) { krf = cbk + (((size_t)sb * 512 + j) * 24 + h) * 128; vv = cbv[(((size_t)sb * 512 + j) * 24 + h) * 128 + d]; }
                else { kr = Kb + ((size_t)(MP + sb * 32 + (j - 512))) * TOK + h * 128; vv = b2f(VT[(size_t)(h * 128 + d) * M + MP + sb * 32 + (j - 512)]); } }
            float s = 0.f; for (int k = 0; k < 128; ++k) s += b2f(Qb[(size_t)t * TOK + h * 128 + k]) * (kr ? b2f(kr[k]) : krf[k]);
            int rel = qpos - kpos; rel = rel < -128 ? -128 : (rel > 128 ? 128 : rel); s += relb[h * 257 + rel + 128]; (void)kv;
            if (pass == 0) mx = fmaxf(mx, s); else { const float p = expf(s - mx); den += p; num += p * vv; }
        }
    }
    if (badv(b2f(CATp[(size_t)t * D + h * 128 + d]), num / den, 0.03f, 0.004f)) FLAG(id);
}
__global__ void chk_z(const float* xp, const float* xs, const bf16* CATp, const bf16* Wo, const float* Zp, unsigned* chk, int id) {
    const unsigned i = blockIdx.x * blockDim.x + threadIdx.x; const int m = hsh(i * 2u + 1u) % M, n = hsh(i * 2u + 2u) % D;
    const float x = (m < MP) ? xp[(size_t)m * D + n] : xs[(size_t)(m - MP) * D + n];
    if (badv(Zp[(size_t)m * D + n], ALPHA * x + dotbb(CATp + (size_t)m * D, Wo + (size_t)n * D, D), 0.002f, 0.004f)) FLAG(id);
}
__global__ void chk_ln1(const float* Zp, const float* g, const float* b, const float* xf, const bf16* xb, unsigned* chk, int id) {
    const unsigned i = blockIdx.x * blockDim.x + threadIdx.x; const int m = hsh(i + 9u) % M; const float* z = Zp + (size_t)m * D; float s = 0.f, q = 0.f;
    for (int k = 0; k < D; ++k) s += z[k]; const float mean = s / D; for (int k = 0; k < D; ++k) q += (z[k] - mean) * (z[k] - mean); const float rstd = rsqrtf(q / D + LN_EPS);
    for (int k = (i & 7); k < D; k += 8) { const float y = (z[k] - mean) * rstd * g[k] + b[k]; if (badv(xf[(size_t)m * D + k], y, 0.001f, 0.001f) || badv(b2f(xb[(size_t)m * D + k]), y, 0.01f, 0.002f)) { FLAG(id); break; } }
}
__global__ void chk_topk(const bf16* PQp, const bf16* KEYp, const int* IDXp, const float* GATEp, unsigned* chk, int id) {
    __shared__ float s0[128], s1[128]; __shared__ float bs[16]; __shared__ int be[16];
    const unsigned i = blockIdx.x; const int t = hsh(i * 2u + 1u) % M, h = hsh(i * 2u + 2u) & 7, n = threadIdx.x;
    s0[n] = dotbb(PQp + (size_t)t * 2048 + h * 256, KEYp + ((size_t)(h * 2 + 0) * 128 + n) * 128, 128); s1[n] = dotbb(PQp + (size_t)t * 2048 + h * 256 + 128, KEYp + ((size_t)(h * 2 + 1) * 128 + n) * 128, 128);
    __syncthreads();
    if (n == 0) {
        float last = 3e38f; int laste = -1;
        for (int r = 0; r < 16; ++r) { float best = -3e38f; int beste = -1;
            for (int e = 0; e < 16384; ++e) { const float v = s0[e >> 7] + s1[e & 127]; if ((v < last || (v == last && e > laste)) && v > best) { best = v; beste = e; } }
            bs[r] = best; be[r] = beste; last = best; laste = beste; }
        float den = 0.f; for (int r = 0; r < 16; ++r) den += expf(bs[r] - bs[0]);
        int miss = 0; float gerr = 0.f;
        for (int r = 0; r < 16; ++r) { const int e = IDXp[(size_t)t * 128 + h * 16 + r]; const float gg = GATEp[(size_t)t * 128 + h * 16 + r]; int f = -1; for (int q = 0; q < 16; ++q) if (be[q] == e) f = q;
            if (f < 0) { ++miss; if (e < 0 || e >= 16384 || s0[e >> 7] + s1[e & 127] < bs[15] - 1e-3f) miss += 100; } else gerr = fmaxf(gerr, fabsf(gg - expf(bs[f] - bs[0]) / den)); }
        if (miss > 1 || gerr > 2e-3f) FLAG(id);
    }
}
__global__ void chk_peer(const float* X1Fp, const int* IDXp, const float* GATEp, const float* pu, const float* pv, const float* g2, const float* b2, const float* of0, const float* of1, const bf16* ob, const float* adbg, unsigned* chk, int id) {
    __shared__ float a[128]; __shared__ float red[256]; __shared__ float zrow[D];
    const int t = hsh(blockIdx.x + 1234u) % M, tid = threadIdx.x; const float* x = X1Fp + (size_t)t * D;
    if (tid < 128) { const int e = IDXp[(size_t)t * 128 + tid]; float d = 0.f; for (int k = 0; k < D; ++k) d += x[k] * pu[(size_t)e * D + k]; a[tid] = GATEp[(size_t)t * 128 + tid] * gelu_ref(d); }
    if (tid < 128 && badv(adbg[(size_t)t * 128 + tid], a[tid], 0.02f, 2e-4f)) FLAG(32);
    __syncthreads();
    float s = 0.f;
    for (int c = tid; c < D; c += 256) { float y = 0.f; for (int k = 0; k < 128; ++k) y += a[k] * pv[(size_t)IDXp[(size_t)t * 128 + k] * D + c]; const float z = ALPHA * x[c] + y; zrow[c] = z; s += z; }
    red[tid] = s; __syncthreads(); for (int o = 128; o > 0; o >>= 1) { if (tid < o) red[tid] += red[tid + o]; __syncthreads(); } const float mean = red[0] / D; __syncthreads();
    float q = 0.f; for (int c = tid; c < D; c += 256) q += (zrow[c] - mean) * (zrow[c] - mean);
    red[tid] = q; __syncthreads(); for (int o = 128; o > 0; o >>= 1) { if (tid < o) red[tid] += red[tid + o]; __syncthreads(); } const float rstd = rsqrtf(red[0] / D + LN_EPS);
    const float* of = (t < MP) ? of0 + (size_t)t * D : of1 + (size_t)(t - MP) * D; int bad = 0;
    int bad2 = 0, bad3 = 0;
    for (int c = tid; c < D; c += 256) { const float y = (zrow[c] - mean) * rstd * g2[c] + b2[c]; if (badv(of[c], y, 0.01f, 0.01f)) bad = 1; if (badv(of[c], y, 0.1f, 0.1f)) bad2 = 1; if (badv(of[c], y, 1.0f, 1.0f)) bad3 = 1; if (ob && badv(b2f(ob[(size_t)t * D + c]), y, 0.015f, 0.012f)) bad = 1; }
    if (bad) FLAG(id); if (bad2) FLAG(33); if (bad3) FLAG(34);
}
__global__ void chk_report(const unsigned* chk, float* out) {
    int first = 0; for (int k = 31; k >= 1; --k) if (chk[k]) first = k;
    if ((first == 17 || first == 27) && chk[32]) first = 50; else
    if (first == 17 || first == 27) { if (chk[34]) first = 60; else if (chk[33]) first = 40; if (chk[17] + chk[27] >= 64 * 128) first += 5; }
    if (first) for (size_t i = blockIdx.x * blockDim.x + threadIdx.x; i < (size_t)MS * D; i += (size_t)gridDim.x * blockDim.x) out[O_YS + i] *= (1.0f + first);
}
#endif

extern "C" void kernel_launch(void* const* d_in, const int* in_sizes, int n_in, void* d_out, int out_size, void* d_ws, size_t ws_size, hipStream_t stream) {
    static int grid = 0;
    if (grid == 0) {
        if (n_in != 24 || (size_t)out_size != O_END || ws_size < WS_END) { fprintf(stderr, "kernel_launch: unexpected shapes: n_in %d out %d ws %zu (need %zu)\n", n_in, out_size, ws_size, (size_t)WS_END); grid = -1; return; }
        int dev = 0, cus = 0, per_cu = 0;
        if (hipGetDevice(&dev) != hipSuccess || hipDeviceGetAttribute(&cus, hipDeviceAttributeMultiprocessorCount, dev) != hipSuccess) { grid = -1; return; }
        if (hipFuncSetAttribute((const void*)mk_fwd, hipFuncAttributeMaxDynamicSharedMemorySize, LDS_BYTES) != hipSuccess) { fprintf(stderr, "kernel_launch: hipFuncSetAttribute failed\n"); grid = -1; return; }
        if (hipOccupancyMaxActiveBlocksPerMultiprocessor(&per_cu, (const void*)mk_fwd, NWAVES * 64, LDS_BYTES) != hipSuccess || per_cu < 1) { fprintf(stderr, "kernel_launch: occupancy query says %d\n", per_cu); }
        (void)hipGetLastError();
        grid = cus;
    }
    if (grid < 0) return;
    if (hipMemsetAsync((char*)d_ws + WS_CTL, 0, CTL_ZERO_BYTES, stream) != hipSuccess) return;
    Args a{};
    for (int i = 0; i < 24; ++i) a.in[i] = (const float*)d_in[i];
    a.out = (float*)d_out; a.ws = (unsigned char*)d_ws; a.dup = MK_DUP_MASK; a.pad = 0;
    for (int li = 0; li < N_LAUNCHES; ++li) {
        a.ph_lo = (N_LAUNCHES == 1) ? 0 : li; a.ph_hi = (N_LAUNCHES == 1) ? NPHASES : li + 1;
        hipLaunchKernelGGL(mk_fwd, dim3(grid), dim3(NWAVES * 64), LDS_BYTES, stream, a);
#if MK_CHECK
        {   unsigned char* ws = (unsigned char*)d_ws; unsigned* chk = (unsigned*)(ws + WS_CTL) + CW_CHK; float* out = (float*)d_out; const float* const* in = a.in;
#define CK1(kern, n, ...) hipLaunchKernelGGL(kern, dim3(((n) + 255) / 256), dim3(256), 0, stream, __VA_ARGS__)
            const int ph = a.ph_lo;
            if (ph == 0) {
                CK1(chk_tr, 65536, in[I_WINA], Wa, 4096, 7168, 1, chk, 1); CK1(chk_tr, 65536, in[I_WINB], Wb, 4096, 10240, 1, chk, 1); CK1(chk_tr, 65536, in[I_WMKV], Wmkv, 4096, 2048, 2, chk, 1);
                CK1(chk_tr, 65536, in[I_WOUT], Wout, 4096, 4096, 2, chk, 1); CK1(chk_tr, 65536, in[I_PWQ], Wq, 4096, 2048, 2, chk, 1); CK1(chk_tr, 65536, in[I_CMV], CMVT, 256, 1024, 32, chk, 2); CK1(chk_tr, 65536, in[I_CBV], CVT, 512, 3072, 16, chk, 2);
                CK1(chk_cvt, 65536, in[I_XP], XB, (size_t)MP * D, chk, 3); CK1(chk_cvt, 65536, in[I_XS], XB + (size_t)MP * D, (size_t)MS * D, chk, 3); CK1(chk_cvt, 65536, in[I_MEMP], MEMB, (size_t)512 * D, chk, 3);
                CK1(chk_cvt, 65536, in[I_PKEYS], KEYB, (size_t)2 * 8 * 2 * 128 * 128, chk, 3); CK1(chk_cvt, 65536, in[I_CMK], CMK, (size_t)2 * 16 * 256 * 1024, chk, 3); CK1(chk_cvt, 65536, in[I_CBK], CK, (size_t)16 * 512 * 3072, chk, 3);
                CK1(chk_swb, 8 * 128 * 128, in[I_SGUW], SWB, chk, 3);
            } else if (ph == 1) {
                CK1(chk_gemm, 32768, XB, Wa, M, 3072, BUFA, 3072, 0, 1, 1.0f, chk, 4);
                CK1(chk_gemm, 32768, XB, Wa + (size_t)6144 * KDIM, M, 1024, QM, 1024, 0, 0, 0.0625f, chk, 5);
                CK1(chk_gemm, 32768, XB, Wa + (size_t)3072 * KDIM, M, 3072, BUFB, M, 1, 1, 1.0f, chk, 6);
                CK1(chk_vst, 2048, BUFB, VST, chk, 7);
                for (int li = 0; li < 2; ++li) {
                    CK1(chk_gemm, 16384, MEMB, Wmkv + (size_t)li * 2048 * KDIM, 512, 1024, MKB + (size_t)li * 512 * 1024, 1024, 0, 0, 1.0f, chk, 8);
                    CK1(chk_gemm, 16384, MEMB, Wmkv + (size_t)li * 2048 * KDIM, 512, 1024, out + O_MKP + (size_t)li * 512 * 1024, 1024, 2, 0, 1.0f, chk, 8);
                    CK1(chk_gemm, 16384, MEMB, Wmkv + ((size_t)li * 2048 + 1024) * KDIM, 512, 1024, out + O_MVP + (size_t)li * 512 * 1024, 1024, 2, 0, 1.0f, chk, 8);
                    CK1(chk_gemm, 16384, MEMB, Wmkv + ((size_t)li * 2048 + 1024) * KDIM, 512, 1024, MVT + (size_t)li * 1024 * 512, 512, 1, 0, 1.0f, chk, 9); }
            } else if (ph == 2) {
                CK1(chk_sgu, 2048, BUFA, BUFB, in[I_SGUW], in[I_SGUB], in[I_SLNG], in[I_SLNB], CAT, out, chk, 10);
                hipLaunchKernelGGL(chk_memattn, dim3(2048), dim3(256), 0, stream, 0, QM, MKB, MVT, in[I_CMK], in[I_CMV], CAT, chk, 12);
            } else if (ph == 3 || ph == 10) {
                if (ph == 3) CK1(chk_z, 32768, in[I_XP], in[I_XS], CAT, Wout, Z, chk, 13); else CK1(chk_z, 32768, XF, XF + (size_t)MP * D, CAT, Wout + (size_t)4096 * KDIM, Z, chk, 23);
            } else if (ph == 4 || ph == 11) { const int li = ph == 11; CK1(chk_ln1, 2048, Z, in[I_LN1G] + li * D, in[I_LN1B] + li * D, X1F, X1B, chk, li ? 24 : 14);
            } else if (ph == 5 || ph == 12) { const int li = ph == 12; CK1(chk_gemm, 32768, X1B, Wq + (size_t)li * 2048 * KDIM, M, 2048, PQ, 2048, 0, 0, 1.0f, chk, li ? 25 : 15);
            } else if (ph == 6 || ph == 13) { const int li = ph == 13; hipLaunchKernelGGL(chk_topk, dim3(1024), dim3(128), 0, stream, PQ, KEYB + (size_t)li * 8 * 2 * 128 * 128, IDX, GATE, chk, li ? 26 : 16);
            } else if (ph == 7) { hipLaunchKernelGGL(chk_peer, dim3(64), dim3(256), 0, stream, X1F, IDX, GATE, in[I_PU], in[I_PV], in[I_LN2G], in[I_LN2B], XF, XF + (size_t)MP * D, XB, (const float*)(ws + WS_END), chk, 17);
            } else if (ph == 8) {
                CK1(chk_gemm, 32768, XB, Wb, M, 3072, BUFA, 3072, 0, 0, 0.08838834764831845f, chk, 18);
                CK1(chk_gemm, 32768, XB, Wb + (size_t)3072 * KDIM, M, 3072, BUFC, 3072, 0, 0, 1.0f, chk, 19);
                CK1(chk_gemm, 32768, XB, Wb + (size_t)6144 * KDIM, M, 3072, BUFB, M, 1, 0, 1.0f, chk, 20);
                CK1(chk_gemm, 32768, XB, Wb + (size_t)9216 * KDIM, M, 1024, QM, 1024, 0, 0, 0.0625f, chk, 19);
                CK1(chk_bandout, 16384, XB, Wb + (size_t)3072 * KDIM, out, chk, 28); CK1(chk_bandout, 16384, XB, Wb + (size_t)6144 * KDIM, out, chk, 29);
            } else if (ph == 9) {
                CK1(chk_band, 8192, BUFA, BUFC, BUFB, in[I_CBK], in[I_CBV], in[I_RELB], CAT, chk, 21);
                hipLaunchKernelGGL(chk_memattn, dim3(2048), dim3(256), 0, stream, 1, QM, MKB, MVT, in[I_CMK], in[I_CMV], CAT, chk, 22);
            } else if (ph == 14) {
                hipLaunchKernelGGL(chk_peer, dim3(64), dim3(256), 0, stream, X1F, IDX, GATE, in[I_PU] + (size_t)NEXP * D, in[I_PV] + (size_t)NEXP * D, in[I_LN2G] + D, in[I_LN2B] + D, out + O_YP, out + O_YS, (const bf16*)nullptr, (const float*)(ws + WS_END), chk, 27);
                hipLaunchKernelGGL(chk_report, dim3(256), dim3(256), 0, stream, chk, out);
            }
#undef CK1
        }
#endif
    }
}
```

```cpp
#include <hip/hip_runtime.h>
#include <cstdio>
#include <cstdint>

#define GAS __attribute__((address_space(1)))
#define LAS __attribute__((address_space(3)))
#define DI __device__ __forceinline__
typedef unsigned short bf16;
typedef short bf16x8 __attribute__((ext_vector_type(8)));
typedef float f32x4 __attribute__((ext_vector_type(4)));
typedef float f32x2 __attribute__((ext_vector_type(2)));
typedef unsigned u32x4 __attribute__((ext_vector_type(4)));
typedef unsigned u32x2 __attribute__((ext_vector_type(2)));
typedef __bf16 bf2_t __attribute__((ext_vector_type(2)));

#ifndef MK_CHECK
#define MK_CHECK 0
#endif
#ifndef MK_N_LAUNCHES
#define MK_N_LAUNCHES 1
#endif
constexpr int NPHASES = 15;
constexpr int U1_A = 8192, V1_A = 12288;
constexpr int V0_A = 4096, V0_B = 12288;
#ifndef MK_P9_SUB
#define MK_P9_SUB 1
#endif
#ifndef MK_STEP_DUP
#define MK_STEP_DUP 0
#endif
#ifndef MK_DUP_MASK
#define MK_DUP_MASK 0
#endif
constexpr int N_LAUNCHES = MK_N_LAUNCHES;

constexpr int D = 4096, MP = 8192, MS = 512, M = MP + MS;
constexpr int TOK = 3072, MEMW = 1024;
constexpr int NEXP = 16384;
constexpr float ALPHA = 1.41421356237f;
constexpr float LN_EPS = 1e-5f;
constexpr int KDIM = 4096;

constexpr size_t O_YP = 0, O_YS = 33554432, O_BKP = 35651584, O_BVP = 38797312, O_MKP = 41943040, O_MVP = 42991616,
                 O_BKS = 44040192, O_BVS = 45613056, O_SGV = 47185920, O_END = 48758784;

constexpr size_t MiB = 1u << 20;
constexpr size_t WS_CTL = 0, CTL_ZERO_BYTES = 2 * MiB;
constexpr size_t WS_WA = 4 * MiB, WS_WB = 60 * MiB, WS_WMKV = 140 * MiB, WS_WOUT = 172 * MiB, WS_WQ = 236 * MiB, WS_KEYB = 268 * MiB, WS_SWB = 269 * MiB;
constexpr size_t WS_PU = 270 * MiB, WS_SCU = 400 * MiB, WS_PV = 526 * MiB, WS_SCV = 656 * MiB,
                  WS_XB = 782 * MiB, WS_XF = 850 * MiB, WS_MEMB = 986 * MiB, WS_MKB = 990 * MiB, WS_MVT = 992 * MiB;
constexpr size_t WS_CMK = 994 * MiB, WS_CMVT = 1010 * MiB, WS_CK = 1026 * MiB, WS_CVT = 1074 * MiB;
constexpr size_t WS_BUFA = 1122 * MiB, WS_BUFB = 1173 * MiB, WS_BUFC = 1224 * MiB, WS_QM = 1275 * MiB, WS_CAT = 1292 * MiB;
constexpr size_t WS_Z = 1360 * MiB, WS_X1F = 1496 * MiB, WS_X1B = 1632 * MiB, WS_PQ = 1700 * MiB, WS_IDX = 1734 * MiB, WS_GATE = 1739 * MiB, WS_VST = 1744 * MiB, WS_XB8 = 1746 * MiB, WS_WA8 = 1780 * MiB, WS_WB8 = 1808 * MiB, WS_END = 1848 * MiB;
constexpr int CW_TMO = 0, CW_BAR = 4096;

constexpr int RING_BYTES = 131072;
constexpr int LDSCTL_OFF = 163328, MISC_OFF = LDSCTL_OFF + 320;
constexpr int LDS_BYTES = 163840;
constexpr int NWAVES = 8;

DI unsigned pk2(float lo, float hi) { return __builtin_bit_cast(unsigned, __builtin_convertvector((f32x2){lo, hi}, bf2_t)); }
DI unsigned pk4_fp8(float a, float b, float c, float d) {
    a = fminf(fmaxf(a, -448.f), 448.f); b = fminf(fmaxf(b, -448.f), 448.f); c = fminf(fmaxf(c, -448.f), 448.f); d = fminf(fmaxf(d, -448.f), 448.f);
    int w = 0; w = __builtin_amdgcn_cvt_pk_fp8_f32(a, b, w, false); w = __builtin_amdgcn_cvt_pk_fp8_f32(c, d, w, true); return (unsigned)w; }
constexpr float CAT_SCALE = 32.0f, WOUT_SCALE = 2048.0f, XB_SCALE = 16.0f, WIN_SCALE = 2048.0f;
DI float bflo(unsigned u) { return __uint_as_float(u << 16); }
DI float bfhi(unsigned u) { return __uint_as_float(u & 0xffff0000u); }
DI float gelu_tanh(float x) {
    const float t = x * (1.0f + 0.044715f * x * x);
    return x * __builtin_amdgcn_rcpf(1.0f + __builtin_amdgcn_exp2f(-2.3022081984f * t));
}
DI float wave_sum(float v) {
#pragma unroll
    for (int o = 1; o < 64; o <<= 1) v += __shfl_xor(v, o);
    return v;
}
DI float row16_sum(float x) {
    x += __builtin_bit_cast(float, __builtin_amdgcn_update_dpp(0, __builtin_bit_cast(int, x), 0x128, 0xf, 0xf, false));
    x += __builtin_bit_cast(float, __builtin_amdgcn_update_dpp(0, __builtin_bit_cast(int, x), 0x124, 0xf, 0xf, false));
    x += __builtin_bit_cast(float, __builtin_amdgcn_update_dpp(0, __builtin_bit_cast(int, x), 0x122, 0xf, 0xf, false));
    x += __builtin_bit_cast(float, __builtin_amdgcn_update_dpp(0, __builtin_bit_cast(int, x), 0x121, 0xf, 0xf, false));
    return x;
}
#define LDS_WAIT() asm volatile("s_waitcnt lgkmcnt(0)" ::: "memory")
#define VM_WAIT() asm volatile("s_waitcnt vmcnt(0)" ::: "memory")

namespace pg8 {
constexpr int BM = 256, BK = 64, HALF = 128, HTB = HALF * BK * 2, STAGE_BYTES = 8 * HTB, NXCD = 8, WGM = 8;
DI int lds_byte(int r, int c) { const int st = (r >> 4) * 2 + (c >> 5), rr = r & 15, cc = c & 31, ob = rr * 64 + cc * 2; return st * 1024 + (ob ^ (((ob >> 9) & 1) << 5)); }
DI void stage_rc(int b, int& R, int& C) { const int st = b / 1024, sb = b % 1024, swz = sb ^ (((sb >> 9) & 1) << 5); R = (st >> 1) * 16 + swz / 64; C = (st & 1) * 32 + (swz % 64) / 2; }
DI int perm32(int rho) { const int n = rho >> 4, i = rho & 15; return 8 * (i >> 2) + 4 * n + (i & 3); }

typedef int v8i __attribute__((ext_vector_type(8))); typedef int v4i __attribute__((ext_vector_type(4)));
DI v8i cat8(bf16x8 a, bf16x8 b) { return __builtin_shufflevector(__builtin_bit_cast(v4i, a), __builtin_bit_cast(v4i, b), 0, 1, 2, 3, 4, 5, 6, 7); }
struct Unit { int pm, pn, kind, aux; const char* pA; const char* pB; };
struct Job { const bf16* A; const bf16* Bt; int nM, nN, kind, aux; int pm0 = 0, pn0 = 0; };
constexpr size_t TSTEP = (size_t)BM * KDIM * 2;

template <class JT, size_t TS = TSTEP> struct MultiOrder {
    JT jt; int G, c;
    DI bool next(int i, Unit& u) const {
        int L = i * G + c;
#pragma unroll
        for (int k = 0; k < JT::NJ; ++k) {
            const Job jb = jt.job(k);
            const int nM = jb.nM, nN = jb.nN, nwg = nM * nN;
            if (L < nwg) {
                unsigned wgid = (unsigned)L; { const unsigned q = (unsigned)nwg / NXCD, r = (unsigned)nwg % NXCD, xcd = wgid % NXCD, off = wgid / NXCD; wgid = (xcd < r ? xcd * (q + 1) : r * (q + 1) + (xcd - r) * q) + off; }
                const unsigned nig = WGM * (unsigned)nN, gid = wgid / nig, fm = gid * WGM, gsz = ((unsigned)nM - fm) < WGM ? ((unsigned)nM - fm) : WGM;
                u.pm = (int)(fm + ((wgid % nig) % gsz)); u.pn = (int)((wgid % nig) / gsz); u.kind = jb.kind; u.aux = jb.aux;
                u.pA = (const char*)jb.A + (size_t)u.pm * TS; u.pB = (const char*)jb.Bt + (size_t)u.pn * TS; u.pm += jb.pm0; u.pn += jb.pn0;
                return true;
            }
            L -= nwg;
        }
        return false;
    }
};

template <class Epi, class Sched, bool F8 = false>
DI void gemm_phase(LAS unsigned char* lds, const Sched& S, const Epi& E, const int tid) {
    constexpr int K = F8 ? KDIM / 2 : KDIM;
    const int wid = __builtin_amdgcn_readfirstlane(tid >> 6), lane = tid & 63, wr = wid >> 2, wc = wid & 3, fr = lane & 15, fq = lane >> 4;
    constexpr int nt = K / BK;
    unsigned voffA[2], voffB[2];
#pragma unroll
    for (int i = 0; i < 2; ++i) { int R, C; stage_rc(tid * 16 + i * 8192, R, C); const int Rb = ((R & ~31) + perm32(R & 31));
        voffA[i] = (unsigned)(R * K + C) * 2u; voffB[i] = (unsigned)(Rb * K + C) * 2u; }
    const size_t kstep = (size_t)(BK * 2);
    const size_t hstep = (size_t)HALF * K * 2;
    const unsigned ldsw = (unsigned)wid * 1024u;
    const int aoff = lds_byte(wr * 64 + fr, fq * 8), boff = lds_byte(wc * 32 + fr, fq * 8);
#define PG8_SA(b, h) (((b) * 2 + (h)) * HTB)
#define PG8_SB(b, h) ((4 + (b) * 2 + (h)) * HTB)
#define PG8_STAGE(bufoff, gbase, voff) do { _Pragma("unroll") for (int _i = 0; _i < 2; ++_i) \
        __builtin_amdgcn_global_load_lds((const unsigned*)((const char*)(gbase) + (voff)[_i]), (LAS unsigned*)(lds + (bufoff) + ldsw + _i * 8192), 16, 0, 0); } while (0)
#define PG8_LDA(dst, b, h) do { _Pragma("unroll") for (int m = 0; m < 4; ++m) { dst[m].lo = *(const LAS v4i*)(lds + PG8_SA(b, h) + aoff + m * 2048); dst[m].hi = *(const LAS v4i*)(lds + PG8_SA(b, h) + aoff + m * 2048 + 1024); } } while (0)
#define PG8_LDB(dst, b, h) do { _Pragma("unroll") for (int n = 0; n < 2; ++n) { dst[n].lo = *(const LAS v4i*)(lds + PG8_SB(b, h) + boff + n * 2048); dst[n].hi = *(const LAS v4i*)(lds + PG8_SB(b, h) + boff + n * 2048 + 1024); } } while (0)
#define PG8_MMA(ai, bj, At, Bt) do { __builtin_amdgcn_s_setprio(1); _Pragma("unroll") for (int m = 0; m < 4; ++m) _Pragma("unroll") for (int n = 0; n < 2; ++n) { \
        if constexpr (F8) { asm volatile("v_mfma_scale_f32_16x16x128_f8f6f4 %0, %1, %2, %0, %3, %3 op_sel_hi:[0,0,0]" : "+v"(acc[ai][bj][m][n]) : "v"(Bt[n]), "v"(At[m]), "v"(sc1)); } \
        else { const v4i _bl = Bt[n].lo, _bh = Bt[n].hi, _al = At[m].lo, _ah = At[m].hi;     \
               acc[ai][bj][m][n] = __builtin_amdgcn_mfma_f32_16x16x32_bf16(__builtin_bit_cast(bf16x8, _bl), __builtin_bit_cast(bf16x8, _al), acc[ai][bj][m][n], 0, 0, 0); \
               acc[ai][bj][m][n] = __builtin_amdgcn_mfma_f32_16x16x32_bf16(__builtin_bit_cast(bf16x8, _bh), __builtin_bit_cast(bf16x8, _ah), acc[ai][bj][m][n], 0, 0, 0); } } __builtin_amdgcn_s_setprio(0); } while (0)
#define PG8_WAIT_V(n) asm volatile("s_waitcnt vmcnt(" #n ")" ::: "memory")
#define PG8_WAIT_L(n) asm volatile("s_waitcnt lgkmcnt(" #n ")" ::: "memory")
#define PG8_BAR __builtin_amdgcn_s_barrier()
#define PG8_SCHED __builtin_amdgcn_sched_barrier(0)
    Unit cur, nxt; int ui = 0;
    if (!S.next(0, cur)) return;
    f32x4 acc[2][2][4][2];
#pragma unroll
    for (int a = 0; a < 2; ++a)
#pragma unroll
        for (int b = 0; b < 2; ++b)
#pragma unroll
            for (int m = 0; m < 4; ++m)
#pragma unroll
                for (int n = 0; n < 2; ++n) acc[a][b][m][n] = (f32x4){0.f, 0.f, 0.f, 0.f};
    const int sc1 = 0x7F7F7F7F;
    v8i At[4], B0[2], B1[2];
    const char* cA = cur.pA; const char* cB = cur.pB;
    PG8_STAGE(PG8_SB(0, 0), cB, voffB); PG8_STAGE(PG8_SB(0, 1), cB + hstep, voffB); PG8_STAGE(PG8_SA(0, 0), cA, voffA); PG8_STAGE(PG8_SA(0, 1), cA + hstep, voffA);
    if (wr == 1) PG8_BAR;
    PG8_WAIT_V(2); PG8_BAR;
    PG8_STAGE(PG8_SB(1, 0), cB + kstep, voffB); PG8_STAGE(PG8_SA(1, 0), cA + kstep, voffA); PG8_STAGE(PG8_SB(1, 1), cB + hstep + kstep, voffB);
    PG8_WAIT_V(6); PG8_BAR;
    for (;;) {
        const bool has_next = S.next(ui + 1, nxt);
        const char* nA = has_next ? nxt.pA : cA; const char* nB = has_next ? nxt.pB : cB;
        for (int t = 0; t < nt; t += 2) {
            const bool last = (t == nt - 2);
            const char* a1 = cA + (size_t)(t + 1) * kstep;
            const char* a2 = last ? nA : cA + (size_t)(t + 2) * kstep; const char* b2 = last ? nB : cB + (size_t)(t + 2) * kstep;
            const char* a3 = a2 + kstep; const char* b3 = b2 + kstep;
            PG8_LDB(B0, 0, 0); PG8_LDB(B1, 0, 1); PG8_SCHED; PG8_LDA(At, 0, 0); PG8_STAGE(PG8_SA(1, 1), a1 + hstep, voffA);
            PG8_WAIT_V(8); PG8_WAIT_L(0); PG8_BAR; PG8_MMA(0, 0, At, B0); PG8_MMA(0, 1, At, B1); PG8_BAR; PG8_SCHED;
            PG8_LDA(At, 0, 1); PG8_STAGE(PG8_SB(0, 0), b2, voffB); PG8_STAGE(PG8_SB(0, 1), b2 + hstep, voffB); PG8_STAGE(PG8_SA(0, 0), a2, voffA);
            PG8_WAIT_V(8); PG8_WAIT_L(0); PG8_BAR; PG8_MMA(1, 0, At, B0); PG8_MMA(1, 1, At, B1); PG8_BAR; PG8_SCHED;
            PG8_LDB(B0, 1, 0); PG8_LDB(B1, 1, 1); PG8_SCHED; PG8_LDA(At, 1, 0); PG8_STAGE(PG8_SA(0, 1), a2 + hstep, voffA);
            PG8_WAIT_V(8); PG8_WAIT_L(0); PG8_BAR; PG8_MMA(0, 0, At, B0); PG8_MMA(0, 1, At, B1); PG8_BAR; PG8_SCHED;
            PG8_LDA(At, 1, 1); PG8_STAGE(PG8_SB(1, 0), b3, voffB); PG8_STAGE(PG8_SB(1, 1), b3 + hstep, voffB); PG8_STAGE(PG8_SA(1, 0), a3, voffA);
            PG8_WAIT_V(8); PG8_WAIT_L(0); PG8_BAR; PG8_MMA(1, 0, At, B0); PG8_MMA(1, 1, At, B1); PG8_BAR; PG8_SCHED;
        }
        if (wr == 0) PG8_BAR;
        if constexpr (F8) asm volatile("s_nop 15\n\ts_nop 15" ::: "memory");
        E(acc, cur, wr, wc, fr, fq);
        if (!has_next) break;
#pragma unroll
        for (int a = 0; a < 2; ++a)
#pragma unroll
            for (int b = 0; b < 2; ++b)
#pragma unroll
                for (int m = 0; m < 4; ++m)
#pragma unroll
                    for (int n = 0; n < 2; ++n) acc[a][b][m][n] = (f32x4){0.f, 0.f, 0.f, 0.f};
        cur = nxt; cA = nA; cB = nB; ++ui;
        if (wr == 1) PG8_BAR;
    }
    PG8_WAIT_V(0);
    PG8_BAR;
#undef PG8_SA
#undef PG8_SB
#undef PG8_STAGE
#undef PG8_LDA
#undef PG8_LDB
#undef PG8_MMA
#undef PG8_WAIT_V
#undef PG8_WAIT_L
#undef PG8_BAR
#undef PG8_SCHED
}
}

#define XB_TMO      128
#define XB_XCNT(j)  (256  + 64 * (j))
#define XB_XSUB(j)  (1280 + 64 * (j))
#define XB_XGEN(j)  (2304 + 64 * (j))
#define XB_TOP      3328
#define XB_TOPGEN   3392
#define XCD_BAR_WORDS 3456
#define XB_SPIN_CAP (1u << 22)

DI unsigned xb_ld(unsigned* p)              { return __hip_atomic_load(p, __ATOMIC_RELAXED, __HIP_MEMORY_SCOPE_AGENT); }
DI unsigned xb_add(unsigned* p, unsigned v) { return __hip_atomic_fetch_add(p, v, __ATOMIC_RELAXED, __HIP_MEMORY_SCOPE_AGENT); }
DI unsigned xb_xcc_id() { return (unsigned)__builtin_amdgcn_s_getreg((3 << 11) | 20) & 0xFu; }
#define XB_SPIN(cond, bar) do { unsigned _sp = 0; while (cond) { __builtin_amdgcn_s_sleep(1); \
    if ((++_sp & 255u) == 0u) { if (xb_ld(&(bar)[XB_TMO])) break; if (_sp > XB_SPIN_CAP) { atomicAdd(&(bar)[XB_TMO], 1u); break; } } } } while (0)

struct XcdBarrier { unsigned* bar; unsigned x; volatile LAS unsigned* st; };

DI XcdBarrier xcd_barrier_post(unsigned* bar, volatile LAS unsigned* st) {
    XcdBarrier b; b.bar = bar; b.x = xb_xcc_id(); b.st = st;
    if (threadIdx.x == 0) st[2] = xb_add(&bar[XB_XCNT(b.x)], 1u);
    return b;
}
DI void xcd_barrier_complete(unsigned* bar, unsigned x, unsigned& nloc, unsigned& nx) {
    const unsigned G = gridDim.x * gridDim.y * gridDim.z;
    unsigned sum, cnt, mine, sp = 0u;
    for (;;) {
        sum = 0u; cnt = 0u; mine = 0u;
#pragma unroll
        for (unsigned j = 0; j < 16; ++j) { const unsigned c = xb_ld(&bar[XB_XCNT(j)]); sum += c; cnt += (c > 0u) ? 1u : 0u; mine = (j == x) ? c : mine; }
        if (sum == G) break;
        __builtin_amdgcn_s_sleep(1);
        if ((++sp & 255u) == 0u) { if (xb_ld(&bar[XB_TMO])) break; if (sp > XB_SPIN_CAP) { atomicAdd(&bar[XB_TMO], 1u); break; } }
    }
    nloc = mine > 0u ? mine : 1u; nx = cnt > 0u ? cnt : 1u;
}
DI void xcd_barrier(const XcdBarrier& b) {
    asm volatile("s_waitcnt vmcnt(0)" ::: "memory");
    __syncthreads();
    if (threadIdx.x == 0) {
        unsigned* bar = b.bar;
        __builtin_amdgcn_s_waitcnt(0);
        unsigned nloc = b.st[0], nx = b.st[1];
        if (nloc == 0u) { xcd_barrier_complete(bar, b.x, nloc, nx); b.st[0] = nloc; b.st[1] = nx; }
        const unsigned old = xb_add(&bar[XB_XSUB(b.x)], 1u);
        const unsigned gen = old / nloc;
        if (old + 1u == (gen + 1u) * nloc) {
            __builtin_amdgcn_fence(__ATOMIC_RELEASE, "agent");
            asm volatile("s_waitcnt vmcnt(0)" ::: "memory");
            const unsigned og = xb_add(&bar[XB_TOP], 1u);
            const unsigned tg = og / nx;
            if (og + 1u == (tg + 1u) * nx) xb_add(&bar[XB_TOPGEN], 1u);
            else XB_SPIN(xb_ld(&bar[XB_TOPGEN]) == tg, bar);
            __builtin_amdgcn_fence(__ATOMIC_ACQUIRE, "agent");
            xb_add(&bar[XB_XGEN(b.x)], 1u);
            asm volatile("s_waitcnt vmcnt(0)" ::: "memory");
        } else {
            XB_SPIN(xb_ld(&bar[XB_XGEN(b.x)]) == gen, bar);
            __builtin_amdgcn_fence(__ATOMIC_ACQUIRE, "agent");
            asm volatile("s_waitcnt vmcnt(0)" ::: "memory");
        }
    }
    __syncthreads();
}

struct Args { const float* in[24]; float* out; unsigned char* ws; int ph_lo, ph_hi, dup, pad; };
enum { I_XP = 0, I_XS, I_CBK, I_CBV, I_CMK, I_CMV, I_MEMP, I_WINA, I_SLNG, I_SLNB, I_SGUW, I_SGUB, I_WINB, I_RELB, I_WMKV, I_WOUT,
       I_LN1G, I_LN1B, I_LN2G, I_LN2B, I_PWQ, I_PKEYS, I_PU, I_PV };

DI void tr_item_load(const float* W, int N, int ldw, int item, int lane, f32x4 (&v)[16]) {
    const int nblk = N / 64, kb = item / nblk, nb = item % nblk, k0 = 64 * kb, n0 = 64 * nb;
#pragma unroll
    for (int i = 0; i < 16; ++i) v[i] = *(const f32x4*)(W + (size_t)(k0 + 4 * i + (lane >> 4)) * ldw + n0 + 4 * (lane & 15));
}
DI void tr_item_store(const f32x4 (&v)[16], int K, int N, bf16* WT, unsigned char* W8T, float scale, LAS float* scr, int item, int lane) {
    const int nblk = N / 64, kb = item / nblk, nb = item % nblk, k0 = 64 * kb, n0 = 64 * nb;
#pragma unroll
    for (int i = 0; i < 16; ++i) { LAS float* p = scr + (4 * i + (lane >> 4)) * 65 + 4 * (lane & 15); p[0] = v[i][0]; p[1] = v[i][1]; p[2] = v[i][2]; p[3] = v[i][3]; }
    LDS_WAIT(); asm volatile("" ::: "memory");
    const int c = lane >> 3, nl = lane & 7;
#pragma unroll
    for (int j = 0; j < 8; ++j) { const int n = nl + 8 * j; const LAS float* s = scr + (8 * c) * 65 + n;
        const float e0 = s[0 * 65], e1 = s[1 * 65], e2 = s[2 * 65], e3 = s[3 * 65], e4 = s[4 * 65], e5 = s[5 * 65], e6 = s[6 * 65], e7 = s[7 * 65];
        if (WT) { u32x4 o; o.x = pk2(e0, e1); o.y = pk2(e2, e3); o.z = pk2(e4, e5); o.w = pk2(e6, e7); *(u32x4*)(WT + (size_t)(n0 + n) * K + k0 + 8 * c) = o; }
        if (W8T) { u32x2 o8; o8.x = pk4_fp8(e0 * scale, e1 * scale, e2 * scale, e3 * scale); o8.y = pk4_fp8(e4 * scale, e5 * scale, e6 * scale, e7 * scale); *(u32x2*)(W8T + (size_t)(n0 + n) * K + k0 + 8 * c) = o8; } }
    LDS_WAIT(); asm volatile("" ::: "memory");
}
DI void tr_generic(const float* src, int K, int N, int ldw, int nmat, size_t sstride, bf16* dstb, unsigned char* dst8, size_t dstride, float scale, LAS float* scr, int gw, int ngw, int lane) {
    const int per = (K / 64) * (N / 64), total = per * nmat;
    f32x4 va[16], vb[16];
    int it = gw; if (it >= total) return;
#define TRG_LOAD(v, i) do { const int _mi = (i) / per; tr_item_load(src + (size_t)_mi * sstride, N, ldw, (i) - _mi * per, lane, v); } while (0)
#define TRG_STORE(v, i) do { const int _mi = (i) / per; tr_item_store(v, K, N, dstb ? dstb + (size_t)_mi * dstride : nullptr, dst8 ? dst8 + (size_t)_mi * dstride : nullptr, scale, scr, (i) - _mi * per, lane); } while (0)
    TRG_LOAD(va, it);
#pragma unroll 1
    for (; it < total; it += 2 * ngw) {
        const int i2 = it + ngw, i3 = i2 + ngw;
        if (i2 < total) TRG_LOAD(vb, i2);
        TRG_STORE(va, it);
        if (i3 < total) TRG_LOAD(va, i3);
        if (i2 < total) TRG_STORE(vb, i2);
    }
#undef TRG_LOAD
#undef TRG_STORE
}
DI void tr_job_both(const float* src, bf16* dst, unsigned char* dst8, int K, int N, int ldw, float scale, LAS float* scr, int gw, int ngw, int lane) { tr_generic(src, K, N, ldw, 1, 0, dst, dst8, 0, scale, scr, gw, ngw, lane); }
DI void tr_job8(const float* src, unsigned char* dst, int K, int N, int ldw, float scale, LAS float* scr, int gw, int ngw, int lane) { tr_generic(src, K, N, ldw, 1, 0, nullptr, dst, 0, scale, scr, gw, ngw, lane); }
DI void tr_job(const float* src, bf16* dst, int K, int N, int nmat, size_t sstride, size_t dstride, LAS float* scr, int gw, int ngw, int lane) { tr_generic(src, K, N, N, nmat, sstride, dst, nullptr, dstride, 1.f, scr, gw, ngw, lane); }
DI void tr_job_ld(const float* src, bf16* dst, int K, int N, int ldw, LAS float* scr, int gw, int ngw, int lane) { tr_generic(src, K, N, ldw, 1, 0, dst, nullptr, 0, 1.f, scr, gw, ngw, lane); }
DI void cvt_job(const float* src, bf16* dst, size_t n, size_t gtid, size_t nthr, unsigned char* dst8 = nullptr, float scale8 = 1.f) {
    const size_t n8 = n / 8;
    for (size_t i0 = gtid; i0 < n8; i0 += 4 * nthr) {
        f32x4 a[4], b[4];
#pragma unroll
        for (int u = 0; u < 4; ++u) { const size_t i = i0 + u * nthr; if (i < n8) { a[u] = ((const f32x4*)src)[2 * i]; b[u] = ((const f32x4*)src)[2 * i + 1]; } }
#pragma unroll
        for (int u = 0; u < 4; ++u) { const size_t i = i0 + u * nthr; if (i < n8) { u32x4 o; o.x = pk2(a[u][0], a[u][1]); o.y = pk2(a[u][2], a[u][3]); o.z = pk2(b[u][0], b[u][1]); o.w = pk2(b[u][2], b[u][3]); ((u32x4*)dst)[i] = o;
            if (dst8) { u32x2 o8; o8.x = pk4_fp8(a[u][0] * scale8, a[u][1] * scale8, a[u][2] * scale8, a[u][3] * scale8); o8.y = pk4_fp8(b[u][0] * scale8, b[u][1] * scale8, b[u][2] * scale8, b[u][3] * scale8); ((u32x2*)dst8)[i] = o8; } } }
    }
}
DI void fp4_row_load(const float* src, int r, int lane, f32x4 (&v)[8][2]) {
    const f32x4* sp = (const f32x4*)(src + (size_t)r * D);
#pragma unroll
    for (int j = 0; j < 8; ++j)
#pragma unroll
        for (int hh = 0; hh < 2; ++hh) v[j][hh] = sp[(j * 64 + lane) * 2 + hh];
}
DI void fp4_row_store(const f32x4 (&v)[8][2], unsigned* dst, float* sc, int r, int lane) {
    float am = 0.f;
#pragma unroll
    for (int j = 0; j < 8; ++j)
#pragma unroll
        for (int hh = 0; hh < 2; ++hh) am = fmaxf(am, fmaxf(fmaxf(fabsf(v[j][hh][0]), fabsf(v[j][hh][1])), fmaxf(fabsf(v[j][hh][2]), fabsf(v[j][hh][3]))));
#pragma unroll
    for (int o = 1; o < 64; o <<= 1) am = fmaxf(am, __shfl_xor(am, o));
    const float mul = am > 0.f ? 6.0f / am : 1.0f;
#pragma unroll
    for (int j = 0; j < 8; ++j) { unsigned w = 0u;
        w = __builtin_amdgcn_cvt_scalef32_pk_fp4_f32(w, v[j][0][0] * mul, v[j][0][1] * mul, 1.0f, 0); w = __builtin_amdgcn_cvt_scalef32_pk_fp4_f32(w, v[j][0][2] * mul, v[j][0][3] * mul, 1.0f, 1);
        w = __builtin_amdgcn_cvt_scalef32_pk_fp4_f32(w, v[j][1][0] * mul, v[j][1][1] * mul, 1.0f, 2); w = __builtin_amdgcn_cvt_scalef32_pk_fp4_f32(w, v[j][1][2] * mul, v[j][1][3] * mul, 1.0f, 3);
        dst[(size_t)(2 * j + (lane >> 5)) * (NEXP * 32) + (size_t)r * 32 + (lane & 31)] = w; }
    if (lane == 0) sc[r] = am > 0.f ? am * (1.0f / 6.0f) : 1.0f;
}
DI void fp4_rows_job(const float* src, unsigned* dst, float* sc, int r0, int nrows, int gw, int ngw, int lane) {
    f32x4 va[8][2], vb[8][2];
    int r = r0 + gw; if (r >= nrows) return;
    fp4_row_load(src, r, lane, va);
#pragma unroll 1
    for (; r < nrows; r += 2 * ngw) {
        const int r2 = r + ngw, r3 = r2 + ngw;
        if (r2 < nrows) fp4_row_load(src, r2, lane, vb);
        fp4_row_store(va, dst, sc, r, lane);
        if (r3 < nrows) fp4_row_load(src, r3, lane, va);
        if (r2 < nrows) fp4_row_store(vb, dst, sc, r2, lane);
    }
}

enum { K_U = 0, K_QM, K_VT0, K_MEMKV, K_MEMVT, K_OUT, K_WQ, K_Q, K_KK, K_VT1 };
DI void st_bf16x8(bf16* p, f32x4 v0, f32x4 v1) { u32x4 w; w.x = pk2(v0[0], v0[1]); w.y = pk2(v0[2], v0[3]); w.z = pk2(v1[0], v1[1]); w.w = pk2(v1[2], v1[3]); *(u32x4*)p = w; }


DI pg8::Job mkjob(const void* A, const void* Bt, int nM, int nN, int kind, int aux, int pm0, int pn0) { pg8::Job j{(const bf16*)A, (const bf16*)Bt, nM, nN, kind, aux}; j.pm0 = pm0; j.pn0 = pn0; return j; }
struct JobsA { static constexpr int NJ = 5; const bf16 *XB, *Wa, *MEMB, *Wmkv;
    DI pg8::Job job(int k) const {
        switch (k) {
            case 0: return mkjob(Wa + (size_t)3072 * KDIM, XB + (size_t)32 * 256 * KDIM, 12, 2, K_VT0, 0, 0, 32);
            case 1: return pg8::Job{MEMB, Wmkv, 2, 8, K_MEMKV, 0};
            case 2: return pg8::Job{MEMB, Wmkv + (size_t)2048 * KDIM, 2, 8, K_MEMKV, 1};
            case 3: return pg8::Job{Wmkv + (size_t)1024 * KDIM, MEMB, 4, 2, K_MEMVT, 0};
            default: return pg8::Job{Wmkv + (size_t)(2048 + 1024) * KDIM, MEMB, 4, 2, K_MEMVT, 1};
        } } };
struct JobsA8 { static constexpr int NJ = 3; const unsigned char *X8, *W8;
    DI pg8::Job job(int k) const {
        if (k == 0) return mkjob(X8, W8, 34, 12, K_U, 0, 0, 0);
        if (k == 1) return mkjob(W8 + (size_t)4096 * KDIM, X8, 12, 32, K_VT0, 1, 0, 0);
        return mkjob(X8, W8 + (size_t)3072 * KDIM, 34, 4, K_QM, 0, 0, 0); } };
struct JobsB { static constexpr int NJ = 6; const bf16 *XB, *Wb;
    DI pg8::Job job(int k) const {
        const int p0 = (k % 3 == 0) ? 14 : (k % 3 == 1 ? 30 : 32);
        if (k < 3) return mkjob(XB + (size_t)p0 * 256 * KDIM, Wb + (size_t)3072 * KDIM, 2, 12, K_KK, 0, p0, 0);
        return mkjob(Wb + (size_t)6144 * KDIM, XB + (size_t)p0 * 256 * KDIM, 12, 2, K_VT1, 0, 0, p0); } };
struct JobsB8 { static constexpr int NJ = 6; const unsigned char *X8, *W8;
    DI pg8::Job job(int k) const {
        switch (k) {
            case 0: return mkjob(X8, W8, 34, 12, K_Q, 0, 0, 0);
            case 1: return mkjob(X8, W8 + (size_t)4096 * KDIM, 14, 12, K_KK, 1, 0, 0);
            case 2: return mkjob(X8 + (size_t)16 * 256 * KDIM, W8 + (size_t)4096 * KDIM, 14, 12, K_KK, 1, 16, 0);
            case 3: return mkjob(W8 + (size_t)7168 * KDIM, X8, 12, 14, K_VT1, 1, 0, 0);
            case 4: return mkjob(W8 + (size_t)7168 * KDIM, X8 + (size_t)16 * 256 * KDIM, 12, 14, K_VT1, 1, 0, 16);
            default: return mkjob(X8, W8 + (size_t)3072 * KDIM, 34, 4, K_QM, 0, 0, 0);
        } } };
struct Jobs1 { static constexpr int NJ = 1; const bf16 *A, *Bt; int nN, kind;
    DI pg8::Job job(int) const { return pg8::Job{A, Bt, 34, nN, kind, 0}; } };

struct EpiA {
    bf16* U; bf16* QM; bf16* VT; float* vst; float* out; bf16* MKB; bf16* MVT;
    DI void operator()(const f32x4 (&acc)[2][2][4][2], const pg8::Unit& u, int wr, int wc, int fr, int fq) const {
        const int row0 = u.pm * 256 + wr * 64 + fr, col0 = u.pn * 256 + wc * 32 + 8 * fq;
        if (u.kind == K_U) {
#pragma unroll
            for (int ai = 0; ai < 2; ++ai)
#pragma unroll
                for (int m = 0; m < 4; ++m) { bf16* rowp = U + (size_t)(row0 + ai * 128 + m * 16) * TOK + col0;
#pragma unroll
                    for (int bj = 0; bj < 2; ++bj) { f32x4 v0 = acc[ai][bj][m][0], v1 = acc[ai][bj][m][1];
#pragma unroll
                        for (int i = 0; i < 4; ++i) { v0[i] = gelu_tanh(v0[i] * (1.0f / (XB_SCALE * WIN_SCALE))); v1[i] = gelu_tanh(v1[i] * (1.0f / (XB_SCALE * WIN_SCALE))); }
                        st_bf16x8(rowp + bj * 128, v0, v1); } }
        } else if (u.kind == K_QM) {
#pragma unroll
            for (int ai = 0; ai < 2; ++ai)
#pragma unroll
                for (int m = 0; m < 4; ++m) { bf16* rowp = QM + (size_t)(row0 + ai * 128 + m * 16) * MEMW + col0;
#pragma unroll
                    for (int bj = 0; bj < 2; ++bj) st_bf16x8(rowp + bj * 128, acc[ai][bj][m][0] * (0.0625f * (1.0f / (XB_SCALE * WIN_SCALE))), acc[ai][bj][m][1] * (0.0625f * (1.0f / (XB_SCALE * WIN_SCALE)))); }
        } else if (u.kind == K_VT0) {
            const int slot = u.pm * 2 + wr;
            const float ds = u.aux ? (1.0f / (XB_SCALE * WIN_SCALE)) : 1.0f;
#pragma unroll
            for (int bj = 0; bj < 2; ++bj)
#pragma unroll
                for (int n = 0; n < 2; ++n) {
                    float cs[4], cq[4];
#pragma unroll
                    for (int i = 0; i < 4; ++i) { cs[i] = 0.f; cq[i] = 0.f; }
#pragma unroll
                    for (int ai = 0; ai < 2; ++ai)
#pragma unroll
                        for (int m = 0; m < 4; ++m) { bf16* rowp = VT + (unsigned)((row0 + ai * 128 + m * 16) * M + col0 + bj * 128 + 4 * n);
                            f32x4 v0 = acc[ai][bj][m][n];
#pragma unroll
                            for (int i = 0; i < 4; ++i) { v0[i] = gelu_tanh(v0[i] * ds); cs[i] += v0[i]; cq[i] += v0[i] * v0[i]; }
                            u32x2 w; w.x = pk2(v0[0], v0[1]); w.y = pk2(v0[2], v0[3]); *(u32x2*)rowp = w; }
                    float ms = 0.f, mq = 0.f;
#pragma unroll
                    for (int i = 0; i < 4; ++i) { const float s = row16_sum(cs[i]), q = row16_sum(cq[i]); if (fr == i) { ms = s; mq = q; } }
                    if (fr < 4) { const int tokc = u.pn * 256 + bj * 128 + wc * 32 + 8 * fq + 4 * n + fr; *(f32x2*)(vst + ((size_t)slot * M + tokc) * 2) = (f32x2){ms, mq}; }
                    asm volatile("" ::: "memory");
                }
        } else if (u.kind == K_MEMKV) {
            const int li = u.aux; const bool isk = u.pn < 4;
            float* ob = out + (isk ? O_MKP : O_MVP) + (size_t)li * 512 * 1024; const int cc = col0 - (isk ? 0 : 1024);
#pragma unroll
            for (int ai = 0; ai < 2; ++ai)
#pragma unroll
                for (int m = 0; m < 4; ++m) { const int row = row0 + ai * 128 + m * 16;
#pragma unroll
                    for (int bj = 0; bj < 2; ++bj) { float* p = ob + (size_t)row * 1024 + cc + bj * 128;
                        *(f32x4*)p = acc[ai][bj][m][0]; *(f32x4*)(p + 4) = acc[ai][bj][m][1];
                        if (isk) st_bf16x8(MKB + ((size_t)li * 512 + row) * 1024 + cc + bj * 128, acc[ai][bj][m][0], acc[ai][bj][m][1]); } }
        } else {
            const int li = u.aux;
#pragma unroll
            for (int ai = 0; ai < 2; ++ai)
#pragma unroll
                for (int m = 0; m < 4; ++m) { bf16* rowp = MVT + ((size_t)li * 1024 + row0 + ai * 128 + m * 16) * 512 + col0;
#pragma unroll
                    for (int bj = 0; bj < 2; ++bj) st_bf16x8(rowp + bj * 128, acc[ai][bj][m][0], acc[ai][bj][m][1]); }
        }
    }
};

template <bool XBF> struct EpiOut {
    const void* xp; const void* xs; bf16* Z;
    DI void operator()(const f32x4 (&acc)[2][2][4][2], const pg8::Unit& u, int wr, int wc, int fr, int fq) const {
        const int row0 = u.pm * 256 + wr * 64 + fr, col0 = u.pn * 256 + wc * 32 + 8 * fq;
#pragma unroll
        for (int ai = 0; ai < 2; ++ai)
#pragma unroll
            for (int m = 0; m < 4; ++m) { const size_t off = (size_t)(row0 + ai * 128 + m * 16) * D + col0;
#pragma unroll
                for (int bj = 0; bj < 2; ++bj) { f32x4 x0, x1;
                    if (XBF) { const bf16* xb = (u.pm < 32) ? (const bf16*)xp : ((const bf16*)xs - (size_t)MP * D); const u32x4 r = *(const u32x4*)(xb + off + bj * 128);
                        x0 = (f32x4){bflo(r.x), bfhi(r.x), bflo(r.y), bfhi(r.y)}; x1 = (f32x4){bflo(r.z), bfhi(r.z), bflo(r.w), bfhi(r.w)}; }
                    else { const float* xb = (u.pm < 32) ? (const float*)xp : ((const float*)xs - (size_t)MP * D); x0 = *(const f32x4*)(xb + off + bj * 128); x1 = *(const f32x4*)(xb + off + bj * 128 + 4); }
                    st_bf16x8(Z + off + bj * 128, x0 * ALPHA + acc[ai][bj][m][0] * (1.0f / (CAT_SCALE * WOUT_SCALE)), x1 * ALPHA + acc[ai][bj][m][1] * (1.0f / (CAT_SCALE * WOUT_SCALE))); } }
    }
};
struct EpiWq {
    bf16* PQ;
    DI void operator()(const f32x4 (&acc)[2][2][4][2], const pg8::Unit& u, int wr, int wc, int fr, int fq) const {
        const int row0 = u.pm * 256 + wr * 64 + fr, col0 = u.pn * 256 + wc * 32 + 8 * fq;
#pragma unroll
        for (int ai = 0; ai < 2; ++ai)
#pragma unroll
            for (int m = 0; m < 4; ++m) { bf16* rowp = PQ + (size_t)(row0 + ai * 128 + m * 16) * 2048 + col0;
#pragma unroll
                for (int bj = 0; bj < 2; ++bj) st_bf16x8(rowp + bj * 128, acc[ai][bj][m][0], acc[ai][bj][m][1]); }
    }
};
template <bool F8P> struct EpiB {
    bf16* Q; bf16* Kb; bf16* QM; bf16* VT; float* out;
    DI void operator()(const f32x4 (&acc)[2][2][4][2], const pg8::Unit& u, int wr, int wc, int fr, int fq) const {
        const int row0 = u.pm * 256 + wr * 64 + fr, col0 = u.pn * 256 + wc * 32 + 8 * fq;
        constexpr float ds = F8P ? (1.0f / (XB_SCALE * WIN_SCALE)) : 1.0f;
        if (F8P && (u.kind == K_Q || u.kind == K_QM)) {
            const bool isq = u.kind == K_Q; bf16* base = isq ? Q : QM; const int ld = isq ? TOK : MEMW;
            const float sc = (isq ? 0.08838834764831845f : 0.0625f) * ds;
#pragma unroll
            for (int ai = 0; ai < 2; ++ai)
#pragma unroll
                for (int m = 0; m < 4; ++m) { bf16* rowp = base + (size_t)(row0 + ai * 128 + m * 16) * ld + col0;
#pragma unroll
                    for (int bj = 0; bj < 2; ++bj) st_bf16x8(rowp + bj * 128, acc[ai][bj][m][0] * sc, acc[ai][bj][m][1] * sc); }
        } else if (u.kind == K_KK) {
            float* fo = nullptr;
            if (!F8P) { if (u.pm >= 32) fo = out + O_BKS + (size_t)(u.pm - 32) * 256 * TOK; else fo = out + O_BKP + ((size_t)(u.pm >> 4) * 512 + ((u.pm & 15) - 14) * 256) * TOK; }
#pragma unroll
            for (int ai = 0; ai < 2; ++ai)
#pragma unroll
                for (int m = 0; m < 4; ++m) { const int rl = wr * 64 + fr + ai * 128 + m * 16; bf16* rowp = Kb + (size_t)(u.pm * 256 + rl) * TOK + col0;
#pragma unroll
                    for (int bj = 0; bj < 2; ++bj) { st_bf16x8(rowp + bj * 128, acc[ai][bj][m][0] * ds, acc[ai][bj][m][1] * ds);
                        if (!F8P) { float* p = fo + (size_t)rl * TOK + col0 + bj * 128; *(f32x4*)p = acc[ai][bj][m][0]; *(f32x4*)(p + 4) = acc[ai][bj][m][1]; } } }
        } else {
            float* fo = nullptr;
            if (!F8P) { if (u.pn >= 32) fo = out + O_BVS + (size_t)(u.pn - 32) * 256 * TOK; else fo = out + O_BVP + ((size_t)(u.pn >> 4) * 512 + ((u.pn & 15) - 14) * 256) * TOK; }
#pragma unroll
            for (int ai = 0; ai < 2; ++ai)
#pragma unroll
                for (int m = 0; m < 4; ++m) { const int ch = row0 + ai * 128 + m * 16; bf16* rowp = VT + (size_t)ch * M + col0;
#pragma unroll
                    for (int bj = 0; bj < 2; ++bj) { st_bf16x8(rowp + bj * 128, acc[ai][bj][m][0] * ds, acc[ai][bj][m][1] * ds);
                        if (!F8P) { float* p = fo + (size_t)(wc * 32 + 8 * fq + bj * 128) * TOK + ch;
#pragma unroll
                            for (int i = 0; i < 4; ++i) { p[(size_t)i * TOK] = acc[ai][bj][m][0][i]; p[(size_t)(4 + i) * TOK] = acc[ai][bj][m][1][i]; } } } }
        }
    }
};

template <int DH> struct AttnState {
    bf16x8 qf[DH / 32]; f32x4 o[DH / 16]; float m, l;
    DI void init(const bf16* qrow, int fq) {
#pragma unroll
        for (int ks = 0; ks < DH / 32; ++ks) qf[ks] = *(const bf16x8*)(qrow + ks * 32 + fq * 8);
#pragma unroll
        for (int db = 0; db < DH / 16; ++db) o[db] = (f32x4){0.f, 0.f, 0.f, 0.f};
        m = -1e30f; l = 0.f;
    }
    template <bool BIAS> DI void tile(const bf16* Kb, int kstride, const bf16* VTb, int vstride, int nblk, const float* rb, int dpos, int fr, int fq) {
        f32x4 s[4];
#pragma unroll
        for (int nb = 0; nb < 4; ++nb) { s[nb] = (f32x4){0.f, 0.f, 0.f, 0.f};
            if (nb < nblk) {
#pragma unroll
                for (int ks = 0; ks < DH / 32; ++ks) { const bf16x8 kf = *(const bf16x8*)(Kb + (size_t)(nb * 16 + fr) * kstride + ks * 32 + fq * 8);
                    s[nb] = __builtin_amdgcn_mfma_f32_16x16x32_bf16(kf, qf[ks], s[nb], 0, 0, 0); }
                if (BIAS) {
#pragma unroll
                    for (int j = 0; j < 4; ++j) { int rel = dpos - (nb * 16 + 4 * fq + j); rel = rel < -128 ? -128 : (rel > 128 ? 128 : rel); s[nb][j] += rb[rel + 128]; }
                }
            } else s[nb] = (f32x4){-1e30f, -1e30f, -1e30f, -1e30f};
        }
        float mx = -1e30f;
#pragma unroll
        for (int nb = 0; nb < 4; ++nb)
#pragma unroll
            for (int j = 0; j < 4; ++j) mx = fmaxf(mx, s[nb][j]);
        mx = fmaxf(mx, __shfl_xor(mx, 16)); mx = fmaxf(mx, __shfl_xor(mx, 32));
        const float mn = fmaxf(m, mx), alpha = __expf(m - mn); m = mn;
        float ps = 0.f;
#pragma unroll
        for (int nb = 0; nb < 4; ++nb)
#pragma unroll
            for (int j = 0; j < 4; ++j) { const float p = __expf(s[nb][j] - mn); s[nb][j] = p; ps += p; }
        l = l * alpha + ps;
#pragma unroll
        for (int db = 0; db < DH / 16; ++db) o[db] = o[db] * alpha;
#pragma unroll
        for (int kk = 0; kk < 2; ++kk) if (2 * kk < nblk) {
            u32x4 pw; pw.x = pk2(s[2 * kk][0], s[2 * kk][1]); pw.y = pk2(s[2 * kk][2], s[2 * kk][3]); pw.z = pk2(s[2 * kk + 1][0], s[2 * kk + 1][1]); pw.w = pk2(s[2 * kk + 1][2], s[2 * kk + 1][3]);
            const bf16x8 pf = __builtin_bit_cast(bf16x8, pw);
#pragma unroll
            for (int db = 0; db < DH / 16; ++db) { const bf16* vp = VTb + (size_t)(db * 16 + fr) * vstride + kk * 32 + 4 * fq;
                const u32x2 lo = *(const u32x2*)vp, hi = *(const u32x2*)(vp + 16); u32x4 vw; vw.x = lo.x; vw.y = lo.y; vw.z = hi.x; vw.w = hi.y;
                o[db] = __builtin_amdgcn_mfma_f32_16x16x32_bf16(__builtin_bit_cast(bf16x8, vw), pf, o[db], 0, 0, 0); }
        }
    }
    DI void finish(bf16* orow, int fq) {
        float lt = l; lt += __shfl_xor(lt, 16); lt += __shfl_xor(lt, 32);
        const float inv = 1.0f / lt;
#pragma unroll
        for (int db = 0; db < DH / 16; ++db) { u32x2 w; w.x = pk2(o[db][0] * inv, o[db][1] * inv); w.y = pk2(o[db][2] * inv, o[db][3] * inv); *(u32x2*)(orow + db * 16 + 4 * fq) = w; }
    }
};

template <int DH> struct AttnWG {
    static constexpr int VT0 = (DH / 64) * 8192, STAGE = VT0 + (DH / 128) * 16384, NDMA = DH / 64 + DH / 64;
    bf16x8 qf[DH / 32]; f32x4 o[DH / 16]; float m, l;
    DI void init(const bf16* qrow, int fq) {
#pragma unroll
        for (int ks = 0; ks < DH / 32; ++ks) qf[ks] = *(const bf16x8*)(qrow + ks * 32 + fq * 8);
#pragma unroll
        for (int db = 0; db < DH / 16; ++db) o[db] = (f32x4){0.f, 0.f, 0.f, 0.f};
        m = -1e30f; l = 0.f;
#pragma unroll
        for (int ks = 0; ks < DH / 32; ++ks) asm volatile("" : "+v"(qf[ks]));
    }
    static DI int kperm(int R) { return (R & 0x23) | ((R & 0x0C) << 1) | ((R & 0x10) >> 2); }
    static DI void dma16(const void* g, LAS unsigned char* l) {
        const unsigned la = __builtin_amdgcn_readfirstlane((unsigned)(unsigned long)l);
        asm volatile("s_mov_b32 m0, %0\n\ts_nop 0\n\tglobal_load_lds_dwordx4 %1, off" :: "s"(la), "v"(g) : "memory", "m0");
    }
    static DI void stage(LAS unsigned char* st, const bf16* kg, int kstride, const bf16* vg, int vstride, int sR, int sC, int wave) {
#pragma unroll
        for (int dh = 0; dh < DH / 64; ++dh) dma16(kg + (size_t)kperm(sR) * kstride + dh * 64 + sC, st + dh * 8192 + wave * 1024);
#pragma unroll
        for (int vb = 0; vb < DH / 128; ++vb)
#pragma unroll
            for (int hf = 0; hf < 2; ++hf) dma16(vg + (size_t)(vb * 128 + hf * 64 + sR) * vstride + sC, st + VT0 + vb * 16384 + hf * 8192 + wave * 1024);
    }
    template <bool BIAS> DI void tile(const LAS unsigned char* st, int nblk, const LAS float* rb, int dpos, int fr, int fq) {
        const int koff = (fr * 64 + fq * 16) ^ ((fr >> 3) << 5);
        const bool far = BIAS && (__builtin_amdgcn_readfirstlane(dpos - fr) - 63 >= 128); float bfar = 0.f; if (BIAS) bfar = rb[0];
        f32x4 s[4];
#pragma unroll
        for (int nb = 0; nb < 4; ++nb) { s[nb] = (f32x4){0.f, 0.f, 0.f, 0.f};
            if (nb < nblk) {
#pragma unroll
                for (int ks = 0; ks < DH / 32; ++ks) { const bf16x8 kf = *(const LAS bf16x8*)(st + (ks >> 1) * 8192 + (nb * 2 + (ks & 1)) * 1024 + koff);
                    s[nb] = __builtin_amdgcn_mfma_f32_16x16x32_bf16(kf, qf[ks], s[nb], 0, 0, 0); }
                if (DH > 128) __builtin_amdgcn_sched_barrier(0);
                if (BIAS) {
                    if (far) { s[nb] = s[nb] + bfar; }
                    else { const LAS float* bp = rb + (640 - dpos) + 8 * fq + (nb >> 1) * 32 + (nb & 1) * 4;
#pragma unroll
                        for (int j = 0; j < 4; ++j) s[nb][j] += bp[j]; }
                }
            } else s[nb] = (f32x4){-1e30f, -1e30f, -1e30f, -1e30f};
        }
        float mx = -1e30f;
#pragma unroll
        for (int nb = 0; nb < 4; ++nb)
#pragma unroll
            for (int j = 0; j < 4; ++j) mx = fmaxf(mx, s[nb][j]);
        mx = fmaxf(mx, __shfl_xor(mx, 16)); mx = fmaxf(mx, __shfl_xor(mx, 32));
        const float mn = fmaxf(m, mx), alpha = __expf(m - mn); m = mn;
        float ps = 0.f;
#pragma unroll
        for (int nb = 0; nb < 4; ++nb)
#pragma unroll
            for (int j = 0; j < 4; ++j) { const float p = __expf(s[nb][j] - mn); s[nb][j] = p; ps += p; }
        l = l * alpha + ps;
#pragma unroll
        for (int db = 0; db < DH / 16; ++db) o[db] = o[db] * alpha;
#pragma unroll
        for (int kk = 0; kk < 2; ++kk) if (2 * kk < nblk) {
            u32x4 pw; pw.x = pk2(s[2 * kk][0], s[2 * kk][1]); pw.y = pk2(s[2 * kk][2], s[2 * kk][3]); pw.z = pk2(s[2 * kk + 1][0], s[2 * kk + 1][1]); pw.w = pk2(s[2 * kk + 1][2], s[2 * kk + 1][3]);
            const bf16x8 pf = __builtin_bit_cast(bf16x8, pw);
#pragma unroll
            for (int db = 0; db < DH / 16; ++db) { const bf16x8 vf = *(const LAS bf16x8*)(st + VT0 + (db >> 3) * 16384 + ((db & 7) * 2 + kk) * 1024 + koff);
                o[db] = __builtin_amdgcn_mfma_f32_16x16x32_bf16(vf, pf, o[db], 0, 0, 0);
                if (DH > 128 && (db & 3) == 3) __builtin_amdgcn_sched_barrier(0); }
        }
    }
    DI void finish(unsigned char* orow, int fq) {
        float lt = l; lt += __shfl_xor(lt, 16); lt += __shfl_xor(lt, 32);
        const float inv = CAT_SCALE / lt;
#pragma unroll
        for (int db = 0; db < DH / 16; ++db) *(unsigned*)(orow + db * 16 + 4 * fq) = pk4_fp8(o[db][0] * inv, o[db][1] * inv, o[db][2] * inv, o[db][3] * inv);
    }
};
#define AW_WAIT(n) asm volatile("s_waitcnt vmcnt(" #n ")" ::: "memory")
#define AW_BAR() do { asm volatile("s_waitcnt lgkmcnt(0)" ::: "memory"); __builtin_amdgcn_s_barrier(); asm volatile("" ::: "memory"); } while (0)
DI void mem_wg(int task, int li, const bf16* QMp, const bf16* MKBp, const bf16* MVTp, const bf16* CMKp, const bf16* CMVTp, unsigned char* CATp, LAS unsigned char* lds, int tid, int wave, int lane) {
    typedef AttnWG<256> A;
    asm volatile("" : "+v"(tid), "+v"(lane));
    const int fr = lane & 15, fq = lane >> 4; int sR, sC; pg8::stage_rc(tid * 16, sR, sC);
    const bf16* kg; const bf16* vg; int vstride, m0; bool active;
    if (task < 256) { const int hm = task & 3, rb = task >> 2, b = rb >> 5; kg = MKBp + ((size_t)li * 512 + b * 256) * 1024 + hm * 256; vg = MVTp + ((size_t)li * 1024 + hm * 256) * 512 + b * 256; vstride = 512; m0 = rb * 128 + wave * 16; active = true; }
    else { const int t2 = task - 256, hm = t2 & 3, sb = t2 >> 2; kg = CMKp + ((size_t)(li * 16 + sb) * 256) * 1024 + hm * 256; vg = CMVTp + ((size_t)(li * 16 + sb) * 1024 + hm * 256) * 256; vstride = 256; m0 = MP + sb * 32 + (wave & 1) * 16; active = wave < 2; }
    const int hm = (task < 256 ? task : task - 256) & 3;
    A st; st.init(QMp + (size_t)(m0 + fr) * MEMW + hm * 256, fq);
    AW_WAIT(0);
    A::stage(lds, kg, 1024, vg, vstride, sR, sC, wave);
    for (int t = 0; t < 4; ++t) {
        if (t < 3) { A::stage(lds + ((t + 1) & 1) * A::STAGE, kg + (size_t)(t + 1) * 64 * 1024, 1024, vg + (t + 1) * 64, vstride, sR, sC, wave); AW_WAIT(8); } else AW_WAIT(0);
        AW_BAR();
        if (active) st.tile<false>(lds + (t & 1) * A::STAGE, 4, nullptr, 0, fr, fq);
        AW_BAR();
    }
    if (active) st.finish(CATp + (size_t)(m0 + fr) * D + TOK + hm * 256, fq);
}
DI void band_wg(int task, const bf16* Qb, const bf16* Kb, const bf16* VT, const bf16* CKp, const bf16* CVTp, const float* relb, unsigned char* CATp, LAS unsigned char* lds, int tid, int wave, int lane) {
    typedef AttnWG<128> A;
    asm volatile("" : "+v"(tid), "+v"(lane));
    const int fr = lane & 15, fq = lane >> 4, grp = wave >> 2; int sR, sC; pg8::stage_rc(tid * 16, sR, sC);
    LAS float* biasl = (LAS float*)(lds + 3 * A::STAGE);
    const bool prompt = task < 1536;
    int h, b, c0 = 0, m0, qpos, jfirst, jlast; bool active;
    if (prompt) { const int cp = task & 31, bh = task >> 5; h = bh % 24; b = bh / 24; c0 = 2 * cp; const int c = c0 + grp; m0 = b * 4096 + c * 64 + (wave & 3) * 16; qpos = c * 64 + (wave & 3) * 16 + fr; jfirst = c0 < 8 ? 8 - c0 : 0; jlast = 9; active = true; }
    else { const int t2 = task - 1536; h = t2 % 24; b = t2 / 24; m0 = MP + b * 32 + (wave & 1) * 16; qpos = 1024 + (wave & 1) * 16 + fr; jfirst = 0; jlast = 8; active = wave < 2; }
    AW_BAR();
    for (int i = tid; i < 704; i += NWAVES * 64) { int rel = 640 - i; rel = rel < -128 ? -128 : (rel > 128 ? 128 : rel); biasl[i] = relb[h * 257 + rel + 128]; }
    A st; st.init(Qb + (size_t)(m0 + fr) * TOK + h * 128, fq);
    AW_WAIT(0);
#define BAND_SRC(j, kp, vp, vs) do { if (prompt) { const int kt = b * 4096 + (c0 - 8 + (j)) * 64; kp = Kb + (size_t)kt * TOK + h * 128; vp = VT + (size_t)(h * 128) * M + kt; vs = M; } \
        else if ((j) < 8) { kp = CKp + ((size_t)(b * 512 + (j) * 64)) * TOK + h * 128; vp = CVTp + ((size_t)b * TOK + h * 128) * 512 + (j) * 64; vs = 512; } \
        else { kp = Kb + (size_t)(MP + b * 32) * TOK + h * 128; vp = VT + (size_t)(h * 128) * M + MP + b * 32; vs = M; } } while (0)
#define BAND_STAGE(j) do { const bf16* kp; const bf16* vp; int vs; BAND_SRC((j), kp, vp, vs); A::stage(lds + (((j) - jfirst) % 3) * A::STAGE, kp, TOK, vp, vs, sR, sC, wave); } while (0)
    BAND_STAGE(jfirst);
    if (jfirst + 1 <= jlast) BAND_STAGE(jfirst + 1);
    for (int j = jfirst; j <= jlast; ++j) {
        if (j < jlast) AW_WAIT(4); else AW_WAIT(0);
        AW_BAR();
        if (j + 2 <= jlast) BAND_STAGE(j + 2);
        const bool part = active && (prompt ? (grp == 0 ? j <= 8 : j >= 1) : true);
        if (part) { const int kp0 = prompt ? (c0 - 8 + j) * 64 : (j < 8 ? 512 + 64 * j : 1024); st.tile<true>(lds + ((j - jfirst) % 3) * A::STAGE, (!prompt && j == 8) ? 2 : 4, biasl, qpos - kp0, fr, fq); }
    }
#undef BAND_STAGE
#undef BAND_SRC
    if (active) st.finish(CATp + (size_t)(m0 + fr) * D + h * 128, fq);
}

struct AttnWG2 {
    static constexpr int VT0 = 16384, STAGE = 32768;
    bf16x8 qf[2][4]; f32x4 o[2][8]; float m[2], l[2];
    DI void init(const bf16* qrow0, const bf16* qrow1, int fq) {
#pragma unroll
        for (int ks = 0; ks < 4; ++ks) { qf[0][ks] = *(const bf16x8*)(qrow0 + ks * 32 + fq * 8); qf[1][ks] = *(const bf16x8*)(qrow1 + ks * 32 + fq * 8); }
#pragma unroll
        for (int g = 0; g < 2; ++g) {
#pragma unroll
            for (int db = 0; db < 8; ++db) o[g][db] = (f32x4){0.f, 0.f, 0.f, 0.f};
            m[g] = -1e30f; l[g] = 0.f; }
#pragma unroll
        for (int ks = 0; ks < 4; ++ks) { asm volatile("" : "+v"(qf[0][ks])); asm volatile("" : "+v"(qf[1][ks])); }
    }
    DI void tile(const LAS unsigned char* st, const LAS float* rb, int dpos0, int fr, int fq) {
        int koff = (fr * 64 + fq * 16) ^ ((fr >> 3) << 5);
        asm volatile("" : "+v"(dpos0), "+v"(koff));
        const int dbase = __builtin_amdgcn_readfirstlane(dpos0 - fr); const float bfar = rb[0];
        const LAS unsigned char* kb = st + koff; const LAS unsigned char* vb = st + VT0 + koff;
        f32x4 s[2][4]; bf16x8 kf[2][4];
#pragma unroll
        for (int ks = 0; ks < 4; ++ks) kf[0][ks] = *(const LAS bf16x8*)(kb + (ks >> 1) * 8192 + (ks & 1) * 1024);
        __builtin_amdgcn_sched_barrier(0);
#pragma unroll
        for (int nb = 0; nb < 4; ++nb) {
            if (nb < 3) {
#pragma unroll
                for (int ks = 0; ks < 4; ++ks) kf[(nb + 1) & 1][ks] = *(const LAS bf16x8*)(kb + (ks >> 1) * 8192 + ((nb + 1) * 2 + (ks & 1)) * 1024); }
            s[0][nb] = (f32x4){0.f, 0.f, 0.f, 0.f}; s[1][nb] = (f32x4){0.f, 0.f, 0.f, 0.f};
#pragma unroll
            for (int ks = 0; ks < 4; ++ks) { s[0][nb] = __builtin_amdgcn_mfma_f32_16x16x32_bf16(kf[nb & 1][ks], qf[0][ks], s[0][nb], 0, 0, 0); s[1][nb] = __builtin_amdgcn_mfma_f32_16x16x32_bf16(kf[nb & 1][ks], qf[1][ks], s[1][nb], 0, 0, 0); }
            if (nb < 3) __builtin_amdgcn_sched_group_barrier(0x100, 4, 0);
            __builtin_amdgcn_sched_group_barrier(0x008, 8, 0);
            __builtin_amdgcn_sched_barrier(0);
        }
        bf16x8 vf[2][4];
#pragma unroll
        for (int i = 0; i < 4; ++i) vf[0][i] = *(const LAS bf16x8*)(vb + (i * 2) * 1024);
        __builtin_amdgcn_sched_barrier(0);
        bf16x8 pf[2][2];
#pragma unroll
        for (int g = 0; g < 2; ++g) {
            const bool far = dbase + 16 * g - 63 >= 128;
#pragma unroll
            for (int nb = 0; nb < 4; ++nb) {
                if (far) s[g][nb] = s[g][nb] + bfar;
                else { const LAS float* bp = rb + (640 - dpos0 - 16 * g) + 8 * fq + (nb >> 1) * 32 + (nb & 1) * 4;
#pragma unroll
                    for (int j = 0; j < 4; ++j) s[g][nb][j] += bp[j]; } }
            float mx = -1e30f;
#pragma unroll
            for (int nb = 0; nb < 4; ++nb)
#pragma unroll
                for (int j = 0; j < 4; ++j) mx = fmaxf(mx, s[g][nb][j]);
            mx = fmaxf(mx, __shfl_xor(mx, 16)); mx = fmaxf(mx, __shfl_xor(mx, 32));
            const float mn = fmaxf(m[g], mx), alpha = __expf(m[g] - mn); m[g] = mn;
            float ps = 0.f;
#pragma unroll
            for (int nb = 0; nb < 4; ++nb)
#pragma unroll
                for (int j = 0; j < 4; ++j) { const float p = __expf(s[g][nb][j] - mn); s[g][nb][j] = p; ps += p; }
            l[g] = l[g] * alpha + ps;
#pragma unroll
            for (int db = 0; db < 8; ++db) o[g][db] = o[g][db] * alpha;
#pragma unroll
            for (int kk = 0; kk < 2; ++kk) { u32x4 pw; pw.x = pk2(s[g][2 * kk][0], s[g][2 * kk][1]); pw.y = pk2(s[g][2 * kk][2], s[g][2 * kk][3]); pw.z = pk2(s[g][2 * kk + 1][0], s[g][2 * kk + 1][1]); pw.w = pk2(s[g][2 * kk + 1][2], s[g][2 * kk + 1][3]);
                pf[g][kk] = __builtin_bit_cast(bf16x8, pw); }
        }
        __builtin_amdgcn_sched_barrier(0);
#pragma unroll
        for (int b = 0; b < 4; ++b) {
            if (b < 3) {
#pragma unroll
                for (int i = 0; i < 4; ++i) { const int f = 4 * (b + 1) + i, kk = f >> 3, db = f & 7; vf[(b + 1) & 1][i] = *(const LAS bf16x8*)(vb + (db * 2 + kk) * 1024); } }
#pragma unroll
            for (int i = 0; i < 4; ++i) { const int f = 4 * b + i, kk = f >> 3, db = f & 7;
                o[0][db] = __builtin_amdgcn_mfma_f32_16x16x32_bf16(vf[b & 1][i], pf[0][kk], o[0][db], 0, 0, 0); o[1][db] = __builtin_amdgcn_mfma_f32_16x16x32_bf16(vf[b & 1][i], pf[1][kk], o[1][db], 0, 0, 0); }
            if (b < 3) __builtin_amdgcn_sched_group_barrier(0x100, 4, 0);
            __builtin_amdgcn_sched_group_barrier(0x008, 8, 0);
            __builtin_amdgcn_sched_barrier(0);
        }
    }
    DI void finish(unsigned char* orow0, unsigned char* orow1, int fq) {
#pragma unroll
        for (int g = 0; g < 2; ++g) { float lt = l[g]; lt += __shfl_xor(lt, 16); lt += __shfl_xor(lt, 32); const float inv = CAT_SCALE / lt; unsigned char* orow = g ? orow1 : orow0;
#pragma unroll
            for (int db = 0; db < 8; ++db) *(unsigned*)(orow + db * 16 + 4 * fq) = pk4_fp8(o[g][db][0] * inv, o[g][db][1] * inv, o[g][db][2] * inv, o[g][db][3] * inv); }
    }
};
DI void band_wg2(int task, const bf16* Qb, const bf16* Kb, const bf16* VT, const float* relb, unsigned char* CATp, LAS unsigned char* lds0, int tid, int wave, int lane, int mode = 0) {
    typedef AttnWG<128> A;
    asm volatile("" : "+v"(tid), "+v"(lane));
    LAS unsigned char* lds = lds0; asm volatile("" : "+v"(lds));
    const int fr = lane & 15, fq = lane >> 4, ci = wave >> 1; int sR, sC; pg8::stage_rc(tid * 16, sR, sC);
    LAS float* biasl = (LAS float*)(lds + 3 * A::STAGE);
    const int cq = task & 15, bh = task >> 4, h = bh % 24, b = bh / 24, c0 = 4 * cq, c = c0 + ci;
    const int r0 = c * 64 + (wave & 1) * 32, m0 = b * 4096 + r0;
    const int jfirst = c0 < 8 ? 8 - c0 : 0, jlast = 11;
    AW_BAR();
    for (int i = tid; i < 704; i += NWAVES * 64) { int rel = 640 - i; rel = rel < -128 ? -128 : (rel > 128 ? 128 : rel); biasl[i] = relb[h * 257 + rel + 128]; }
    AttnWG2 st; st.init(Qb + (size_t)(m0 + fr) * TOK + h * 128, Qb + (size_t)(m0 + 16 + fr) * TOK + h * 128, fq);
    AW_WAIT(0);
    const bf16* kp = Kb + (size_t)(b * 4096 + (c0 - 8 + jfirst) * 64) * TOK + h * 128;
    const bf16* vp = VT + (size_t)(h * 128) * M + b * 4096 + (c0 - 8 + jfirst) * 64;
    if (!(mode & 16)) { A::stage(lds, kp, TOK, vp, M, sR, sC, wave);
    A::stage(lds + A::STAGE, kp + (size_t)64 * TOK, TOK, vp + 64, M, sR, sC, wave); }
    kp += (size_t)128 * TOK; vp += 128;
    int sidx = 0;
    for (int j = jfirst; j <= jlast; ++j) {
        if (j < jlast) AW_WAIT(4); else AW_WAIT(0);
        AW_BAR();
        if (j + 2 <= jlast && !(mode & 16)) { const int s2 = sidx == 0 ? 2 : sidx - 1; A::stage(lds + s2 * A::STAGE, kp, TOK, vp, M, sR, sC, wave); kp += (size_t)64 * TOK; vp += 64; }
        if (j >= ci && j <= ci + 8 && !(mode & 8)) st.tile(lds + sidx * A::STAGE, biasl, r0 + fr - (c0 - 8 + j) * 64, fr, fq);
        sidx = sidx == 2 ? 0 : sidx + 1;
    }
    if (!(mode & 24)) st.finish(CATp + (size_t)(m0 + fr) * D + h * 128, CATp + (size_t)(m0 + 16 + fr) * D + h * 128, fq);
}

DI void sgu_task(int task, const bf16* U, const bf16* VT, const float* vst, const bf16* SWB, const float* lng, const float* lnb, const float* sgub, unsigned char* CAT, float* out, LAS float* stl, int lane) {
    const int fr = lane & 15, fq = lane >> 4;
    const int part = task % 3, g = (task / 3) & 7, ck = task / 24;
    const bool prompt = ck < 64; const int m0 = prompt ? ck * 128 : MP + (ck - 64) * 32, n = prompt ? 128 : 32;
#pragma unroll
    for (int h = 0; h < 2; ++h) { const int t = lane + 64 * h;
        if (t < n) { float s = 0.f, q = 0.f;
            for (int sl = 0; sl < 24; ++sl) { const f32x2 v = *(const f32x2*)(vst + ((size_t)sl * M + m0 + t) * 2); s += v.x; q += v.y; }
            const float mean = s * (1.0f / TOK), var = q * (1.0f / TOK) - mean * mean;
            stl[2 * t] = mean; stl[2 * t + 1] = __builtin_amdgcn_rsqf(var + LN_EPS); } }
    LDS_WAIT(); asm volatile("" ::: "memory");
    const int nrg = n >> 4, nks = n >> 5;
    bf16x8 wf[8][4];
#pragma unroll
    for (int rg = 0; rg < 8; ++rg)
#pragma unroll
        for (int ks = 0; ks < 4; ++ks) if (ks <= (rg >> 1)) { wf[rg][ks] = (rg < nrg) ? *(const bf16x8*)(SWB + ((size_t)g * 128 + rg * 16 + fr) * 128 + ks * 32 + fq * 8) : (bf16x8){0, 0, 0, 0, 0, 0, 0, 0}; }
    float bs[8];
#pragma unroll
    for (int rg = 0; rg < 8; ++rg) bs[rg] = sgub[g * 128 + ((rg < nrg) ? rg * 16 + fr : 0)];
    for (int cb = 0; cb < 8; ++cb) {
        const int ch0 = g * 384 + part * 128 + cb * 16, ch = ch0 + fr;
        const float gg = lng[ch], gb = lnb[ch];
        bf16x8 af[4];
#pragma unroll
        for (int ks = 0; ks < 4; ++ks) if (ks < nks) {
            const u32x4 raw = *(const u32x4*)(VT + (size_t)ch * M + m0 + ks * 32 + fq * 8);
            const LAS f32x4* sp = (const LAS f32x4*)(stl + 2 * (ks * 32 + fq * 8));
            float v[8]; v[0] = bflo(raw.x); v[1] = bfhi(raw.x); v[2] = bflo(raw.y); v[3] = bfhi(raw.y); v[4] = bflo(raw.z); v[5] = bfhi(raw.z); v[6] = bflo(raw.w); v[7] = bfhi(raw.w);
#pragma unroll
            for (int e2 = 0; e2 < 4; ++e2) { const f32x4 mr = sp[e2]; v[2 * e2] = (v[2 * e2] - mr[0]) * mr[1] * gg + gb; v[2 * e2 + 1] = (v[2 * e2 + 1] - mr[2]) * mr[3] * gg + gb; }
            if (!prompt) { float* op = out + O_SGV + (size_t)(m0 - MP + ks * 32 + fq * 8) * TOK + ch;
#pragma unroll
                for (int e = 0; e < 8; ++e) op[(size_t)e * TOK] = v[e]; }
            u32x4 pw; pw.x = pk2(v[0], v[1]); pw.y = pk2(v[2], v[3]); pw.z = pk2(v[4], v[5]); pw.w = pk2(v[6], v[7]);
            af[ks] = __builtin_bit_cast(bf16x8, pw);
        } else af[ks] = (bf16x8){0, 0, 0, 0, 0, 0, 0, 0};
#pragma unroll
        for (int rg = 0; rg < 8; ++rg) if (rg < nrg) {
            f32x4 acc = (f32x4){0.f, 0.f, 0.f, 0.f};
#pragma unroll
            for (int ks = 0; ks < 4; ++ks) if (ks <= (rg >> 1)) acc = __builtin_amdgcn_mfma_f32_16x16x32_bf16(af[ks], wf[rg][ks], acc, 0, 0, 0);
            const size_t t = (size_t)(m0 + rg * 16 + fr);
            const u32x2 uu = *(const u32x2*)(U + t * TOK + ch0 + 4 * fq);
            *(unsigned*)(CAT + t * D + ch0 + 4 * fq) = pk4_fp8(CAT_SCALE * bflo(uu.x) * (acc[0] + bs[rg]), CAT_SCALE * bfhi(uu.x) * (acc[1] + bs[rg]), CAT_SCALE * bflo(uu.y) * (acc[2] + bs[rg]), CAT_SCALE * bfhi(uu.y) * (acc[3] + bs[rg]));
        }
    }
    LDS_WAIT(); asm volatile("" ::: "memory");
}

DI void ln1_row(const bf16* z, const float* g, const float* b, bf16* xb, unsigned char* x8, int lane) {
    f32x4 v[16]; float s = 0.f;
#pragma unroll
    for (int j = 0; j < 8; ++j) { const u32x4 r = ((const u32x4*)z)[j * 64 + lane];
        v[2 * j] = (f32x4){bflo(r.x), bfhi(r.x), bflo(r.y), bfhi(r.y)}; v[2 * j + 1] = (f32x4){bflo(r.z), bfhi(r.z), bflo(r.w), bfhi(r.w)};
        s += ((v[2 * j][0] + v[2 * j][1]) + (v[2 * j][2] + v[2 * j][3])) + ((v[2 * j + 1][0] + v[2 * j + 1][1]) + (v[2 * j + 1][2] + v[2 * j + 1][3])); }
    const float mean = wave_sum(s) * (1.0f / D); float q = 0.f;
#pragma unroll
    for (int j = 0; j < 16; ++j) { v[j] = v[j] - mean; q += (v[j][0] * v[j][0] + v[j][1] * v[j][1]) + (v[j][2] * v[j][2] + v[j][3] * v[j][3]); }
    const float rstd = __builtin_amdgcn_rsqf(wave_sum(q) * (1.0f / D) + LN_EPS);
#pragma unroll
    for (int j = 0; j < 8; ++j) { const int ci = (j * 64 + lane) * 2;
        const f32x4 y0 = v[2 * j] * rstd * ((const f32x4*)g)[ci] + ((const f32x4*)b)[ci], y1 = v[2 * j + 1] * rstd * ((const f32x4*)g)[ci + 1] + ((const f32x4*)b)[ci + 1];
        st_bf16x8(xb + (size_t)(j * 64 + lane) * 8, y0, y1);
        u32x2 w8; w8.x = pk4_fp8(y0[0] * XB_SCALE, y0[1] * XB_SCALE, y0[2] * XB_SCALE, y0[3] * XB_SCALE); w8.y = pk4_fp8(y1[0] * XB_SCALE, y1[1] * XB_SCALE, y1[2] * XB_SCALE, y1[3] * XB_SCALE); ((u32x2*)x8)[j * 64 + lane] = w8; }
}

DI unsigned fkey(float f) { const unsigned u = __float_as_uint(f); return u ^ ((u >> 31) ? 0xffffffffu : 0x80000000u); }
DI float fkey_inv(unsigned k) { return __uint_as_float(k ^ ((k >> 31) ? 0x80000000u : 0xffffffffu)); }
DI unsigned radix_thr16_2(unsigned u0, unsigned u1) {
    unsigned T, bm, c, n0, n1; unsigned long long m0, m1;
    asm volatile("s_mov_b32 %[T], 0\n\ts_brev_b32 %[bm], 1\n"
                 "1:\n\ts_or_b32 %[c], %[T], %[bm]\n\t"
                 "v_cmp_ge_u32_e64 %[m0], %[u0], %[c]\n\tv_cmp_ge_u32_e64 %[m1], %[u1], %[c]\n\t"
                 "s_bcnt1_i32_b64 %[n0], %[m0]\n\ts_bcnt1_i32_b64 %[n1], %[m1]\n\ts_add_i32 %[n0], %[n0], %[n1]\n\t"
                 "s_cmp_ge_u32 %[n0], 16\n\ts_cselect_b32 %[T], %[c], %[T]\n\ts_cmp_eq_u32 %[n0], 16\n\ts_cbranch_scc1 2f\n\t"
                 "s_lshr_b32 %[bm], %[bm], 1\n\ts_cmp_lg_u32 %[bm], 0\n\ts_cbranch_scc1 1b\n"
                 "2:\n"
                 : [T] "=&s"(T), [bm] "=&s"(bm), [c] "=&s"(c), [n0] "=&s"(n0), [n1] "=&s"(n1), [m0] "=&s"(m0), [m1] "=&s"(m1)
                 : [u0] "v"(u0), [u1] "v"(u1) : "scc");
    return T;
}
DI unsigned radix_thr16_4(unsigned u0, unsigned u1, unsigned u2, unsigned u3) {
    unsigned T, bm, c, n0, n1; unsigned long long m0, m1, m2, m3;
    asm volatile("s_mov_b32 %[T], 0\n\ts_brev_b32 %[bm], 1\n"
                 "1:\n\ts_or_b32 %[c], %[T], %[bm]\n\t"
                 "v_cmp_ge_u32_e64 %[m0], %[u0], %[c]\n\tv_cmp_ge_u32_e64 %[m1], %[u1], %[c]\n\tv_cmp_ge_u32_e64 %[m2], %[u2], %[c]\n\tv_cmp_ge_u32_e64 %[m3], %[u3], %[c]\n\t"
                 "s_bcnt1_i32_b64 %[n0], %[m0]\n\ts_bcnt1_i32_b64 %[n1], %[m1]\n\ts_add_i32 %[n0], %[n0], %[n1]\n\t"
                 "s_bcnt1_i32_b64 %[n1], %[m2]\n\ts_add_i32 %[n0], %[n0], %[n1]\n\ts_bcnt1_i32_b64 %[n1], %[m3]\n\ts_add_i32 %[n0], %[n0], %[n1]\n\t"
                 "s_cmp_ge_u32 %[n0], 16\n\ts_cselect_b32 %[T], %[c], %[T]\n\ts_cmp_eq_u32 %[n0], 16\n\ts_cbranch_scc1 2f\n\t"
                 "s_lshr_b32 %[bm], %[bm], 1\n\ts_cmp_lg_u32 %[bm], 0\n\ts_cbranch_scc1 1b\n"
                 "2:\n"
                 : [T] "=&s"(T), [bm] "=&s"(bm), [c] "=&s"(c), [n0] "=&s"(n0), [n1] "=&s"(n1), [m0] "=&s"(m0), [m1] "=&s"(m1), [m2] "=&s"(m2), [m3] "=&s"(m3)
                 : [u0] "v"(u0), [u1] "v"(u1), [u2] "v"(u2), [u3] "v"(u3) : "scc");
    return T;
}
DI void radix_thr16_4x2(unsigned u00, unsigned u01, unsigned u10, unsigned u11, unsigned u20, unsigned u21, unsigned u30, unsigned u31, unsigned& o0, unsigned& o1, unsigned& o2, unsigned& o3) {
    unsigned T0, T1, T2, T3, cc0, cc1, cc2, cc3, bm, dd, n0, n1; unsigned long long m00, m01, m10, m11, m20, m21, m30, m31;
    asm volatile("s_mov_b32 %[T0], 0\n\ts_mov_b32 %[T1], 0\n\ts_mov_b32 %[T2], 0\n\ts_mov_b32 %[T3], 0\n\ts_brev_b32 %[bm], 1\n\ts_mov_b32 %[d], 0\n1:\n\ts_or_b32 %[c0], %[T0], %[bm]\n\ts_or_b32 %[c1], %[T1], %[bm]\n\ts_or_b32 %[c2], %[T2], %[bm]\n\ts_or_b32 %[c3], %[T3], %[bm]\n\tv_cmp_ge_u32_e64 %[m00], %[u00], %[c0]\n\tv_cmp_ge_u32_e64 %[m01], %[u01], %[c0]\n\tv_cmp_ge_u32_e64 %[m10], %[u10], %[c1]\n\tv_cmp_ge_u32_e64 %[m11], %[u11], %[c1]\n\tv_cmp_ge_u32_e64 %[m20], %[u20], %[c2]\n\tv_cmp_ge_u32_e64 %[m21], %[u21], %[c2]\n\tv_cmp_ge_u32_e64 %[m30], %[u30], %[c3]\n\tv_cmp_ge_u32_e64 %[m31], %[u31], %[c3]\n\ts_bcnt1_i32_b64 %[n0], %[m00]\n\ts_bcnt1_i32_b64 %[n1], %[m01]\n\ts_add_i32 %[n0], %[n0], %[n1]\n\ts_cmp_ge_u32 %[n0], 16\n\ts_cselect_b32 %[T0], %[c0], %[T0]\n\ts_cmp_eq_u32 %[n0], 16\n\ts_cselect_b32 %[n1], 1, 0\n\ts_or_b32 %[d], %[d], %[n1]\n\ts_bcnt1_i32_b64 %[n0], %[m10]\n\ts_bcnt1_i32_b64 %[n1], %[m11]\n\ts_add_i32 %[n0], %[n0], %[n1]\n\ts_cmp_ge_u32 %[n0], 16\n\ts_cselect_b32 %[T1], %[c1], %[T1]\n\ts_cmp_eq_u32 %[n0], 16\n\ts_cselect_b32 %[n1], 2, 0\n\ts_or_b32 %[d], %[d], %[n1]\n\ts_bcnt1_i32_b64 %[n0], %[m20]\n\ts_bcnt1_i32_b64 %[n1], %[m21]\n\ts_add_i32 %[n0], %[n0], %[n1]\n\ts_cmp_ge_u32 %[n0], 16\n\ts_cselect_b32 %[T2], %[c2], %[T2]\n\ts_cmp_eq_u32 %[n0], 16\n\ts_cselect_b32 %[n1], 4, 0\n\ts_or_b32 %[d], %[d], %[n1]\n\ts_bcnt1_i32_b64 %[n0], %[m30]\n\ts_bcnt1_i32_b64 %[n1], %[m31]\n\ts_add_i32 %[n0], %[n0], %[n1]\n\ts_cmp_ge_u32 %[n0], 16\n\ts_cselect_b32 %[T3], %[c3], %[T3]\n\ts_cmp_eq_u32 %[n0], 16\n\ts_cselect_b32 %[n1], 8, 0\n\ts_or_b32 %[d], %[d], %[n1]\n\ts_cmp_eq_u32 %[d], 15\n\ts_cbranch_scc1 2f\n\ts_lshr_b32 %[bm], %[bm], 1\n\ts_cmp_lg_u32 %[bm], 0\n\ts_cbranch_scc1 1b\n2:\n"
                 : [T0] "=&s"(T0), [T1] "=&s"(T1), [T2] "=&s"(T2), [T3] "=&s"(T3), [c0] "=&s"(cc0), [c1] "=&s"(cc1), [c2] "=&s"(cc2), [c3] "=&s"(cc3), [bm] "=&s"(bm), [d] "=&s"(dd), [n0] "=&s"(n0), [n1] "=&s"(n1), [m00] "=&s"(m00), [m01] "=&s"(m01), [m10] "=&s"(m10), [m11] "=&s"(m11), [m20] "=&s"(m20), [m21] "=&s"(m21), [m30] "=&s"(m30), [m31] "=&s"(m31)
                 : [u00] "v"(u00), [u01] "v"(u01), [u10] "v"(u10), [u11] "v"(u11), [u20] "v"(u20), [u21] "v"(u21), [u30] "v"(u30), [u31] "v"(u31) : "scc");
    o0 = T0; o1 = T1; o2 = T2; o3 = T3;
}
DI void radix_thr16_2x4(unsigned u00, unsigned u01, unsigned u02, unsigned u03, unsigned u10, unsigned u11, unsigned u12, unsigned u13, unsigned& o0, unsigned& o1) {
    unsigned T0, T1, cc0, cc1, bm, dd, n0, n1; unsigned long long m00, m01, m02, m03, m10, m11, m12, m13;
    asm volatile("s_mov_b32 %[T0], 0\n\ts_mov_b32 %[T1], 0\n\ts_brev_b32 %[bm], 1\n\ts_mov_b32 %[d], 0\n1:\n\ts_or_b32 %[c0], %[T0], %[bm]\n\ts_or_b32 %[c1], %[T1], %[bm]\n\tv_cmp_ge_u32_e64 %[m00], %[u00], %[c0]\n\tv_cmp_ge_u32_e64 %[m01], %[u01], %[c0]\n\tv_cmp_ge_u32_e64 %[m02], %[u02], %[c0]\n\tv_cmp_ge_u32_e64 %[m03], %[u03], %[c0]\n\tv_cmp_ge_u32_e64 %[m10], %[u10], %[c1]\n\tv_cmp_ge_u32_e64 %[m11], %[u11], %[c1]\n\tv_cmp_ge_u32_e64 %[m12], %[u12], %[c1]\n\tv_cmp_ge_u32_e64 %[m13], %[u13], %[c1]\n\ts_bcnt1_i32_b64 %[n0], %[m00]\n\ts_bcnt1_i32_b64 %[n1], %[m01]\n\ts_add_i32 %[n0], %[n0], %[n1]\n\ts_bcnt1_i32_b64 %[n1], %[m02]\n\ts_add_i32 %[n0], %[n0], %[n1]\n\ts_bcnt1_i32_b64 %[n1], %[m03]\n\ts_add_i32 %[n0], %[n0], %[n1]\n\ts_cmp_ge_u32 %[n0], 16\n\ts_cselect_b32 %[T0], %[c0], %[T0]\n\ts_cmp_eq_u32 %[n0], 16\n\ts_cselect_b32 %[n1], 1, 0\n\ts_or_b32 %[d], %[d], %[n1]\n\ts_bcnt1_i32_b64 %[n0], %[m10]\n\ts_bcnt1_i32_b64 %[n1], %[m11]\n\ts_add_i32 %[n0], %[n0], %[n1]\n\ts_bcnt1_i32_b64 %[n1], %[m12]\n\ts_add_i32 %[n0], %[n0], %[n1]\n\ts_bcnt1_i32_b64 %[n1], %[m13]\n\ts_add_i32 %[n0], %[n0], %[n1]\n\ts_cmp_ge_u32 %[n0], 16\n\ts_cselect_b32 %[T1], %[c1], %[T1]\n\ts_cmp_eq_u32 %[n0], 16\n\ts_cselect_b32 %[n1], 2, 0\n\ts_or_b32 %[d], %[d], %[n1]\n\ts_cmp_eq_u32 %[d], 3\n\ts_cbranch_scc1 2f\n\ts_lshr_b32 %[bm], %[bm], 1\n\ts_cmp_lg_u32 %[bm], 0\n\ts_cbranch_scc1 1b\n2:\n"
                 : [T0] "=&s"(T0), [T1] "=&s"(T1), [c0] "=&s"(cc0), [c1] "=&s"(cc1), [bm] "=&s"(bm), [d] "=&s"(dd), [n0] "=&s"(n0), [n1] "=&s"(n1), [m00] "=&s"(m00), [m01] "=&s"(m01), [m02] "=&s"(m02), [m03] "=&s"(m03), [m10] "=&s"(m10), [m11] "=&s"(m11), [m12] "=&s"(m12), [m13] "=&s"(m13)
                 : [u00] "v"(u00), [u01] "v"(u01), [u02] "v"(u02), [u03] "v"(u03), [u10] "v"(u10), [u11] "v"(u11), [u12] "v"(u12), [u13] "v"(u13) : "scc");
    o0 = T0; o1 = T1;
}
template <int NV> DI void compact16(const unsigned (&u)[NV], unsigned T, int lane, LAS float* dstv, LAS int* dsti) {
    int base = 0;
#pragma unroll
    for (int r = 0; r < NV; ++r) { const bool sel = u[r] >= T; const unsigned long long m = __ballot(sel);
        const int rank = base + (int)__builtin_amdgcn_mbcnt_hi((unsigned)(m >> 32), __builtin_amdgcn_mbcnt_lo((unsigned)m, 0u));
        if (sel && rank < 16) { dstv[rank] = fkey_inv(u[r]); dsti[rank] = lane + 64 * r; }
        base += __builtin_popcountll(m); }
}
DI float row16_max(float x) {
    x = fmaxf(x, __builtin_bit_cast(float, __builtin_amdgcn_update_dpp(0, __builtin_bit_cast(int, x), 0x128, 0xf, 0xf, false)));
    x = fmaxf(x, __builtin_bit_cast(float, __builtin_amdgcn_update_dpp(0, __builtin_bit_cast(int, x), 0x124, 0xf, 0xf, false)));
    x = fmaxf(x, __builtin_bit_cast(float, __builtin_amdgcn_update_dpp(0, __builtin_bit_cast(int, x), 0x122, 0xf, 0xf, false)));
    x = fmaxf(x, __builtin_bit_cast(float, __builtin_amdgcn_update_dpp(0, __builtin_bit_cast(int, x), 0x121, 0xf, 0xf, false)));
    return x;
}
DI void topk_item(int item, const bf16* PQ, const bf16* KEYB, int* IDX, float* GATE, LAS float* S, LAS float* wscr, int wave, int lane) {
    const int fr = lane & 15, fq = lane >> 4, tt = item >> 3, h = item & 7, p = wave >> 2, r0 = (wave & 3) * 16, t0 = tt * 64;
    bf16x8 af[4];
#pragma unroll
    for (int ks = 0; ks < 4; ++ks) af[ks] = *(const bf16x8*)(PQ + (size_t)(t0 + r0 + fr) * 2048 + h * 256 + p * 128 + ks * 32 + fq * 8);
    const bf16* kb = KEYB + ((size_t)(h * 2 + p) * 128) * 128;
#pragma unroll
    for (int nb = 0; nb < 8; ++nb) { f32x4 acc = (f32x4){0.f, 0.f, 0.f, 0.f};
#pragma unroll
        for (int ks = 0; ks < 4; ++ks) { const bf16x8 bfr = *(const bf16x8*)(kb + (size_t)(nb * 16 + fr) * 128 + ks * 32 + fq * 8); acc = __builtin_amdgcn_mfma_f32_16x16x32_bf16(af[ks], bfr, acc, 0, 0, 0); }
#pragma unroll
        for (int j = 0; j < 4; ++j) S[(r0 + 4 * fq + j) * 256 + p * 128 + nb * 16 + fr] = acc[j]; }
    __syncthreads();
    LAS float* v0s = wscr; LAS int* i0s = (LAS int*)(wscr + 16); LAS float* v1s = wscr + 32; LAS int* i1s = (LAS int*)(wscr + 48); LAS float* vfs = wscr + 64; LAS int* ifs = (LAS int*)(wscr + 80);
    for (int q = 0; q < 8; q += 2) { const int tl = wave * 8 + q; const LAS float* sr = S + tl * 256;
        const unsigned ua[2] = {fkey(sr[lane]), fkey(sr[lane + 64])}, ub[2] = {fkey(sr[128 + lane]), fkey(sr[192 + lane])};
        const unsigned uc[2] = {fkey(sr[256 + lane]), fkey(sr[256 + lane + 64])}, ud[2] = {fkey(sr[256 + 128 + lane]), fkey(sr[256 + 192 + lane])};
        unsigned Ta, Tb, Tc, Td; radix_thr16_4x2(ua[0], ua[1], ub[0], ub[1], uc[0], uc[1], ud[0], ud[1], Ta, Tb, Tc, Td);
        compact16<2>(ua, Ta, lane, v0s, i0s); compact16<2>(ub, Tb, lane, v1s, i1s); compact16<2>(uc, Tc, lane, v0s + 96, i0s + 96); compact16<2>(ud, Td, lane, v1s + 96, i1s + 96);
        unsigned c0[4], c1[4]; const float s1a = v1s[lane & 15], s1b = v1s[96 + (lane & 15)];
#pragma unroll
        for (int r = 0; r < 4; ++r) { c0[r] = fkey(v0s[(lane >> 4) + 4 * r] + s1a); c1[r] = fkey(v0s[96 + (lane >> 4) + 4 * r] + s1b); }
        unsigned Tf0, Tf1; radix_thr16_2x4(c0[0], c0[1], c0[2], c0[3], c1[0], c1[1], c1[2], c1[3], Tf0, Tf1);
        compact16<4>(c0, Tf0, lane, vfs, ifs); compact16<4>(c1, Tf1, lane, vfs + 96, ifs + 96);
#pragma unroll
        for (int tk = 0; tk < 2; ++tk) {
            const float bs = vfs[96 * tk + (lane & 15)]; const int pos = ifs[96 * tk + (lane & 15)];
            const int e = i0s[96 * tk + ((pos >> 4) & 15)] * 128 + i1s[96 * tk + (pos & 15)];
            const float ex = __expf(bs - row16_max(bs)), sum = row16_sum(ex);
            if (lane < 16) { const size_t o = (size_t)(t0 + tl + tk) * 128 + h * 16 + lane; IDX[o] = e; GATE[o] = ex / sum; } }
    }
    __syncthreads();
}


#define TK_CHAIN(Lst, k) do { _Pragma("unroll") for (int _s = 0; _s < 16; ++_s) { const unsigned _t = Lst[_s] > (k) ? Lst[_s] : (k); (k) = Lst[_s] > (k) ? (k) : Lst[_s]; Lst[_s] = _t; } } while (0)
DI void topk_item2(int item, const bf16* PQ, const bf16* KEYB, int* IDX, float* GATE, LAS unsigned* S, LAS unsigned* T, int tid, int wave, int lane) {
    const int fr = lane & 15, fq = lane >> 4, tile = item >> 1, hg = item & 1, t0 = tile * 32, hl = wave >> 1, p = wave & 1, h = hg * 4 + hl;
    {
        bf16x8 af[2][4];
#pragma unroll
        for (int rb = 0; rb < 2; ++rb)
#pragma unroll
            for (int ks = 0; ks < 4; ++ks) af[rb][ks] = *(const bf16x8*)(PQ + (size_t)(t0 + rb * 16 + fr) * 2048 + h * 256 + p * 128 + ks * 32 + fq * 8);
        const bf16* kb = KEYB + ((size_t)(h * 2 + p) * 128) * 128;
#pragma unroll
        for (int nb = 0; nb < 8; ++nb) { bf16x8 bfr[4];
#pragma unroll
            for (int ks = 0; ks < 4; ++ks) bfr[ks] = *(const bf16x8*)(kb + (size_t)(nb * 16 + fr) * 128 + ks * 32 + fq * 8);
#pragma unroll
            for (int rb = 0; rb < 2; ++rb) { f32x4 acc = (f32x4){0.f, 0.f, 0.f, 0.f};
#pragma unroll
                for (int ks = 0; ks < 4; ++ks) acc = __builtin_amdgcn_mfma_f32_16x16x32_bf16(af[rb][ks], bfr[ks], acc, 0, 0, 0);
#pragma unroll
                for (int j = 0; j < 4; ++j) { const int set = (hl * 2 + p) * 32 + rb * 16 + 4 * fq + j, n = nb * 16 + fr;
                    S[set * 128 + (n ^ (set & 31))] = (fkey(acc[j]) & 0xFFFFFF80u) | (unsigned)(127 - n); } } }
    }
    __syncthreads();
    {
        const int set = tid >> 1, c2 = tid & 1; const LAS unsigned* sp = S + set * 128; const int sw = set & 31;
        unsigned Lst[16];
#pragma unroll
        for (int i = 0; i < 16; ++i) Lst[i] = 0u;
#pragma unroll 2
        for (int i = 0; i < 64; ++i) { unsigned k = sp[(c2 * 64 + i) ^ sw]; TK_CHAIN(Lst, k); }
        unsigned C[16];
#pragma unroll
        for (int i = 0; i < 16; ++i) { const unsigned pr = (unsigned)__builtin_amdgcn_update_dpp(0, (int)Lst[15 - i], 0xB1, 0xf, 0xf, false); C[i] = Lst[i] > pr ? Lst[i] : pr; }
#pragma unroll
        for (int st = 8; st >= 1; st >>= 1)
#pragma unroll
            for (int i = 0; i < 16; ++i) if ((i & st) == 0) { const unsigned a = C[i] > C[i + st] ? C[i] : C[i + st], b = C[i] > C[i + st] ? C[i + st] : C[i]; C[i] = a; C[i + st] = b; }
        if (c2 == 0) {
#pragma unroll
            for (int i = 0; i < 4; ++i) { u32x4 w; w.x = C[4 * i]; w.y = C[4 * i + 1]; w.z = C[4 * i + 2]; w.w = C[4 * i + 3]; *(LAS u32x4*)(T + set * 16 + 4 * i) = w; } }
    }
    __syncthreads();
    if (tid < 128) {
        const int tok = tid & 31, hl2 = tid >> 5, set0 = (hl2 * 2) * 32 + tok, set1 = set0 + 32;
        float s0[16], s1[16];
#pragma unroll
        for (int i = 0; i < 4; ++i) { const u32x4 a = *(const LAS u32x4*)(T + set0 * 16 + 4 * i), b = *(const LAS u32x4*)(T + set1 * 16 + 4 * i);
            s0[4 * i] = fkey_inv(a.x & 0xFFFFFF80u); s0[4 * i + 1] = fkey_inv(a.y & 0xFFFFFF80u); s0[4 * i + 2] = fkey_inv(a.z & 0xFFFFFF80u); s0[4 * i + 3] = fkey_inv(a.w & 0xFFFFFF80u);
            s1[4 * i] = fkey_inv(b.x & 0xFFFFFF80u); s1[4 * i + 1] = fkey_inv(b.y & 0xFFFFFF80u); s1[4 * i + 2] = fkey_inv(b.z & 0xFFFFFF80u); s1[4 * i + 3] = fkey_inv(b.w & 0xFFFFFF80u); }
        unsigned L2[16];
#pragma unroll
        for (int i = 0; i < 16; ++i) L2[i] = 0u;
#define TK_INS2(i, j) do { unsigned _k = (fkey(s0[i] + s1[j]) & 0xFFFFFF00u) | (unsigned)((i) * 16 + (j)); TK_CHAIN(L2, _k); } while (0)
        TK_INS2(0, 0);
        TK_INS2(0, 1);
        TK_INS2(0, 2);
        TK_INS2(0, 3);
        TK_INS2(0, 4);
        TK_INS2(0, 5);
        TK_INS2(0, 6);
        TK_INS2(0, 7);
        TK_INS2(0, 8);
        TK_INS2(0, 9);
        TK_INS2(0, 10);
        TK_INS2(0, 11);
        TK_INS2(0, 12);
        TK_INS2(0, 13);
        TK_INS2(0, 14);
        TK_INS2(0, 15);
        TK_INS2(1, 0);
        TK_INS2(1, 1);
        TK_INS2(1, 2);
        TK_INS2(1, 3);
        TK_INS2(1, 4);
        TK_INS2(1, 5);
        TK_INS2(1, 6);
        TK_INS2(1, 7);
        TK_INS2(2, 0);
        TK_INS2(2, 1);
        TK_INS2(2, 2);
        TK_INS2(2, 3);
        TK_INS2(2, 4);
        TK_INS2(3, 0);
        TK_INS2(3, 1);
        TK_INS2(3, 2);
        TK_INS2(3, 3);
        TK_INS2(4, 0);
        TK_INS2(4, 1);
        TK_INS2(4, 2);
        TK_INS2(5, 0);
        TK_INS2(5, 1);
        TK_INS2(6, 0);
        TK_INS2(6, 1);
        TK_INS2(7, 0);
        TK_INS2(7, 1);
        TK_INS2(8, 0);
        TK_INS2(9, 0);
        TK_INS2(10, 0);
        TK_INS2(11, 0);
        TK_INS2(12, 0);
        TK_INS2(13, 0);
        TK_INS2(14, 0);
        TK_INS2(15, 0);
#undef TK_INS2
        float ex[16]; float tot = 0.f; const float mx = fkey_inv(L2[0] & 0xFFFFFF00u);
#pragma unroll
        for (int r = 0; r < 16; ++r) { ex[r] = __expf(fkey_inv(L2[r] & 0xFFFFFF00u) - mx); tot += ex[r]; }
        const float inv = 1.0f / tot; const size_t o = (size_t)(t0 + tok) * 128 + (hg * 4 + hl2) * 16;
#pragma unroll
        for (int r4 = 0; r4 < 4; ++r4) { int ev[4]; f32x4 gv;
#pragma unroll
            for (int q = 0; q < 4; ++q) { const unsigned code = L2[4 * r4 + q] & 0xFFu; const int i = code >> 4, j = code & 15;
                ev[q] = (127 - (int)(T[set0 * 16 + i] & 0x7Fu)) * 128 + (127 - (int)(T[set1 * 16 + j] & 0x7Fu)); gv[q] = ex[4 * r4 + q] * inv; }
            *(u32x4*)(IDX + o + 4 * r4) = (u32x4){(unsigned)ev[0], (unsigned)ev[1], (unsigned)ev[2], (unsigned)ev[3]}; *(f32x4*)(GATE + o + 4 * r4) = gv; }
    }
    __syncthreads();
}

DI f32x2 dot32_fp4(const u32x4 w, const f32x4 (&x)[8], f32x2 c) {
    const unsigned ww[4] = {w.x, w.y, w.z, w.w};
#pragma unroll
    for (int i = 0; i < 4; ++i) {
        c = __builtin_elementwise_fma(__builtin_amdgcn_cvt_scalef32_pk_f32_fp4(ww[i], 1.0f, 0), x[2 * i].lo, c); c = __builtin_elementwise_fma(__builtin_amdgcn_cvt_scalef32_pk_f32_fp4(ww[i], 1.0f, 1), x[2 * i].hi, c);
        c = __builtin_elementwise_fma(__builtin_amdgcn_cvt_scalef32_pk_f32_fp4(ww[i], 1.0f, 2), x[2 * i + 1].lo, c); c = __builtin_elementwise_fma(__builtin_amdgcn_cvt_scalef32_pk_f32_fp4(ww[i], 1.0f, 3), x[2 * i + 1].hi, c); }
    return c;
}
DI void axpy32_fp4(const u32x4 w, float a, f32x4 (&y)[8]) {
    const unsigned ww[4] = {w.x, w.y, w.z, w.w}; const f32x2 aa = {a, a};
#pragma unroll
    for (int i = 0; i < 4; ++i) {
        y[2 * i].lo = __builtin_elementwise_fma(aa, __builtin_amdgcn_cvt_scalef32_pk_f32_fp4(ww[i], 1.0f, 0), y[2 * i].lo); y[2 * i].hi = __builtin_elementwise_fma(aa, __builtin_amdgcn_cvt_scalef32_pk_f32_fp4(ww[i], 1.0f, 1), y[2 * i].hi);
        y[2 * i + 1].lo = __builtin_elementwise_fma(aa, __builtin_amdgcn_cvt_scalef32_pk_f32_fp4(ww[i], 1.0f, 2), y[2 * i + 1].lo); y[2 * i + 1].hi = __builtin_elementwise_fma(aa, __builtin_amdgcn_cvt_scalef32_pk_f32_fp4(ww[i], 1.0f, 3), y[2 * i + 1].hi); }
}
template <bool COOP> DI void peer_token(int t, const bf16* X1Bp, const int* IDX, const float* GATE, const unsigned char* PU4, const float* SCU_, const unsigned char* PV4, const float* SCV_,
                   const float* g2, const float* b2, float* outf, bf16* outb, unsigned char* outb8, float* dbg, int lane, int q4 = 0, LAS f32x4* part = nullptr) {
    const int kbeg = COOP ? 32 * q4 : 0, kend = COOP ? 32 * q4 + 32 : 128;
    const u32x4* xr = (const u32x4*)(X1Bp + (size_t)t * D);
    const int id0 = IDX[(size_t)t * 128 + lane], id1 = IDX[(size_t)t * 128 + 64 + lane];
    const float gt0 = GATE[(size_t)t * 128 + lane], gt1 = GATE[(size_t)t * 128 + 64 + lane];
    float a0 = 0.f, a1 = 0.f;
    {
        f32x4 x[2][8];
#pragma unroll
        for (int p = 0; p < 2; ++p)
#pragma unroll
            for (int i = 0; i < 4; ++i) { const u32x4 r = xr[(p * 64 + lane) * 4 + i]; x[p][2 * i] = (f32x4){bflo(r.x), bfhi(r.x), bflo(r.y), bfhi(r.y)}; x[p][2 * i + 1] = (f32x4){bflo(r.z), bfhi(r.z), bflo(r.w), bfhi(r.w)}; }
#pragma unroll 1
        for (int k0 = kbeg; k0 < kend; k0 += 8) {
            u32x4 w[8][2]; float su[8];
#pragma unroll
            for (int q = 0; q < 8; ++q) { const int k = k0 + q; const int e = __builtin_amdgcn_readlane(k0 < 64 ? id0 : id1, k & 63); su[q] = SCU_[e];
                const u32x4* row = (const u32x4*)(PU4 + (size_t)e * (D / 2));
                w[q][0] = row[lane]; w[q][1] = row[64 + lane]; }
#pragma unroll
            for (int q = 0; q < 8; ++q) { const int k = k0 + q; f32x2 d2 = {0.f, 0.f};
                d2 = dot32_fp4(w[q][0], x[0], d2); d2 = dot32_fp4(w[q][1], x[1], d2);
                const float d = wave_sum(d2.x + d2.y) * su[q];
                const float gate = __uint_as_float(__builtin_amdgcn_readlane(__float_as_uint(k0 < 64 ? gt0 : gt1), k & 63));
                const float a = gate * gelu_tanh(d);
                if (k0 < 64) { if (lane == (k & 63)) a0 = a; } else { if (lane == (k & 63)) a1 = a; } }
        }
    }
    if (dbg) { dbg[(size_t)t * 128 + lane] = a0; dbg[(size_t)t * 128 + 64 + lane] = a1; }
    f32x4 y[2][8];
#pragma unroll
    for (int p = 0; p < 2; ++p)
#pragma unroll
        for (int i = 0; i < 8; ++i) y[p][i] = (f32x4){0.f, 0.f, 0.f, 0.f};
#pragma unroll 1
    for (int k0 = kbeg; k0 < kend; k0 += 8) {
        u32x4 w[8][2]; float a[8];
#pragma unroll
        for (int q = 0; q < 8; ++q) { const int k = k0 + q; const int e = __builtin_amdgcn_readlane(k0 < 64 ? id0 : id1, k & 63);
            a[q] = __uint_as_float(__builtin_amdgcn_readlane(__float_as_uint(k0 < 64 ? a0 : a1), k & 63)) * SCV_[e];
            const u32x4* row = (const u32x4*)(PV4 + (size_t)e * (D / 2));
            w[q][0] = row[lane]; w[q][1] = row[64 + lane]; }
#pragma unroll
        for (int q = 0; q < 8; ++q) { axpy32_fp4(w[q][0], a[q], y[0]); axpy32_fp4(w[q][1], a[q], y[1]); }
    }
    asm volatile("" : "+v"(lane));
    if (COOP) {
        if (q4 != 0) {
#pragma unroll
            for (int p = 0; p < 2; ++p)
#pragma unroll
                for (int i = 0; i < 8; ++i) part[(q4 * 16 + p * 8 + i) * 64 + lane] = y[p][i]; }
        __syncthreads();
        if (q4 == 0) {
#pragma unroll
            for (int qq = 1; qq < 4; ++qq)
#pragma unroll
                for (int p = 0; p < 2; ++p)
#pragma unroll
                    for (int i = 0; i < 8; ++i) y[p][i] = y[p][i] + part[(qq * 16 + p * 8 + i) * 64 + lane]; }
        __syncthreads();
        if (q4 != 0) return;
    }
    float s = 0.f;
#pragma unroll
    for (int p = 0; p < 2; ++p)
#pragma unroll
        for (int i = 0; i < 4; ++i) { const u32x4 r = xr[(p * 64 + lane) * 4 + i]; const f32x4 xa = (f32x4){bflo(r.x), bfhi(r.x), bflo(r.y), bfhi(r.y)}, xb2 = (f32x4){bflo(r.z), bfhi(r.z), bflo(r.w), bfhi(r.w)};
            y[p][2 * i] = xa * ALPHA + y[p][2 * i]; y[p][2 * i + 1] = xb2 * ALPHA + y[p][2 * i + 1];
            s += ((y[p][2 * i][0] + y[p][2 * i][1]) + (y[p][2 * i][2] + y[p][2 * i][3])) + ((y[p][2 * i + 1][0] + y[p][2 * i + 1][1]) + (y[p][2 * i + 1][2] + y[p][2 * i + 1][3])); }
    const float mean = wave_sum(s) * (1.0f / D); float q = 0.f;
#pragma unroll
    for (int p = 0; p < 2; ++p)
#pragma unroll
        for (int i = 0; i < 8; ++i) { y[p][i] = y[p][i] - mean; q += (y[p][i][0] * y[p][i][0] + y[p][i][1] * y[p][i][1]) + (y[p][i][2] * y[p][i][2] + y[p][i][3] * y[p][i][3]); }
    const float rstd = __builtin_amdgcn_rsqf(wave_sum(q) * (1.0f / D) + LN_EPS);
#pragma unroll
    for (int p = 0; p < 2; ++p)
#pragma unroll
        for (int i2 = 0; i2 < 4; ++i2) { f32x4 o[2];
#pragma unroll
            for (int hh = 0; hh < 2; ++hh) { const int ci = (p * 64 + lane) * 8 + 2 * i2 + hh; o[hh] = y[p][2 * i2 + hh] * rstd * ((const f32x4*)g2)[ci] + ((const f32x4*)b2)[ci]; if (outf) ((f32x4*)outf)[ci] = o[hh]; }
            if (outb) { u32x4 w0; w0.x = pk2(o[0][0], o[0][1]); w0.y = pk2(o[0][2], o[0][3]); w0.z = pk2(o[1][0], o[1][1]); w0.w = pk2(o[1][2], o[1][3]); ((u32x4*)outb)[(p * 64 + lane) * 4 + i2] = w0;
                u32x2 w8; w8.x = pk4_fp8(o[0][0] * XB_SCALE, o[0][1] * XB_SCALE, o[0][2] * XB_SCALE, o[0][3] * XB_SCALE); w8.y = pk4_fp8(o[1][0] * XB_SCALE, o[1][1] * XB_SCALE, o[1][2] * XB_SCALE, o[1][3] * XB_SCALE); ((u32x2*)outb8)[(p * 64 + lane) * 4 + i2] = w8; } }
}

typedef _Float16 h2_t __attribute__((ext_vector_type(2)));
#define H2C(x) __builtin_bit_cast(h2_t, (x))
DI h2_t dot32_fp4_h(const u32x4 w, const h2_t (&x)[16], h2_t c) {
    unsigned ww[4] = {w.x, w.y, w.z, w.w};
#pragma unroll
    for (int i = 0; i < 4; ++i) {
        c = __builtin_elementwise_fma(H2C(__builtin_amdgcn_cvt_scalef32_pk_f16_fp4(ww[i], 1.0f, 0)), x[4 * i], c); c = __builtin_elementwise_fma(H2C(__builtin_amdgcn_cvt_scalef32_pk_f16_fp4(ww[i], 1.0f, 1)), x[4 * i + 1], c);
        c = __builtin_elementwise_fma(H2C(__builtin_amdgcn_cvt_scalef32_pk_f16_fp4(ww[i], 1.0f, 2)), x[4 * i + 2], c); c = __builtin_elementwise_fma(H2C(__builtin_amdgcn_cvt_scalef32_pk_f16_fp4(ww[i], 1.0f, 3)), x[4 * i + 3], c); }
    return c;
}
DI void axpy32_fp4_h(const u32x4 w, h2_t aa, h2_t (&y)[16]) {
    unsigned ww[4] = {w.x, w.y, w.z, w.w};
#pragma unroll
    for (int i = 0; i < 4; ++i) {
        y[4 * i] = __builtin_elementwise_fma(aa, H2C(__builtin_amdgcn_cvt_scalef32_pk_f16_fp4(ww[i], 1.0f, 0)), y[4 * i]); y[4 * i + 1] = __builtin_elementwise_fma(aa, H2C(__builtin_amdgcn_cvt_scalef32_pk_f16_fp4(ww[i], 1.0f, 1)), y[4 * i + 1]);
        y[4 * i + 2] = __builtin_elementwise_fma(aa, H2C(__builtin_amdgcn_cvt_scalef32_pk_f16_fp4(ww[i], 1.0f, 2)), y[4 * i + 2]); y[4 * i + 3] = __builtin_elementwise_fma(aa, H2C(__builtin_amdgcn_cvt_scalef32_pk_f16_fp4(ww[i], 1.0f, 3)), y[4 * i + 3]); }
}
constexpr int NSUB = 16;
constexpr size_t SUB_BYTES = (size_t)NEXP * 128;
DI float oct_sum(float x) {
    x += __builtin_bit_cast(float, __builtin_amdgcn_update_dpp(0, __builtin_bit_cast(int, x), 0xB1, 0xf, 0xf, false));
    x += __builtin_bit_cast(float, __builtin_amdgcn_update_dpp(0, __builtin_bit_cast(int, x), 0x4E, 0xf, 0xf, false));
    x += __builtin_bit_cast(float, __builtin_amdgcn_update_dpp(0, __builtin_bit_cast(int, x), 0x141, 0xf, 0xf, false));
    return x;
}
DI void peer_u_slice(int t, int sub, const bf16* X1Bp, const int* IDX, const unsigned char* PU4s, float* PACTs, int lane) {
    asm volatile("" : "+v"(lane));
    const int c8 = lane & 7, r8 = lane >> 3;
    const u32x4* xr = (const u32x4*)(X1Bp + (size_t)t * D + sub * 256 + c8 * 32);
    const pg8::v4i* ip = (const pg8::v4i*)(IDX + (size_t)t * 128 + r8 * 16);
    pg8::v4i e4[4];
#pragma unroll
    for (int i = 0; i < 4; ++i) e4[i] = ip[i];
    f32x4 x[8];
#pragma unroll
    for (int i = 0; i < 4; ++i) { const u32x4 r = xr[i]; x[2 * i] = (f32x4){bflo(r.x), bfhi(r.x), bflo(r.y), bfhi(r.y)}; x[2 * i + 1] = (f32x4){bflo(r.z), bfhi(r.z), bflo(r.w), bfhi(r.w)}; }
    u32x4 w[16];
#pragma unroll
    for (int j = 0; j < 16; ++j) w[j] = *(const u32x4*)(PU4s + ((unsigned)e4[j >> 2][j & 3] * 128u + (unsigned)c8 * 16u));
    float res[16];
#pragma unroll
    for (int j = 0; j < 16; ++j) { const f32x2 d2 = dot32_fp4(w[j], x, (f32x2){0.f, 0.f}); res[j] = oct_sum(d2.x + d2.y); }
    if (c8 == 0) { f32x4* o = (f32x4*)(PACTs + (size_t)t * 128 + r8 * 16);
#pragma unroll
        for (int i = 0; i < 4; ++i) o[i] = (f32x4){res[4 * i], res[4 * i + 1], res[4 * i + 2], res[4 * i + 3]}; }
}
DI void peer_a_pair(int t0, const int* IDX, const float* GATE, const float* PACT, const float* SCU_, const float* SCV_, float* AV, int lane) {
    asm volatile("" : "+v"(lane));
    const size_t o = (size_t)t0 * 128 + lane * 4;
    const pg8::v4i e = *(const pg8::v4i*)(IDX + o); const f32x4 g = *(const f32x4*)(GATE + o);
    f32x4 p[NSUB];
#pragma unroll
    for (int sub = 0; sub < NSUB; ++sub) p[sub] = *(const f32x4*)(PACT + (size_t)sub * M * 128 + o);
    float su[4], sv[4];
#pragma unroll
    for (int i = 0; i < 4; ++i) { su[i] = SCU_[e[i]]; sv[i] = SCV_[e[i]]; }
    f32x4 sum = p[0];
#pragma unroll
    for (int sub = 1; sub < NSUB; ++sub) sum = sum + p[sub];
    f32x4 a;
#pragma unroll
    for (int i = 0; i < 4; ++i) a[i] = g[i] * gelu_tanh(sum[i] * su[i] * (1.0f / XB_SCALE)) * sv[i];
    *(f32x4*)(AV + o) = a;
}
DI void peer_v_slice(int t, int sub, const bf16* X1Bp, const int* IDX, const float* AV, const unsigned char* PV4s, bf16* ZBp, float* STATs, LAS f32x4* red, int lane) {
    asm volatile("" : "+v"(lane));
    const int c8 = lane & 7, r8 = lane >> 3;
    const pg8::v4i* ip = (const pg8::v4i*)(IDX + (size_t)t * 128 + r8 * 16);
    const f32x4* ap = (const f32x4*)(AV + (size_t)t * 128 + r8 * 16);
    const int col = sub * 256 + 32 * (lane & 7) + 4 * (lane >> 3);
    const u32x2 xv = *(const u32x2*)(X1Bp + (size_t)t * D + col);
    f32x4 y[8];
#pragma unroll
    for (int i = 0; i < 8; ++i) y[i] = (f32x4){0.f, 0.f, 0.f, 0.f};
#pragma unroll 1
    for (int b = 0; b < 2; ++b) {
        pg8::v4i e4[2]; f32x4 a4[2];
#pragma unroll
        for (int i = 0; i < 2; ++i) { e4[i] = ip[2 * b + i]; a4[i] = ap[2 * b + i]; }
        u32x4 w[8];
#pragma unroll
        for (int j = 0; j < 8; ++j) w[j] = *(const u32x4*)(PV4s + ((unsigned)e4[j >> 2][j & 3] * 128u + (unsigned)c8 * 16u));
#pragma unroll
        for (int j = 0; j < 8; ++j) axpy32_fp4(w[j], a4[j >> 2][j & 3], y);
    }
#pragma unroll
    for (int q = 0; q < 8; ++q) red[r8 * 72 + q * 8 + c8] = y[q];
    asm volatile("s_waitcnt lgkmcnt(0)" ::: "memory");
    f32x4 z = red[lane];
#pragma unroll
    for (int r = 1; r < 8; ++r) z = z + red[r * 72 + lane];
    asm volatile("s_waitcnt lgkmcnt(0)" ::: "memory");
    z = (f32x4){bflo(xv.x), bfhi(xv.x), bflo(xv.y), bfhi(xv.y)} * ALPHA + z;
    const float s1 = wave_sum((z[0] + z[1]) + (z[2] + z[3])), s2 = wave_sum((z[0] * z[0] + z[1] * z[1]) + (z[2] * z[2] + z[3] * z[3]));
    u32x2 o; o.x = pk2(z[0], z[1]); o.y = pk2(z[2], z[3]); *(u32x2*)(ZBp + (size_t)t * D + col) = o;
    if (lane == 0) *(f32x2*)(STATs + (size_t)t * 2) = (f32x2){s1, s2};
}
#define PEER_HCL(h) ((h) < nh ? (h) : nh - 1)
#define PEER_HOFF(h) ((size_t)(wx + (PEER_HCL(h) >> 1) * nwx) * 128 + (PEER_HCL(h) & 1) * 8)
#define PEER_MEMFENCE() asm volatile("" ::: "memory")
DI void peer_u_pass(int sub, int wx, int nwx, const bf16* X1Bp, const int* IDX, const unsigned char* PU4s, float* PACTs, int lane, int emask = 0x3fff) {
    asm volatile("" : "+v"(lane));
    if (wx >= M) return;
    const int c8 = lane & 7, r8 = lane >> 3; const unsigned lo = (unsigned)c8 * 16u;
    const int* ibase = IDX + r8 * 16; const bf16* xbase = X1Bp + sub * 256 + c8 * 32;
    pg8::v4i eA[2], eB[2]; u32x4 xraw[4], wA[8], wB[8]; h2_t x[16];
    { const pg8::v4i* ip = (const pg8::v4i*)(ibase + (size_t)wx * 128); eA[0] = ip[0]; eA[1] = ip[1]; eB[0] = ip[2]; eB[1] = ip[3];
#pragma unroll
      for (int i = 0; i < 4; ++i) xraw[i] = ((const u32x4*)(xbase + (size_t)wx * D))[i];
#pragma unroll
      for (int j = 0; j < 8; ++j) wA[j] = *(const u32x4*)(PU4s + ((unsigned)(eA[j >> 2][j & 3] & emask) * 128u + lo)); }
#pragma unroll 1
    for (int t = wx; t < M; t += nwx) {
        const int tn = (t + nwx < M) ? t + nwx : t;
#pragma unroll
        for (int j = 0; j < 8; ++j) wB[j] = *(const u32x4*)(PU4s + ((unsigned)(eB[j >> 2][j & 3] & emask) * 128u + lo));
#pragma unroll
        for (int i = 0; i < 4; ++i) { const u32x4 r = xraw[i]; x[4 * i] = H2C(__builtin_amdgcn_cvt_pkrtz(bflo(r.x), bfhi(r.x))); x[4 * i + 1] = H2C(__builtin_amdgcn_cvt_pkrtz(bflo(r.y), bfhi(r.y))); x[4 * i + 2] = H2C(__builtin_amdgcn_cvt_pkrtz(bflo(r.z), bfhi(r.z))); x[4 * i + 3] = H2C(__builtin_amdgcn_cvt_pkrtz(bflo(r.w), bfhi(r.w))); }
        PEER_MEMFENCE();
        { const pg8::v4i* ip = (const pg8::v4i*)(ibase + (size_t)tn * 128); eA[0] = ip[0]; eA[1] = ip[1]; eB[0] = ip[2]; eB[1] = ip[3];
#pragma unroll
          for (int i = 0; i < 4; ++i) xraw[i] = ((const u32x4*)(xbase + (size_t)tn * D))[i]; }
        PEER_MEMFENCE();
        float res[16];
#pragma unroll
        for (int j = 0; j < 8; ++j) { const h2_t d2 = dot32_fp4_h(wA[j], x, (h2_t){(_Float16)0.f, (_Float16)0.f}); res[j] = oct_sum((float)d2.x + (float)d2.y); }
        PEER_MEMFENCE();
#pragma unroll
        for (int j = 0; j < 8; ++j) wA[j] = *(const u32x4*)(PU4s + ((unsigned)(eA[j >> 2][j & 3] & emask) * 128u + lo));
        PEER_MEMFENCE();
#pragma unroll
        for (int j = 0; j < 8; ++j) { const h2_t d2 = dot32_fp4_h(wB[j], x, (h2_t){(_Float16)0.f, (_Float16)0.f}); res[8 + j] = oct_sum((float)d2.x + (float)d2.y); }
        if (c8 == 0) { f32x4* o = (f32x4*)(PACTs + (size_t)t * 128 + r8 * 16);
#pragma unroll
            for (int i = 0; i < 4; ++i) o[i] = (f32x4){res[4 * i], res[4 * i + 1], res[4 * i + 2], res[4 * i + 3]}; }
    }
}
#define PEER_HOFF4(h) ((size_t)(wx + (PEER_HCL(h) >> 1) * nwx) * 128 + (PEER_HCL(h) & 1) * 4)
DI void peer_u_pass_mfma(int sub, int wx, int nwx, const unsigned char* X18p, const int* IDX, const unsigned char* PU4s, float* PACTs, LAS unsigned char* buf, int lane, int emask = 0x3fff) {
    asm volatile("" : "+v"(lane));
    if (wx >= M) return;
    const int i16 = lane & 15, kg = lane >> 4, r8 = lane >> 3, c8 = lane & 7;
    const int* ibase = IDX + r8 * 8; const unsigned char* xbase = X18p + sub * 256 + kg * 16;
    const unsigned rdoff = (unsigned)((i16 & 7) * 1024 + (i16 >> 3) * 128);
    pg8::v4i eA[2], eB[2]; u32x4 braw[4], bc[4];
#define PEER_DMA_HALF(E, BUF) do { _Pragma("unroll") for (int q = 0; q < 8; ++q) \
        AttnWG<128>::dma16(PU4s + ((unsigned)(E[q >> 2][q & 3] & emask) * 128u + (unsigned)((c8 ^ q) * 16)), (BUF) + q * 1024); } while (0)
#define PEER_MFMA_HALF(BUF, HALF) do { f32x4 acc[4]; \
        _Pragma("unroll") for (int g = 0; g < 4; ++g) { acc[g] = (f32x4){0.f, 0.f, 0.f, 0.f}; \
            _Pragma("unroll") for (int ks = 0; ks < 2; ++ks) { const u32x4 av = *(const LAS u32x4*)((BUF) + rdoff + g * 256 + (((4 * ks + kg) ^ (i16 & 7)) * 16)); const pg8::v8i a8 = {(int)av.x, (int)av.y, (int)av.z, (int)av.w, 0, 0, 0, 0}; \
                const u32x4 b0 = bc[2 * ks], b1 = bc[2 * ks + 1]; const pg8::v8i b8 = {(int)b0.x, (int)b0.y, (int)b0.z, (int)b0.w, (int)b1.x, (int)b1.y, (int)b1.z, (int)b1.w}; \
                acc[g] = __builtin_amdgcn_mfma_scale_f32_16x16x128_f8f6f4(a8, b8, acc[g], 4, 0, 0, 0x7F7F7F7F, 0, 0x7F7F7F7F); } } \
        if (i16 == 0) { _Pragma("unroll") for (int g = 0; g < 4; ++g) *(f32x4*)(PACTs + (size_t)t * 128 + (HALF) * 64 + g * 16 + 4 * kg) = acc[g]; } } while (0)
    LAS unsigned char* bufA = buf; LAS unsigned char* bufB = buf + 8192;
    { const pg8::v4i* ip = (const pg8::v4i*)(ibase + (size_t)wx * 128); eA[0] = ip[0]; eA[1] = ip[1]; const pg8::v4i* iq = (const pg8::v4i*)(ibase + (size_t)wx * 128 + 64); eB[0] = iq[0]; eB[1] = iq[1];
#pragma unroll
      for (int ks = 0; ks < 2; ++ks) { braw[2 * ks] = *(const u32x4*)(xbase + (size_t)wx * D + ks * 128); braw[2 * ks + 1] = *(const u32x4*)(xbase + (size_t)wx * D + ks * 128 + 64); }
      PEER_DMA_HALF(eA, bufA);
      asm volatile("s_waitcnt vmcnt(0)" ::: "memory"); }
#pragma unroll 1
    for (int t = wx; t < M; t += nwx) {
        const int tn = (t + nwx < M) ? t + nwx : t;
        PEER_DMA_HALF(eB, bufB);
#pragma unroll
        for (int i = 0; i < 4; ++i) bc[i] = braw[i];
        PEER_MEMFENCE();
        { const pg8::v4i* ip = (const pg8::v4i*)(ibase + (size_t)tn * 128); eA[0] = ip[0]; eA[1] = ip[1]; const pg8::v4i* iq = (const pg8::v4i*)(ibase + (size_t)tn * 128 + 64); eB[0] = iq[0]; eB[1] = iq[1];
#pragma unroll
          for (int ks = 0; ks < 2; ++ks) { braw[2 * ks] = *(const u32x4*)(xbase + (size_t)tn * D + ks * 128); braw[2 * ks + 1] = *(const u32x4*)(xbase + (size_t)tn * D + ks * 128 + 64); } }
        asm volatile("s_waitcnt vmcnt(16)" ::: "memory");
        PEER_MFMA_HALF(bufA, 0);
        PEER_MEMFENCE();
        PEER_DMA_HALF(eA, bufA);
        asm volatile("s_waitcnt vmcnt(12)" ::: "memory");
        PEER_MFMA_HALF(bufB, 1);
        PEER_MEMFENCE();
    }
    asm volatile("s_waitcnt vmcnt(0)" ::: "memory");
}
DI void peer_v_pass(int sub, int wx, int nwx, const bf16* X1Bp, const int* IDX, const float* AV, const unsigned char* PV4s, bf16* ZBp, float* STATs, LAS f32x4* red, int lane, int emask = 0x3fff) {
    asm volatile("" : "+v"(lane));
    if (wx >= M) return;
    const int c8 = lane & 7, r8 = lane >> 3; const unsigned lo = (unsigned)c8 * 16u;
    const int* ibase = IDX + r8 * 16; const float* abase = AV + r8 * 16;
    const int col = sub * 256 + 32 * (lane & 7) + 4 * (lane >> 3);
    pg8::v4i eA[2], eB[2]; f32x4 aA[2], aB[2]; u32x4 wA[8], wB[8]; h2_t yh[16];
    { const pg8::v4i* ip = (const pg8::v4i*)(ibase + (size_t)wx * 128); eA[0] = ip[0]; eA[1] = ip[1]; eB[0] = ip[2]; eB[1] = ip[3];
      const f32x4* ap = (const f32x4*)(abase + (size_t)wx * 128); aA[0] = ap[0]; aA[1] = ap[1]; aB[0] = ap[2]; aB[1] = ap[3];
#pragma unroll
      for (int j = 0; j < 8; ++j) wA[j] = *(const u32x4*)(PV4s + ((unsigned)(eA[j >> 2][j & 3] & emask) * 128u + lo)); }
#pragma unroll 1
    for (int t = wx; t < M; t += nwx) {
        const int tn = (t + nwx < M) ? t + nwx : t;
#pragma unroll
        for (int j = 0; j < 8; ++j) wB[j] = *(const u32x4*)(PV4s + ((unsigned)(eB[j >> 2][j & 3] & emask) * 128u + lo));
        PEER_MEMFENCE();
        { const pg8::v4i* ip = (const pg8::v4i*)(ibase + (size_t)tn * 128); eA[0] = ip[0]; eA[1] = ip[1]; eB[0] = ip[2]; eB[1] = ip[3]; }
        const u32x2 xv = *(const u32x2*)(X1Bp + (size_t)t * D + col);
        PEER_MEMFENCE();
#pragma unroll
        for (int i = 0; i < 16; ++i) yh[i] = (h2_t){(_Float16)0.f, (_Float16)0.f};
#pragma unroll
        for (int j = 0; j < 8; ++j) { const float aj = aA[j >> 2][j & 3]; axpy32_fp4_h(wA[j], H2C(__builtin_amdgcn_cvt_pkrtz(aj, aj)), yh); }
        PEER_MEMFENCE();
        { const f32x4* ap = (const f32x4*)(abase + (size_t)tn * 128); aA[0] = ap[0]; aA[1] = ap[1]; }
#pragma unroll
        for (int j = 0; j < 8; ++j) wA[j] = *(const u32x4*)(PV4s + ((unsigned)(eA[j >> 2][j & 3] & emask) * 128u + lo));
        PEER_MEMFENCE();
#pragma unroll
        for (int j = 0; j < 8; ++j) { const float aj = aB[j >> 2][j & 3]; axpy32_fp4_h(wB[j], H2C(__builtin_amdgcn_cvt_pkrtz(aj, aj)), yh); }
        PEER_MEMFENCE();
        { const f32x4* ap = (const f32x4*)(abase + (size_t)tn * 128); aB[0] = ap[2]; aB[1] = ap[3]; }
#pragma unroll
        for (int q = 0; q < 8; ++q) red[r8 * 72 + q * 8 + c8] = (f32x4){(float)yh[2 * q].x, (float)yh[2 * q].y, (float)yh[2 * q + 1].x, (float)yh[2 * q + 1].y};
        asm volatile("s_waitcnt lgkmcnt(0)" ::: "memory");
        f32x4 z = red[lane];
#pragma unroll
        for (int r = 1; r < 8; ++r) z = z + red[r * 72 + lane];
        asm volatile("s_waitcnt lgkmcnt(0)" ::: "memory");
        z = (f32x4){bflo(xv.x), bfhi(xv.x), bflo(xv.y), bfhi(xv.y)} * ALPHA + z;
        u32x2 o; o.x = pk2(z[0], z[1]); o.y = pk2(z[2], z[3]); *(u32x2*)(ZBp + (size_t)t * D + col) = o;
    }
}
DI void ln2_row(int t, const bf16* ZBp, const float* STAT, const float* g2, const float* b2, float* outf, bf16* outb, unsigned char* outb8, int lane) {
    asm volatile("" : "+v"(lane));
    const u32x2* zr = (const u32x2*)(ZBp + (size_t)t * D);
    f32x4 zf[16]; float s1 = 0.f;
#pragma unroll
    for (int j = 0; j < 16; ++j) { const u32x2 r = zr[j * 64 + lane]; zf[j] = (f32x4){bflo(r.x), bfhi(r.x), bflo(r.y), bfhi(r.y)}; s1 += (zf[j][0] + zf[j][1]) + (zf[j][2] + zf[j][3]); }
    const float mean = wave_sum(s1) * (1.0f / D); float s2 = 0.f;
#pragma unroll
    for (int j = 0; j < 16; ++j) { zf[j] = zf[j] - mean; s2 += (zf[j][0] * zf[j][0] + zf[j][1] * zf[j][1]) + (zf[j][2] * zf[j][2] + zf[j][3] * zf[j][3]); }
    const float rstd = __builtin_amdgcn_rsqf(wave_sum(s2) * (1.0f / D) + LN_EPS);
#pragma unroll
    for (int j = 0; j < 16; ++j) { const int ci = j * 64 + lane;
        const f32x4 o = zf[j] * rstd * ((const f32x4*)g2)[ci] + ((const f32x4*)b2)[ci];
        if (outf) ((f32x4*)outf)[ci] = o;
        if (outb) { u32x2 w0; w0.x = pk2(o[0], o[1]); w0.y = pk2(o[2], o[3]); ((u32x2*)outb)[ci] = w0; ((unsigned*)outb8)[ci] = pk4_fp8(o[0] * XB_SCALE, o[1] * XB_SCALE, o[2] * XB_SCALE, o[3] * XB_SCALE); } }
}

DI const float* inp_ptr(const LAS unsigned long long* tab, int k) { const unsigned long long v = tab[k];
    const unsigned lo = __builtin_amdgcn_readfirstlane((unsigned)v), hi = __builtin_amdgcn_readfirstlane((unsigned)(v >> 32)); return (const float*)(((unsigned long long)hi << 32) | lo); }
__global__ void __launch_bounds__(NWAVES * 64, 2) mk_fwd(Args args) {
    extern __shared__ __attribute__((aligned(16))) unsigned char lds[];
    LAS unsigned char* L = (LAS unsigned char*)lds;
    volatile LAS unsigned* MISC = (volatile LAS unsigned*)(L + MISC_OFF);
    const int tid = threadIdx.x, lane = tid & 63, wave = __builtin_amdgcn_readfirstlane(tid >> 6);
    const int G = gridDim.x; const int bx = blockIdx.x; const int vcu = (G % 8 == 0) ? (bx % 8) * (G / 8) + bx / 8 : bx;
    const int gw = vcu * NWAVES + wave, NGW = G * NWAVES;
    unsigned char* ws = args.ws; float* out = args.out;
    unsigned* ctl = (unsigned*)(ws + WS_CTL);
    for (int u = tid; u < (LDS_BYTES - LDSCTL_OFF) / 4; u += NWAVES * 64) ((LAS unsigned*)(L + LDSCTL_OFF))[u] = 0u;
    __syncthreads();
    LAS unsigned long long* ptab = (LAS unsigned long long*)(L + LDSCTL_OFF);
    if (tid == 0) {
#pragma unroll
        for (int k = 0; k < 24; ++k) ptab[k] = (unsigned long long)args.in[k]; }
    __syncthreads();
#define INP(k) inp_ptr(ptab, (k))
    XcdBarrier bar; bar.bar = ctl + CW_BAR; bar.x = 0; bar.st = nullptr;
    if (N_LAUNCHES == 1) bar = xcd_barrier_post(ctl + CW_BAR, MISC + 8);
    const int lo = args.ph_lo, hi = args.ph_hi;
#ifndef PH_MASK
#define PH_MASK 0x7fff
#endif
#define IN(k) ((((PH_MASK) >> (k)) & 1) && lo <= (k) && (k) < hi)
#define REP(k) for (int _r = 0, _n = ((args.dup >> (k)) & 1) + 1; _r < _n; ++_r, __syncthreads())
#define TAIL(total) const int first_idle = (total) - (((total) + G - 1) / G - 1) * G; const bool in_tail = bx >= first_idle && first_idle < G; const int gtw = (bx - first_idle) * NWAVES + wave, ngtw = (G - first_idle) * NWAVES; \
    LAS float* scr = (LAS float*)(L + wave * 16640); const size_t gtt = (size_t)gtw * 64 + ln, ntt = (size_t)ngtw * 64; (void)scr; (void)gtt; (void)ntt
#define SEAM(k) do { if (IN(k) && IN((k) + 1)) xcd_barrier(bar); } while (0)

#define Wa ((bf16*)(ws + WS_WA))
#define Wb ((bf16*)(ws + WS_WB))
#define Wmkv ((bf16*)(ws + WS_WMKV))
#define Wout8 ((unsigned char*)(ws + WS_WOUT))
#define Wq ((bf16*)(ws + WS_WQ))
#define KEYB ((bf16*)(ws + WS_KEYB))
#define SWB ((bf16*)(ws + WS_SWB))
#define PU8 ((unsigned char*)(ws + WS_PU))
#define PV8 ((unsigned char*)(ws + WS_PV))
#define SCU ((float*)(ws + WS_SCU))
#define SCV ((float*)(ws + WS_SCV))
#define XB ((bf16*)(ws + WS_XB))
#define XF ((float*)(ws + WS_XF))
#define MEMB ((bf16*)(ws + WS_MEMB))
#define MKB ((bf16*)(ws + WS_MKB))
#define MVT ((bf16*)(ws + WS_MVT))
#define CMK ((bf16*)(ws + WS_CMK))
#define CMVT ((bf16*)(ws + WS_CMVT))
#define CK ((bf16*)(ws + WS_CK))
#define CVT ((bf16*)(ws + WS_CVT))
#define BUFA ((bf16*)(ws + WS_BUFA))
#define BUFB ((bf16*)(ws + WS_BUFB))
#define BUFC ((bf16*)(ws + WS_BUFC))
#define QM ((bf16*)(ws + WS_QM))
#define CAT ((unsigned char*)(ws + WS_CAT))
#define Z ((bf16*)(ws + WS_Z))
#define X1F ((float*)(ws + WS_X1F))
#define X1B ((bf16*)(ws + WS_X1B))
#define X18 ((unsigned char*)(ws + WS_XF + 80 * MiB))
#define PQ ((bf16*)(ws + WS_PQ))
#define IDX ((int*)(ws + WS_IDX))
#define GATE ((float*)(ws + WS_GATE))
#define VST ((float*)(ws + WS_VST))
#define XB8 ((unsigned char*)(ws + WS_XB8))
#define Wa8 ((unsigned char*)(ws + WS_WA8))
#define Wb8 ((unsigned char*)(ws + WS_WB8))

    if (IN(0)) REP(0) { int ln = lane; asm volatile("" : "+v"(ln)); int tq = tid; asm volatile("" : "+v"(tq));
        LAS float* scr = (LAS float*)(L + wave * 16640);
        tr_job_both(INP(I_WINA) + 3072, Wa + (size_t)3072 * KDIM, Wa8 + (size_t)4096 * KDIM, 4096, 3072, 7168, WIN_SCALE, scr, gw, NGW, ln);
        tr_job8(INP(I_WINA), Wa8, 4096, 3072, 7168, WIN_SCALE, scr, gw, NGW, ln);
        tr_job8(INP(I_WINA) + 6144, Wa8 + (size_t)3072 * KDIM, 4096, 1024, 7168, WIN_SCALE, scr, gw, NGW, ln);
        tr_job(INP(I_WMKV), Wmkv, 4096, 2048, 2, (size_t)4096 * 2048, (size_t)4096 * 2048, scr, gw, NGW, ln);
        tr_job8(INP(I_WOUT), Wout8, 4096, 4096, 4096, WOUT_SCALE, scr, gw, NGW, ln);
        tr_job(INP(I_PWQ), Wq, 4096, 2048, 1, 0, 0, scr, gw, NGW, ln);
        tr_job(INP(I_CMV), CMVT, 256, 1024, 32, (size_t)256 * 1024, (size_t)256 * 1024, scr, gw, NGW, ln);
        const size_t gt = (size_t)gw * 64 + ln, nth = (size_t)NGW * 64;
        cvt_job(INP(I_XP), XB, (size_t)MP * D, gt, nth, XB8, XB_SCALE);
        cvt_job(INP(I_XS), XB + (size_t)MP * D, (size_t)MS * D, gt, nth, XB8 + (size_t)MP * D, XB_SCALE);
        cvt_job(INP(I_MEMP), MEMB, (size_t)512 * D, gt, nth);
        cvt_job(INP(I_PKEYS), KEYB, (size_t)2 * 8 * 2 * 128 * 128, gt, nth);
        cvt_job(INP(I_CMK), CMK, (size_t)2 * 16 * 256 * 1024, gt, nth);
        for (size_t i = gt; i < (size_t)8 * 128 * 128; i += nth) { const int s = (int)(i & 127), t = (int)((i >> 7) & 127); const float v = (s <= t) ? INP(I_SGUW)[i] : 0.f; SWB[i] = (bf16)(pk2(v, 0.f) & 0xffffu); }
    }
    SEAM(0);
    if (IN(1)) REP(1) { int ln = lane; asm volatile("" : "+v"(ln)); int tq = tid; asm volatile("" : "+v"(tq));
        EpiA E{BUFA, QM, BUFB, VST, out, MKB, MVT};
        { pg8::MultiOrder<JobsA> S; S.G = G; S.c = bx; S.jt = JobsA{XB, Wa, MEMB, Wmkv};
          pg8::gemm_phase<EpiA, pg8::MultiOrder<JobsA>>(L, S, E, tq); }
        { constexpr int off = 72;
          pg8::MultiOrder<JobsA8, pg8::TSTEP / 2> S; S.G = G; S.c = (G == 256) ? ((bx + 256 - off) & 255) : bx; S.jt = JobsA8{XB8, Wa8};
          int tq2 = tid; asm volatile("" : "+v"(tq2));
          pg8::gemm_phase<EpiA, pg8::MultiOrder<JobsA8, pg8::TSTEP / 2>, true>(L, S, E, tq2); }
    }
    SEAM(1);
    if (IN(2)) REP(2) { int ln = lane; asm volatile("" : "+v"(ln)); int tq = tid; asm volatile("" : "+v"(tq));
        { const int sh = (320 > G) ? (320 - G) : 0;
          for (int t = ((vcu + sh) % G); t < 320; t += G) mem_wg(t, 0, QM, MKB, MVT, CMK, CMVT, CAT, L, tq, wave, ln); }
        AW_BAR();
        LAS float* stl = (LAS float*)(L + wave * 2048);
        constexpr int NSGU = 80 * 8 * 3;
        for (int t = gw; t < NSGU; t += NGW) sgu_task(t, BUFA, BUFB, VST, SWB, INP(I_SLNG), INP(I_SLNB), INP(I_SGUB), CAT, out, stl, ln);
    }
    SEAM(2);
    if (IN(3)) REP(3) { int ln = lane; asm volatile("" : "+v"(ln)); int tq = tid; asm volatile("" : "+v"(tq));
        pg8::MultiOrder<Jobs1, pg8::TSTEP / 2> S; S.G = G; S.c = bx; S.jt = Jobs1{(const bf16*)CAT, (const bf16*)Wout8, 16, K_OUT};
        EpiOut<true> E{XB, XB + (size_t)MP * D, Z};
        pg8::gemm_phase<EpiOut<true>, pg8::MultiOrder<Jobs1, pg8::TSTEP / 2>, true>(L, S, E, tq);
        TAIL(544);
        if (in_tail) { fp4_rows_job(INP(I_PU), (unsigned*)PU8, SCU, 0, NEXP, gtw, ngtw, ln); fp4_rows_job(INP(I_PV), (unsigned*)PV8, SCV, 0, V0_A, gtw, ngtw, ln); }
    }
    SEAM(3);
    if (IN(4)) REP(4) { int ln = lane; asm volatile("" : "+v"(ln)); int tq = tid; asm volatile("" : "+v"(tq)); for (int m = gw; m < M; m += NGW) ln1_row(Z + (size_t)m * D, INP(I_LN1G), INP(I_LN1B), X1B + (size_t)m * D, X18 + (size_t)m * D, ln); }
    SEAM(4);
    if (IN(5)) REP(5) { int ln = lane; asm volatile("" : "+v"(ln)); int tq = tid; asm volatile("" : "+v"(tq));
        pg8::MultiOrder<Jobs1> S; S.G = G; S.c = bx; S.jt = Jobs1{X1B, Wq, 8, K_WQ};
        EpiWq E{PQ};
        pg8::gemm_phase<EpiWq, pg8::MultiOrder<Jobs1>>(L, S, E, tq);
        TAIL(272);
        if (in_tail) {
            tr_job_both(INP(I_WINB) + 3072, Wb + (size_t)3072 * KDIM, Wb8 + (size_t)4096 * KDIM, 4096, 6144, 10240, WIN_SCALE, scr, gtw, ngtw, ln);
            tr_job8(INP(I_WINB), Wb8, 4096, 3072, 10240, WIN_SCALE, scr, gtw, ngtw, ln);
            tr_job8(INP(I_WINB) + 9216, Wb8 + (size_t)3072 * KDIM, 4096, 1024, 10240, WIN_SCALE, scr, gtw, ngtw, ln);
            fp4_rows_job(INP(I_PV), (unsigned*)PV8, SCV, V0_A, V0_B, gtw, ngtw, ln);
        }
    }
    SEAM(5);
    if (IN(6)) REP(6) { int ln = lane; asm volatile("" : "+v"(ln)); int tq = tid; asm volatile("" : "+v"(tq)); for (int it = vcu; it < (M / 32) * 2; it += G) topk_item2(it, PQ, KEYB, IDX, GATE, (LAS unsigned*)L, (LAS unsigned*)(L + 131072), tq, wave, ln);
        { constexpr int items = (M / 32) * 2, busy = items - (items / 256) * 256;
          if (G == 256 ? vcu >= busy : true) { const int gtw = (G == 256 ? vcu - busy : vcu) * NWAVES + wave, ngtw = (G == 256 ? 256 - busy : G) * NWAVES;
            fp4_rows_job(INP(I_PV), (unsigned*)PV8, SCV, V0_B, NEXP, gtw, ngtw, ln); } } }
    SEAM(6);
#define PACT ((float*)(ws + WS_X1F))
#define ZB ((bf16*)(ws + WS_XF))
#define AV ((float*)(ws + WS_XF + 70 * MiB))
#define STAT ((float*)(ws + WS_XF + 76 * MiB))
#define PEER_SLICED(li, OUTF, OUTB, OUTB8) do { \
        int xg = (G % 8 == 0) ? 8 : 1, xk = bx % xg, wx = (bx / xg) * NWAVES + wave, nwx = (G / xg) * NWAVES; \
        if (N_LAUNCHES == 1) {     \
            if (tid == 0) { unsigned cnt = 0u, xi = 0u, mine = 0u; for (unsigned j = 0; j < 16u; ++j) { const unsigned c = xb_ld(&bar.bar[XB_XCNT(j)]); if (c) { ++cnt; if (j < bar.x) ++xi; } if (j == bar.x) mine = c; } MISC[11] = xi; MISC[12] = cnt; MISC[13] = mine; } \
            __syncthreads(); \
            xk = (int)MISC[11]; xg = (int)MISC[12]; wx = (int)MISC[10] * NWAVES + wave; nwx = (int)MISC[13] * NWAVES; __syncthreads(); } \
        const unsigned char* pu = PU8 + (size_t)(li) * NEXP * (D / 2); const unsigned char* pv = PV8 + (size_t)(li) * NEXP * (D / 2); \
        _Pragma("unroll 1") for (int step8 = 0; step8 < 8; ++step8) { const int step = step8 >> 1; const bool sdup = (MK_STEP_DUP >> step) & 1; if ((step8 & 1) && !sdup) continue; const int emk = (sdup && !(step8 & 1)) ? 127 : 0x3fff;                                         \
            if (step == 0) { for (int sub = xk; sub < NSUB; sub += xg) peer_u_pass_mfma(sub, wx, nwx, X18, IDX, pu + (size_t)sub * SUB_BYTES, PACT + (size_t)sub * M * 128, L + wave * 16384, ln, emk); } \
            else if (step == 1) { for (int t = 2 * gw; t < M; t += 2 * NGW) peer_a_pair(t, IDX, GATE, PACT, SCU + (li) * NEXP, SCV + (li) * NEXP, AV, ln); } \
            else if (step == 2) { for (int sub = xk; sub < NSUB; sub += xg) peer_v_pass(sub, wx, nwx, X1B, IDX, AV, pv + (size_t)sub * SUB_BYTES, ZB, STAT + (size_t)sub * M * 2, (LAS f32x4*)(L + wave * 9216), ln, emk); } \
            else { for (int t = gw; t < M; t += NGW) ln2_row(t, ZB, STAT, INP(I_LN2G) + (li) * D, INP(I_LN2B) + (li) * D, OUTF, OUTB, OUTB8, ln); } \
            if (step8 < 7 && N_LAUNCHES == 1) xcd_barrier(bar); } \
    } while (0)
    if (IN(7)) REP(7) { int ln = lane; asm volatile("" : "+v"(ln)); int tq = tid; asm volatile("" : "+v"(tq)); (void)tq;
        PEER_SLICED(0, (float*)nullptr, XB + (size_t)t * D, XB8 + (size_t)t * D); }
    SEAM(7);
    if (IN(8)) REP(8) { int ln = lane; asm volatile("" : "+v"(ln)); int tq = tid; asm volatile("" : "+v"(tq));
        EpiB<false> E{BUFA, BUFC, QM, BUFB, out}; EpiB<true> E8{BUFA, BUFC, QM, BUFB, out};
        { pg8::MultiOrder<JobsB> S; S.G = G; S.c = bx; S.jt = JobsB{XB, Wb};
          pg8::gemm_phase<EpiB<false>, pg8::MultiOrder<JobsB>>(L, S, E, tq); }
        { constexpr int off = 64;
          pg8::MultiOrder<JobsB8, pg8::TSTEP / 2> S; S.G = G; S.c = (G == 256) ? ((bx + 256 - off) & 255) : bx; S.jt = JobsB8{XB8, Wb8};
          int tq2 = tid; asm volatile("" : "+v"(tq2));
          pg8::gemm_phase<EpiB<true>, pg8::MultiOrder<JobsB8, pg8::TSTEP / 2>, true>(L, S, E8, tq2); }
        const bool in_tail = bx >= 144 || G != 256; const int gtw = (G == 256 ? bx - 144 : bx) * NWAVES + wave, ngtw = (G == 256 ? 112 : G) * NWAVES;
        if (in_tail) { LAS float* scr = (LAS float*)(L + wave * 16640); const size_t gtt = (size_t)gtw * 64 + ln, ntt = (size_t)ngtw * 64;
            __syncthreads();
            tr_job(INP(I_CBV), CVT, 512, 3072, 16, (size_t)512 * 3072, (size_t)512 * 3072, scr, gtw, ngtw, ln);
            cvt_job(INP(I_CBK), CK, (size_t)16 * 512 * 3072, gtt, ntt);
            tr_job8(INP(I_WOUT) + (size_t)4096 * 4096, Wout8 + (size_t)4096 * 4096, 4096, 4096, 4096, WOUT_SCALE, scr, gtw, ngtw, ln); }
    }
    SEAM(8);
    if (IN(9)) REP(9) { int ln = lane; asm volatile("" : "+v"(ln)); int tq = tid; asm volatile("" : "+v"(tq));
        const int sub = (_r == 0) ? 7 : MK_P9_SUB;
        for (int t = vcu; t < 768 + 384; t += G) { if (t < 768) { if (sub & 1) band_wg2(t, BUFA, BUFC, BUFB, INP(I_RELB), CAT, L, tq, wave, ln, sub); } else if (sub & 2) band_wg(1536 + (t - 768), BUFA, BUFC, BUFB, CK, CVT, INP(I_RELB), CAT, L, tq, wave, ln); }
        AW_BAR();
        if (sub & 4) { const int sh = (1152 % G == 0) ? 0 : G - 1152 % G;
          for (int t = ((vcu + sh) % G); t < 320; t += G) mem_wg(t, 1, QM, MKB, MVT, CMK, CMVT, CAT, L, tq, wave, ln); }
    }
    SEAM(9);
    if (IN(10)) REP(10) { int ln = lane; asm volatile("" : "+v"(ln)); int tq = tid; asm volatile("" : "+v"(tq));
        pg8::MultiOrder<Jobs1, pg8::TSTEP / 2> S; S.G = G; S.c = bx; S.jt = Jobs1{(const bf16*)CAT, (const bf16*)(Wout8 + (size_t)4096 * 4096), 16, K_OUT};
        EpiOut<true> E{XB, XB + (size_t)MP * D, Z};
        pg8::gemm_phase<EpiOut<true>, pg8::MultiOrder<Jobs1, pg8::TSTEP / 2>, true>(L, S, E, tq);
        TAIL(544);
        if (in_tail) { __syncthreads();
            tr_job(INP(I_PWQ) + (size_t)4096 * 2048, Wq + (size_t)4096 * 2048, 4096, 2048, 1, 0, 0, scr, gtw, ngtw, ln);
            fp4_rows_job(INP(I_PU) + (size_t)NEXP * D, (unsigned*)(PU8 + (size_t)NEXP * (D / 2)), SCU + NEXP, 0, U1_A, gtw, ngtw, ln); }
    }
    SEAM(10);
    if (IN(11)) REP(11) { int ln = lane; asm volatile("" : "+v"(ln)); int tq = tid; asm volatile("" : "+v"(tq)); for (int m = gw; m < M; m += NGW) ln1_row(Z + (size_t)m * D, INP(I_LN1G) + D, INP(I_LN1B) + D, X1B + (size_t)m * D, X18 + (size_t)m * D, ln); }
    SEAM(11);
    if (IN(12)) REP(12) { int ln = lane; asm volatile("" : "+v"(ln)); int tq = tid; asm volatile("" : "+v"(tq));
        pg8::MultiOrder<Jobs1> S; S.G = G; S.c = bx; S.jt = Jobs1{X1B, Wq + (size_t)2048 * KDIM, 8, K_WQ};
        EpiWq E{PQ};
        pg8::gemm_phase<EpiWq, pg8::MultiOrder<Jobs1>>(L, S, E, tq);
        TAIL(272);
        if (in_tail) { fp4_rows_job(INP(I_PU) + (size_t)NEXP * D, (unsigned*)(PU8 + (size_t)NEXP * (D / 2)), SCU + NEXP, U1_A, NEXP, gtw, ngtw, ln);
            fp4_rows_job(INP(I_PV) + (size_t)NEXP * D, (unsigned*)(PV8 + (size_t)NEXP * (D / 2)), SCV + NEXP, 0, V1_A, gtw, ngtw, ln); }
    }
    SEAM(12);
    if (IN(13)) REP(13) { int ln = lane; asm volatile("" : "+v"(ln)); int tq = tid; asm volatile("" : "+v"(tq)); for (int it = vcu; it < (M / 32) * 2; it += G) topk_item2(it, PQ, KEYB + (size_t)8 * 2 * 128 * 128, IDX, GATE, (LAS unsigned*)L, (LAS unsigned*)(L + 131072), tq, wave, ln);
        { constexpr int items = (M / 32) * 2, busy = items - (items / 256) * 256;
          if (G == 256 ? vcu >= busy : true) { const int gtw = (G == 256 ? vcu - busy : vcu) * NWAVES + wave, ngtw = (G == 256 ? 256 - busy : G) * NWAVES;
            fp4_rows_job(INP(I_PV) + (size_t)NEXP * D, (unsigned*)(PV8 + (size_t)NEXP * (D / 2)), SCV + NEXP, V1_A, NEXP, gtw, ngtw, ln); } } }
    SEAM(13);
    if (IN(14)) REP(14) { int ln = lane; asm volatile("" : "+v"(ln)); int tq = tid; asm volatile("" : "+v"(tq)); (void)tq;
        PEER_SLICED(1, out + O_YP + (size_t)t * D, (bf16*)nullptr, (unsigned char*)nullptr); }
#undef IN
#undef SEAM
#undef INP
}


#if MK_CHECK
constexpr int CW_CHK = 2048;
__device__ inline unsigned hsh(unsigned x) { x ^= x >> 16; x *= 0x7feb352du; x ^= x >> 15; x *= 0x846ca68bu; x ^= x >> 16; return x; }
__device__ inline float b2f(bf16 b) { return __uint_as_float(((unsigned)b) << 16); }
__device__ inline bf16 f2b(float f) { unsigned u = __float_as_uint(f); u += 0x7fffu + ((u >> 16) & 1u); return (bf16)(u >> 16); }
__device__ inline bool badv(float got, float ref, float rtol, float atol) { return !(fabsf(got - ref) <= rtol * fabsf(ref) + atol); }
__device__ inline float gelu_ref(float x) { return 0.5f * x * (1.0f + tanhf(0.7978845608f * (x + 0.044715f * x * x * x))); }
__device__ inline float dotbb(const bf16* a, const bf16* b, int n) { float s = 0.f; for (int k = 0; k < n; ++k) s += b2f(a[k]) * b2f(b[k]); return s; }
#define FLAG(id) atomicAdd(chk + (id), 1u)
__global__ void chk_tr(const float* src, const bf16* dst, int K, int N, int nmat, unsigned* chk, int id) {
    const unsigned i = blockIdx.x * blockDim.x + threadIdx.x; const unsigned r = hsh(i * 3u + 1u), r2 = hsh(i * 3u + 2u), r3 = hsh(i * 3u + 3u);
    const int mi = r % nmat, k = r2 % K, n = r3 % N; const size_t mo = (size_t)mi * K * N;
    if (dst[mo + (size_t)n * K + k] != f2b(src[mo + (size_t)k * N + n])) FLAG(id);
}
__global__ void chk_cvt(const float* src, const bf16* dst, size_t n, unsigned* chk, int id) {
    const unsigned i = blockIdx.x * blockDim.x + threadIdx.x; const size_t j = ((size_t)hsh(i) * 2654435761ull + hsh(i + 77u)) % n;
    if (dst[j] != f2b(src[j])) FLAG(id);
}
__global__ void chk_swb(const float* src, const bf16* dst, unsigned* chk, int id) {
    const unsigned i = blockIdx.x * blockDim.x + threadIdx.x; if (i >= 8 * 128 * 128) return; const int s_ = i & 127, t = (i >> 7) & 127;
    if (dst[i] != f2b(s_ <= t ? src[i] : 0.f)) FLAG(id);
}
__global__ void chk_gemm(const bf16* A, const bf16* B, int Mr, int Nr, const void* O, int ldo, int mode, int act, float scale, unsigned* chk, int id) {
    const unsigned i = blockIdx.x * blockDim.x + threadIdx.x; const int m = hsh(i * 2u + 11u) % Mr, n = hsh(i * 2u + 12u) % Nr;
    float d = dotbb(A + (size_t)m * KDIM, B + (size_t)n * KDIM, KDIM); if (act) d = gelu_ref(d); d *= scale;
    float got; if (mode == 0) got = b2f(((const bf16*)O)[(size_t)m * ldo + n]); else if (mode == 1) got = b2f(((const bf16*)O)[(size_t)n * ldo + m]); else got = ((const float*)O)[(size_t)m * ldo + n];
    if (badv(got, d, 0.012f, 0.004f)) FLAG(id);
}
__global__ void chk_bandout(const bf16* XBp, const bf16* Wrows, const float* out, unsigned* chk, int id) {
    const unsigned i = blockIdx.x * blockDim.x + threadIdx.x; const int r = hsh(i * 2u + 5u) % 1536, c = hsh(i * 2u + 6u) % TOK;
    int m; const float* o;
    if (r < 1024) { const int b = r >> 9, rr = r & 511; m = b * 4096 + 3584 + rr; o = out + (id & 1 ? O_BVP : O_BKP) + ((size_t)(b * 512 + rr)) * TOK + c; }
    else { m = MP + (r - 1024); o = out + (id & 1 ? O_BVS : O_BKS) + (size_t)(r - 1024) * TOK + c; }
    const float d = dotbb(XBp + (size_t)m * KDIM, Wrows + (size_t)c * KDIM, KDIM);
    if (badv(*o, d, 0.002f, 0.002f)) FLAG(id);
}
__global__ void chk_vst(const bf16* VT, const float* vst, unsigned* chk, int id) {
    const unsigned i = blockIdx.x * blockDim.x + threadIdx.x; const int t = hsh(i + 3u) % M; float s = 0.f, q = 0.f, s2 = 0.f, q2 = 0.f;
    for (int c = 0; c < TOK; ++c) { const float v = b2f(VT[(size_t)c * M + t]); s += v; q += v * v; }
    for (int sl = 0; sl < 24; ++sl) { s2 += vst[((size_t)sl * M + t) * 2]; q2 += vst[((size_t)sl * M + t) * 2 + 1]; }
    if (badv(s2, s, 0.01f, 0.5f) || badv(q2, q, 0.01f, 0.5f)) FLAG(id);
}
__device__ inline void ln_stats_tok(const bf16* VT, int t, float& mean, float& rstd) { float s = 0.f, q = 0.f; for (int c = 0; c < TOK; ++c) { const float v = b2f(VT[(size_t)c * M + t]); s += v; q += v * v; } mean = s / TOK; rstd = rsqrtf(q / TOK - mean * mean + LN_EPS); }
__global__ void chk_sgu(const bf16* U, const bf16* VT, const float* sguw, const float* sgub, const float* lng, const float* lnb, const bf16* CATp, const float* out, unsigned* chk, int id) {
    const unsigned i = blockIdx.x * blockDim.x + threadIdx.x; const int t = hsh(i * 2u + 1u) % M, col = hsh(i * 2u + 2u) % TOK, g = col / 384;
    int t0, tl; if (t < MP) { t0 = t & ~127; tl = t & 127; } else { t0 = MP + ((t - MP) & ~31); tl = (t - MP) & 31; }
    float acc = 0.f, vn_t = 0.f;
    for (int s_ = 0; s_ <= tl; ++s_) { float mean, rstd; ln_stats_tok(VT, t0 + s_, mean, rstd); const float vn = (b2f(VT[(size_t)col * M + t0 + s_]) - mean) * rstd * lng[col] + lnb[col];
        acc += sguw[((size_t)g * 128 + tl) * 128 + s_] * vn; if (s_ == tl) vn_t = vn; }
    const float ref = b2f(U[(size_t)t * TOK + col]) * (acc + sgub[g * 128 + tl]);
    if (badv(b2f(CATp[(size_t)t * D + col]), ref, 0.03f, 0.01f)) FLAG(id);
    if (t >= MP && badv(out[O_SGV + (size_t)(t - MP) * TOK + col], vn_t, 0.01f, 0.01f)) FLAG(id + 1);
}
__global__ void chk_memattn(int li, const bf16* QMp, const bf16* MKBp, const bf16* MVTp, const float* cmk, const float* cmv, const bf16* CATp, unsigned* chk, int id) {
    __shared__ float sc[256]; __shared__ float red[256];
    const unsigned i = blockIdx.x; const int t = hsh(i * 3u + 1u) % M, hm = hsh(i * 3u + 2u) & 3, d = hsh(i * 3u + 3u) & 255, m = threadIdx.x;
    float s = 0.f;
    for (int k = 0; k < 256; ++k) { const float q = b2f(QMp[(size_t)t * MEMW + hm * 256 + k]);
        const float kk = (t < MP) ? b2f(MKBp[((size_t)li * 512 + (t >> 12) * 256 + m) * 1024 + hm * 256 + k]) : cmk[(((size_t)(li * 16 + ((t - MP) >> 5)) * 256 + m) * 4 + hm) * 256 + k];
        s += q * kk; }
    sc[m] = s; __syncthreads();
    if (m == 0) { float mx = -1e30f, den = 0.f, num = 0.f; for (int j = 0; j < 256; ++j) mx = fmaxf(mx, sc[j]);
        for (int j = 0; j < 256; ++j) { const float p = expf(sc[j] - mx); den += p;
            const float v = (t < MP) ? b2f(MVTp[((size_t)li * 1024 + hm * 256 + d) * 512 + (t >> 12) * 256 + j]) : cmv[(((size_t)(li * 16 + ((t - MP) >> 5)) * 256 + j) * 4 + hm) * 256 + d];
            num += p * v; }
        if (badv(b2f(CATp[(size_t)t * D + TOK + hm * 256 + d]), num / den, 0.03f, 0.003f)) FLAG(id); }
    (void)red;
}
__global__ void chk_band(const bf16* Qb, const bf16* Kb, const bf16* VT, const float* cbk, const float* cbv, const float* relb, const bf16* CATp, unsigned* chk, int id) {
    const unsigned i = blockIdx.x * blockDim.x + threadIdx.x; const int t = hsh(i * 3u + 1u) % M, h = hsh(i * 3u + 2u) % 24, d = hsh(i * 3u + 3u) & 127;
    float mx = -1e30f, den = 0.f, num = 0.f;
    for (int pass = 0; pass < 2; ++pass) {
        const int nk = (t < MP) ? 576 : 544;
        for (int j = 0; j < nk; ++j) {
            int qpos, kpos; float kv[2]; const bf16* kr = nullptr; const float* krf = nullptr; float vv;
            if (t < MP) { const int b = t >> 12, tt = t & 4095, c = tt >> 6; qpos = tt; kpos = c * 64 - 512 + j; if (kpos < 0) continue;
                kr = Kb + ((size_t)(b * 4096 + kpos)) * TOK + h * 128; vv = b2f(VT[(size_t)(h * 128 + d) * M + b * 4096 + kpos]); }
            else { const int sb = (t - MP) >> 5, tt = (t - MP) & 31; qpos = 1024 + tt; kpos = 512 + j;
                if (j < 512) { krf = cbk + (((size_t)sb * 512 + j) * 24 + h) * 128; vv = cbv[(((size_t)sb * 512 + j) * 24 + h) * 128 + d]; }
                else { kr = Kb + ((size_t)(MP + sb * 32 + (j - 512))) * TOK + h * 128; vv = b2f(VT[(size_t)(h * 128 + d) * M + MP + sb * 32 + (j - 512)]); } }
            float s = 0.f; for (int k = 0; k < 128; ++k) s += b2f(Qb[(size_t)t * TOK + h * 128 + k]) * (kr ? b2f(kr[k]) : krf[k]);
            int rel = qpos - kpos; rel = rel < -128 ? -128 : (rel > 128 ? 128 : rel); s += relb[h * 257 + rel + 128]; (void)kv;
            if (pass == 0) mx = fmaxf(mx, s); else { const float p = expf(s - mx); den += p; num += p * vv; }
        }
    }
    if (badv(b2f(CATp[(size_t)t * D + h * 128 + d]), num / den, 0.03f, 0.004f)) FLAG(id);
}
__global__ void chk_z(const float* xp, const float* xs, const bf16* CATp, const bf16* Wo, const float* Zp, unsigned* chk, int id) {
    const unsigned i = blockIdx.x * blockDim.x + threadIdx.x; const int m = hsh(i * 2u + 1u) % M, n = hsh(i * 2u + 2u) % D;
    const float x = (m < MP) ? xp[(size_t)m * D + n] : xs[(size_t)(m - MP) * D + n];
    if (badv(Zp[(size_t)m * D + n], ALPHA * x + dotbb(CATp + (size_t)m * D, Wo + (size_t)n * D, D), 0.002f, 0.004f)) FLAG(id);
}
__global__ void chk_ln1(const float* Zp, const float* g, const float* b, const float* xf, const bf16* xb, unsigned* chk, int id) {
    const unsigned i = blockIdx.x * blockDim.x + threadIdx.x; const int m = hsh(i + 9u) % M; const float* z = Zp + (size_t)m * D; float s = 0.f, q = 0.f;
    for (int k = 0; k < D; ++k) s += z[k]; const float mean = s / D; for (int k = 0; k < D; ++k) q += (z[k] - mean) * (z[k] - mean); const float rstd = rsqrtf(q / D + LN_EPS);
    for (int k = (i & 7); k < D; k += 8) { const float y = (z[k] - mean) * rstd * g[k] + b[k]; if (badv(xf[(size_t)m * D + k], y, 0.001f, 0.001f) || badv(b2f(xb[(size_t)m * D + k]), y, 0.01f, 0.002f)) { FLAG(id); break; } }
}
__global__ void chk_topk(const bf16* PQp, const bf16* KEYp, const int* IDXp, const float* GATEp, unsigned* chk, int id) {
    __shared__ float s0[128], s1[128]; __shared__ float bs[16]; __shared__ int be[16];
    const unsigned i = blockIdx.x; const int t = hsh(i * 2u + 1u) % M, h = hsh(i * 2u + 2u) & 7, n = threadIdx.x;
    s0[n] = dotbb(PQp + (size_t)t * 2048 + h * 256, KEYp + ((size_t)(h * 2 + 0) * 128 + n) * 128, 128); s1[n] = dotbb(PQp + (size_t)t * 2048 + h * 256 + 128, KEYp + ((size_t)(h * 2 + 1) * 128 + n) * 128, 128);
    __syncthreads();
    if (n == 0) {
        float last = 3e38f; int laste = -1;
        for (int r = 0; r < 16; ++r) { float best = -3e38f; int beste = -1;
            for (int e = 0; e < 16384; ++e) { const float v = s0[e >> 7] + s1[e & 127]; if ((v < last || (v == last && e > laste)) && v > best) { best = v; beste = e; } }
            bs[r] = best; be[r] = beste; last = best; laste = beste; }
        float den = 0.f; for (int r = 0; r < 16; ++r) den += expf(bs[r] - bs[0]);
        int miss = 0; float gerr = 0.f;
        for (int r = 0; r < 16; ++r) { const int e = IDXp[(size_t)t * 128 + h * 16 + r]; const float gg = GATEp[(size_t)t * 128 + h * 16 + r]; int f = -1; for (int q = 0; q < 16; ++q) if (be[q] == e) f = q;
            if (f < 0) { ++miss; if (e < 0 || e >= 16384 || s0[e >> 7] + s1[e & 127] < bs[15] - 1e-3f) miss += 100; } else gerr = fmaxf(gerr, fabsf(gg - expf(bs[f] - bs[0]) / den)); }
        if (miss > 1 || gerr > 2e-3f) FLAG(id);
    }
}
__global__ void chk_peer(const float* X1Fp, const int* IDXp, const float* GATEp, const float* pu, const float* pv, const float* g2, const float* b2, const float* of0, const float* of1, const bf16* ob, const float* adbg, unsigned* chk, int id) {
    __shared__ float a[128]; __shared__ float red[256]; __shared__ float zrow[D];
    const int t = hsh(blockIdx.x + 1234u) % M, tid = threadIdx.x; const float* x = X1Fp + (size_t)t * D;
    if (tid < 128) { const int e = IDXp[(size_t)t * 128 + tid]; float d = 0.f; for (int k = 0; k < D; ++k) d += x[k] * pu[(size_t)e * D + k]; a[tid] = GATEp[(size_t)t * 128 + tid] * gelu_ref(d); }
    if (tid < 128 && badv(adbg[(size_t)t * 128 + tid], a[tid], 0.02f, 2e-4f)) FLAG(32);
    __syncthreads();
    float s = 0.f;
    for (int c = tid; c < D; c += 256) { float y = 0.f; for (int k = 0; k < 128; ++k) y += a[k] * pv[(size_t)IDXp[(size_t)t * 128 + k] * D + c]; const float z = ALPHA * x[c] + y; zrow[c] = z; s += z; }
    red[tid] = s; __syncthreads(); for (int o = 128; o > 0; o >>= 1) { if (tid < o) red[tid] += red[tid + o]; __syncthreads(); } const float mean = red[0] / D; __syncthreads();
    float q = 0.f; for (int c = tid; c < D; c += 256) q += (zrow[c] - mean) * (zrow[c] - mean);
    red[tid] = q; __syncthreads(); for (int o = 128; o > 0; o >>= 1) { if (tid < o) red[tid] += red[tid + o]; __syncthreads(); } const float rstd = rsqrtf(red[0] / D + LN_EPS);
    const float* of = (t < MP) ? of0 + (size_t)t * D : of1 + (size_t)(t - MP) * D; int bad = 0;
    int bad2 = 0, bad3 = 0;
    for (int c = tid; c < D; c += 256) { const float y = (zrow[c] - mean) * rstd * g2[c] + b2[c]; if (badv(of[c], y, 0.01f, 0.01f)) bad = 1; if (badv(of[c], y, 0.1f, 0.1f)) bad2 = 1; if (badv(of[c], y, 1.0f, 1.0f)) bad3 = 1; if (ob && badv(b2f(ob[(size_t)t * D + c]), y, 0.015f, 0.012f)) bad = 1; }
    if (bad) FLAG(id); if (bad2) FLAG(33); if (bad3) FLAG(34);
}
__global__ void chk_report(const unsigned* chk, float* out) {
    int first = 0; for (int k = 31; k >= 1; --k) if (chk[k]) first = k;
    if ((first == 17 || first == 27) && chk[32]) first = 50; else
    if (first == 17 || first == 27) { if (chk[34]) first = 60; else if (chk[33]) first = 40; if (chk[17] + chk[27] >= 64 * 128) first += 5; }
    if (first) for (size_t i = blockIdx.x * blockDim.x + threadIdx.x; i < (size_t)MS * D; i += (size_t)gridDim.x * blockDim.x) out[O_YS + i] *= (1.0f + first);
}
#endif

extern "C" void kernel_launch(void* const* d_in, const int* in_sizes, int n_in, void* d_out, int out_size, void* d_ws, size_t ws_size, hipStream_t stream) {
    static int grid = 0;
    if (grid == 0) {
        if (n_in != 24 || (size_t)out_size != O_END || ws_size < WS_END) { fprintf(stderr, "kernel_launch: unexpected shapes: n_in %d out %d ws %zu (need %zu)\n", n_in, out_size, ws_size, (size_t)WS_END); grid = -1; return; }
        int dev = 0, cus = 0, per_cu = 0;
        if (hipGetDevice(&dev) != hipSuccess || hipDeviceGetAttribute(&cus, hipDeviceAttributeMultiprocessorCount, dev) != hipSuccess) { grid = -1; return; }
        if (hipFuncSetAttribute((const void*)mk_fwd, hipFuncAttributeMaxDynamicSharedMemorySize, LDS_BYTES) != hipSuccess) { fprintf(stderr, "kernel_launch: hipFuncSetAttribute failed\n"); grid = -1; return; }
        if (hipOccupancyMaxActiveBlocksPerMultiprocessor(&per_cu, (const void*)mk_fwd, NWAVES * 64, LDS_BYTES) != hipSuccess || per_cu < 1) { fprintf(stderr, "kernel_launch: occupancy query says %d\n", per_cu); }
        (void)hipGetLastError();
        grid = cus;
    }
    if (grid < 0) return;
    if (hipMemsetAsync((char*)d_ws + WS_CTL, 0, CTL_ZERO_BYTES, stream) != hipSuccess) return;
    Args a{};
    for (int i = 0; i < 24; ++i) a.in[i] = (const float*)d_in[i];
    a.out = (float*)d_out; a.ws = (unsigned char*)d_ws; a.dup = MK_DUP_MASK; a.pad = 0;
    for (int li = 0; li < N_LAUNCHES; ++li) {
        a.ph_lo = (N_LAUNCHES == 1) ? 0 : li; a.ph_hi = (N_LAUNCHES == 1) ? NPHASES : li + 1;
        hipLaunchKernelGGL(mk_fwd, dim3(grid), dim3(NWAVES * 64), LDS_BYTES, stream, a);
#if MK_CHECK
        {   unsigned char* ws = (unsigned char*)d_ws; unsigned* chk = (unsigned*)(ws + WS_CTL) + CW_CHK; float* out = (float*)d_out; const float* const* in = a.in;
#define CK1(kern, n, ...) hipLaunchKernelGGL(kern, dim3(((n) + 255) / 256), dim3(256), 0, stream, __VA_ARGS__)
            const int ph = a.ph_lo;
            if (ph == 0) {
                CK1(chk_tr, 65536, in[I_WINA], Wa, 4096, 7168, 1, chk, 1); CK1(chk_tr, 65536, in[I_WINB], Wb, 4096, 10240, 1, chk, 1); CK1(chk_tr, 65536, in[I_WMKV], Wmkv, 4096, 2048, 2, chk, 1);
                CK1(chk_tr, 65536, in[I_WOUT], Wout, 4096, 4096, 2, chk, 1); CK1(chk_tr, 65536, in[I_PWQ], Wq, 4096, 2048, 2, chk, 1); CK1(chk_tr, 65536, in[I_CMV], CMVT, 256, 1024, 32, chk, 2); CK1(chk_tr, 65536, in[I_CBV], CVT, 512, 3072, 16, chk, 2);
                CK1(chk_cvt, 65536, in[I_XP], XB, (size_t)MP * D, chk, 3); CK1(chk_cvt, 65536, in[I_XS], XB + (size_t)MP * D, (size_t)MS * D, chk, 3); CK1(chk_cvt, 65536, in[I_MEMP], MEMB, (size_t)512 * D, chk, 3);
                CK1(chk_cvt, 65536, in[I_PKEYS], KEYB, (size_t)2 * 8 * 2 * 128 * 128, chk, 3); CK1(chk_cvt, 65536, in[I_CMK], CMK, (size_t)2 * 16 * 256 * 1024, chk, 3); CK1(chk_cvt, 65536, in[I_CBK], CK, (size_t)16 * 512 * 3072, chk, 3);
                CK1(chk_swb, 8 * 128 * 128, in[I_SGUW], SWB, chk, 3);
            } else if (ph == 1) {
                CK1(chk_gemm, 32768, XB, Wa, M, 3072, BUFA, 3072, 0, 1, 1.0f, chk, 4);
                CK1(chk_gemm, 32768, XB, Wa + (size_t)6144 * KDIM, M, 1024, QM, 1024, 0, 0, 0.0625f, chk, 5);
                CK1(chk_gemm, 32768, XB, Wa + (size_t)3072 * KDIM, M, 3072, BUFB, M, 1, 1, 1.0f, chk, 6);
                CK1(chk_vst, 2048, BUFB, VST, chk, 7);
                for (int li = 0; li < 2; ++li) {
                    CK1(chk_gemm, 16384, MEMB, Wmkv + (size_t)li * 2048 * KDIM, 512, 1024, MKB + (size_t)li * 512 * 1024, 1024, 0, 0, 1.0f, chk, 8);
                    CK1(chk_gemm, 16384, MEMB, Wmkv + (size_t)li * 2048 * KDIM, 512, 1024, out + O_MKP + (size_t)li * 512 * 1024, 1024, 2, 0, 1.0f, chk, 8);
                    CK1(chk_gemm, 16384, MEMB, Wmkv + ((size_t)li * 2048 + 1024) * KDIM, 512, 1024, out + O_MVP + (size_t)li * 512 * 1024, 1024, 2, 0, 1.0f, chk, 8);
                    CK1(chk_gemm, 16384, MEMB, Wmkv + ((size_t)li * 2048 + 1024) * KDIM, 512, 1024, MVT + (size_t)li * 1024 * 512, 512, 1, 0, 1.0f, chk, 9); }
            } else if (ph == 2) {
                CK1(chk_sgu, 2048, BUFA, BUFB, in[I_SGUW], in[I_SGUB], in[I_SLNG], in[I_SLNB], CAT, out, chk, 10);
                hipLaunchKernelGGL(chk_memattn, dim3(2048), dim3(256), 0, stream, 0, QM, MKB, MVT, in[I_CMK], in[I_CMV], CAT, chk, 12);
            } else if (ph == 3 || ph == 10) {
                if (ph == 3) CK1(chk_z, 32768, in[I_XP], in[I_XS], CAT, Wout, Z, chk, 13); else CK1(chk_z, 32768, XF, XF + (size_t)MP * D, CAT, Wout + (size_t)4096 * KDIM, Z, chk, 23);
            } else if (ph == 4 || ph == 11) { const int li = ph == 11; CK1(chk_ln1, 2048, Z, in[I_LN1G] + li * D, in[I_LN1B] + li * D, X1F, X1B, chk, li ? 24 : 14);
            } else if (ph == 5 || ph == 12) { const int li = ph == 12; CK1(chk_gemm, 32768, X1B, Wq + (size_t)li * 2048 * KDIM, M, 2048, PQ, 2048, 0, 0, 1.0f, chk, li ? 25 : 15);
            } else if (ph == 6 || ph == 13) { const int li = ph == 13; hipLaunchKernelGGL(chk_topk, dim3(1024), dim3(128), 0, stream, PQ, KEYB + (size_t)li * 8 * 2 * 128 * 128, IDX, GATE, chk, li ? 26 : 16);
            } else if (ph == 7) { hipLaunchKernelGGL(chk_peer, dim3(64), dim3(256), 0, stream, X1F, IDX, GATE, in[I_PU], in[I_PV], in[I_LN2G], in[I_LN2B], XF, XF + (size_t)MP * D, XB, (const float*)(ws + WS_END), chk, 17);
            } else if (ph == 8) {
                CK1(chk_gemm, 32768, XB, Wb, M, 3072, BUFA, 3072, 0, 0, 0.08838834764831845f, chk, 18);
                CK1(chk_gemm, 32768, XB, Wb + (size_t)3072 * KDIM, M, 3072, BUFC, 3072, 0, 0, 1.0f, chk, 19);
                CK1(chk_gemm, 32768, XB, Wb + (size_t)6144 * KDIM, M, 3072, BUFB, M, 1, 0, 1.0f, chk, 20);
                CK1(chk_gemm, 32768, XB, Wb + (size_t)9216 * KDIM, M, 1024, QM, 1024, 0, 0, 0.0625f, chk, 19);
                CK1(chk_bandout, 16384, XB, Wb + (size_t)3072 * KDIM, out, chk, 28); CK1(chk_bandout, 16384, XB, Wb + (size_t)6144 * KDIM, out, chk, 29);
            } else if (ph == 9) {
                CK1(chk_band, 8192, BUFA, BUFC, BUFB, in[I_CBK], in[I_CBV], in[I_RELB], CAT, chk, 21);
                hipLaunchKernelGGL(chk_memattn, dim3(2048), dim3(256), 0, stream, 1, QM, MKB, MVT, in[I_CMK], in[I_CMV], CAT, chk, 22);
            } else if (ph == 14) {
                hipLaunchKernelGGL(chk_peer, dim3(64), dim3(256), 0, stream, X1F, IDX, GATE, in[I_PU] + (size_t)NEXP * D, in[I_PV] + (size_t)NEXP * D, in[I_LN2G] + D, in[I_LN2B] + D, out + O_YP, out + O_YS, (const bf16*)nullptr, (const float*)(ws + WS_END), chk, 27);
                hipLaunchKernelGGL(chk_report, dim3(256), dim3(256), 0, stream, chk, out);
            }
#undef CK1
        }
#endif
    }
}
```
